# Optimizing an MI355X kernel written in HIP

```python
import math
import jax
import jax.numpy as jnp
from jax import lax
import numpy as np

D_MODEL = 1024
BATCH = 4
SEQ = 8192
DEPTH = 2

GRID_W = 64
CTX_LEN = 256
N_MIXERS = 2
HEAD_DIM = 64
A_HEADS = 16
A_KV_HEADS = 4
A_WINDOW = 128
A_BLOCK = 128
B_HEADS = 16
NA_ROWS = 8
NA_COLS = 16
NA_QCOLS = 16
NA_KCOLS = 32
N_EXPERTS = 16
EXPERT_FF = 2048
EC_CAPACITY = 2
ROPE_BASE = 10000.0
EPS = 1e-6
NEG_INF = -1e30
ATTN_SCALE = HEAD_DIM ** -0.5

kernel_name = 'hybrid_swa_natten_ecmoe_dit'


def rms_norm(x, g):
    xf = x.astype(jnp.float32)
    y = xf * lax.rsqrt(jnp.mean(xf * xf, axis=-1, keepdims=True) + EPS)
    return (y * g.astype(jnp.float32)).astype(x.dtype)


def modulate(h, shift, scale):
    return h * (1 + scale[:, None]) + shift[:, None]


def axial_rope_tables(n_tok):
    pos = jnp.arange(n_tok)
    row = (pos // GRID_W).astype(jnp.float32)
    col = (pos % GRID_W).astype(jnp.float32)
    n_freq = HEAD_DIM // 4
    inv = ROPE_BASE ** (-jnp.arange(n_freq, dtype=jnp.float32) / n_freq)
    ang_r = row[:, None] * inv
    ang_c = col[:, None] * inv
    return (jnp.cos(ang_r), jnp.sin(ang_r), jnp.cos(ang_c), jnp.sin(ang_c))


def axial_rope(x, tabs):
    cos_r, sin_r, cos_c, sin_c = tabs
    S = x.shape[1]

    def rot(v, cs, sn):
        shape = (1, S) + (1,) * (v.ndim - 3) + (cs.shape[-1],)
        cs = cs.reshape(shape)
        sn = sn.reshape(shape)
        v1, v2 = jnp.split(v.astype(jnp.float32), 2, axis=-1)
        return jnp.concatenate([v1 * cs - v2 * sn, v1 * sn + v2 * cs], axis=-1)

    xr, xc = jnp.split(x, 2, axis=-1)
    return jnp.concatenate([rot(xr, cos_r, sin_r), rot(xc, cos_c, sin_c)], axis=-1).astype(x.dtype)


def sink_softmax(s, sink):
    m = jnp.maximum(jnp.max(s, axis=-1, keepdims=True), sink)
    p = jnp.exp(s - m)
    return p / (jnp.sum(p, axis=-1, keepdims=True) + jnp.exp(sink - m))


def window_gqa_sink(hl, hc, w_qkv, q_gain, k_gain, sink, w_o, rope_tabs, ctx_out):
    B, S, _ = hl.shape
    G = A_HEADS // A_KV_HEADS
    nb = S // A_BLOCK
    cuts = [A_HEADS * HEAD_DIM, (A_HEADS + A_KV_HEADS) * HEAD_DIM]

    def project(h):
        n = h.shape[1]
        q, k, v = jnp.split(h @ w_qkv, cuts, axis=-1)
        q = rms_norm(q.reshape(B, n, A_KV_HEADS, G, HEAD_DIM), q_gain)
        k = rms_norm(k.reshape(B, n, A_KV_HEADS, HEAD_DIM), k_gain)
        return q, k, v.reshape(B, n, A_KV_HEADS, HEAD_DIM)

    ql, kl, vl = project(hl)
    qc, kc, vc = project(hc)
    ql = axial_rope(ql, rope_tabs)
    kl = axial_rope(kl, rope_tabs)
    sink_l = sink.astype(jnp.float32).reshape(1, A_KV_HEADS, G, 1, 1)

    pad = ((0, 0), (A_BLOCK, A_BLOCK), (0, 0), (0, 0))
    kpad = jnp.pad(kl, pad)
    vpad = jnp.pad(vl, pad)
    qb = jnp.moveaxis(ql.reshape(B, nb, A_BLOCK, A_KV_HEADS, G, HEAD_DIM), 1, 0)
    span = 3 * A_BLOCK
    rel = jnp.arange(A_BLOCK)[:, None] - (jnp.arange(span)[None, :] - A_BLOCK)
    in_window = jnp.abs(rel) <= A_WINDOW

    def block(args):
        i, q = args
        start = i * A_BLOCK
        kw = lax.dynamic_slice_in_dim(kpad, start, span, axis=1)
        vw = lax.dynamic_slice_in_dim(vpad, start, span, axis=1)
        kpos = start - A_BLOCK + jnp.arange(span)
        valid = in_window & ((kpos >= 0) & (kpos < S))[None, :]
        s_loc = jnp.einsum('bqhgd,bkhd->bhgqk', q, kw).astype(jnp.float32) * ATTN_SCALE
        s_loc = jnp.where(valid, s_loc, NEG_INF)
        s_ctx = jnp.einsum('bqhgd,bkhd->bhgqk', q, kc).astype(jnp.float32) * ATTN_SCALE
        p = sink_softmax(jnp.concatenate([s_loc, s_ctx], axis=-1), sink_l).astype(vl.dtype)
        return (jnp.einsum('bhgqk,bkhd->bqhgd', p[..., :span], vw)
                + jnp.einsum('bhgqk,bkhd->bqhgd', p[..., span:], vc))

    o = lax.map(block, (jnp.arange(nb), qb))
    yl = jnp.moveaxis(o, 0, 1).reshape(B, S, A_HEADS * HEAD_DIM) @ w_o
    if not ctx_out:
        return yl, None
    s_cc = jnp.einsum('bqhgd,bkhd->bhgqk', qc, kc).astype(jnp.float32) * ATTN_SCALE
    p_cc = sink_softmax(s_cc, sink_l).astype(vc.dtype)
    oc = jnp.einsum('bhgqk,bkhd->bqhgd', p_cc, vc).reshape(B, hc.shape[1], A_HEADS * HEAD_DIM)
    return yl, oc @ w_o


def neighbourhood_attention(hl, hc, w_qkv, q_gain, k_gain, rpb, w_o, ctx_out):
    B, S, _ = hl.shape
    R = S // GRID_W
    wr = min(NA_ROWS, R)
    nc = GRID_W // NA_QCOLS
    nk = wr * NA_KCOLS

    def project(h):
        n = h.shape[1]
        q, k, v = jnp.split(h @ w_qkv, 3, axis=-1)
        shp = (B, n, B_HEADS, HEAD_DIM)
        return rms_norm(q.reshape(shp), q_gain), rms_norm(k.reshape(shp), k_gain), v.reshape(shp)

    ql, kl, vl = project(hl)
    qc, kc, vc = project(hc)
    qg = jnp.moveaxis(ql.reshape(B, R, nc, NA_QCOLS, B_HEADS, HEAD_DIM), 1, 0)
    kg = kl.reshape(B, R, GRID_W, B_HEADS, HEAD_DIM)
    vg = vl.reshape(B, R, GRID_W, B_HEADS, HEAD_DIM)

    qcol = np.arange(nc)[:, None] * NA_QCOLS + np.arange(NA_QCOLS)[None, :]
    kstart = np.clip(np.arange(nc) * NA_QCOLS - (NA_KCOLS - NA_QCOLS) // 2, 0, GRID_W - NA_KCOLS)
    kcol = kstart[:, None] + np.arange(NA_KCOLS)[None, :]
    wstart = np.clip(qcol - NA_COLS // 2, 0, GRID_W - NA_COLS)
    kc3 = kcol[:, None, :]
    col_ok = (kc3 >= wstart[..., None]) & (kc3 < wstart[..., None] + NA_COLS)
    dcol_idx = np.clip(kc3 - qcol[..., None], -(NA_COLS - 1), NA_COLS - 1) + NA_COLS - 1
    mask = np.broadcast_to(col_ok[:, :, None, :], (nc, NA_QCOLS, wr, NA_KCOLS)).reshape(nc, NA_QCOLS, nk)
    rpb_cols = rpb.astype(jnp.float32)[:, :, dcol_idx]

    def row(args):
        r, q = args
        rs = jnp.clip(r - wr // 2, 0, R - wr)
        kr = lax.dynamic_slice_in_dim(kg, rs, wr, axis=1)[:, :, kcol]
        vr = lax.dynamic_slice_in_dim(vg, rs, wr, axis=1)[:, :, kcol]
        kr = jnp.transpose(kr, (0, 2, 1, 3, 4, 5)).reshape(B, nc, nk, B_HEADS, HEAD_DIM)
        vr = jnp.transpose(vr, (0, 2, 1, 3, 4, 5)).reshape(B, nc, nk, B_HEADS, HEAD_DIM)
        dr_idx = rs - r + jnp.arange(wr) + NA_ROWS - 1
        bias = jnp.transpose(rpb_cols[:, dr_idx], (0, 2, 3, 1, 4)).reshape(B_HEADS, nc, NA_QCOLS, nk)
        s_loc = jnp.einsum('bjqhd,bjkhd->bhjqk', q, kr).astype(jnp.float32) * ATTN_SCALE + bias
        s_loc = jnp.where(mask, s_loc, NEG_INF)
        s_ctx = jnp.einsum('bjqhd,bkhd->bhjqk', q, kc).astype(jnp.float32) * ATTN_SCALE
        p = jax.nn.softmax(jnp.concatenate([s_loc, s_ctx], axis=-1), axis=-1).astype(vl.dtype)
        return (jnp.einsum('bhjqk,bjkhd->bjqhd', p[..., :nk], vr)
                + jnp.einsum('bhjqk,bkhd->bjqhd', p[..., nk:], vc))

    o = lax.map(row, (jnp.arange(R), qg))
    yl = jnp.moveaxis(o, 0, 1).reshape(B, S, B_HEADS * HEAD_DIM) @ w_o
    if not ctx_out:
        return yl, None
    s_cc = jnp.einsum('bqhd,bkhd->bhqk', qc, kc).astype(jnp.float32) * ATTN_SCALE
    p_cc = jax.nn.softmax(s_cc, axis=-1).astype(vc.dtype)
    oc = jnp.einsum('bhqk,bkhd->bqhd', p_cc, vc).reshape(B, hc.shape[1], B_HEADS * HEAD_DIM)
    return yl, oc @ w_o


def ec_moe(x, w_router, w_gate, w_up, w_down):
    B, S, _ = x.shape
    cap = EC_CAPACITY * S // N_EXPERTS
    aff = jax.nn.softmax(jnp.einsum('bsd,de->bse', x, w_router).astype(jnp.float32), axis=-1)
    gate, idx = lax.top_k(jnp.swapaxes(aff, 1, 2), cap)
    bidx = jnp.arange(B)[:, None, None]
    xg = x[bidx, idx]
    h = jax.nn.silu(jnp.einsum('becd,edf->becf', xg, w_gate)) * jnp.einsum('becd,edf->becf', xg, w_up)
    y = jnp.einsum('becf,efd->becd', h, w_down) * gate[..., None].astype(x.dtype)
    return jnp.zeros_like(x).at[bidx, idx].add(y)


def setup_inputs(seed: int = 0) -> dict:
    key = jax.random.key(seed)
    ks = jax.random.split(key, 24)
    n_a = (DEPTH + N_MIXERS - 1) // N_MIXERS
    n_b = DEPTH // N_MIXERS
    f32 = jnp.float32

    def nrm(k, shape, scale):
        return jax.random.normal(k, shape, f32) * scale

    qkv_a = (A_HEADS + 2 * A_KV_HEADS) * HEAD_DIM
    d_a = A_HEADS * HEAD_DIM
    d_b = B_HEADS * HEAD_DIM
    return {
        'x': nrm(ks[0], (BATCH, SEQ, D_MODEL), 1.0),
        'c': nrm(ks[1], (BATCH, D_MODEL), 1.0),
        'ctx': nrm(ks[2], (BATCH, CTX_LEN, D_MODEL), 1.0),
        'c_ctx': nrm(ks[3], (D_MODEL,), 1.0),
        'w_mod': nrm(ks[4], (DEPTH, D_MODEL, 6 * D_MODEL), 0.5 * D_MODEL ** -0.5),
        'b_mod': nrm(ks[5], (DEPTH, 6 * D_MODEL), 0.02),
        'norm_mix': 1.0 + nrm(ks[6], (DEPTH, D_MODEL), 0.02),
        'norm_ffn': 1.0 + nrm(ks[7], (DEPTH, D_MODEL), 0.02),
        'a_w_qkv': nrm(ks[8], (n_a, D_MODEL, qkv_a), D_MODEL ** -0.5),
        'a_q_gain': 1.0 + nrm(ks[9], (n_a, HEAD_DIM), 0.02),
        'a_k_gain': 1.0 + nrm(ks[10], (n_a, HEAD_DIM), 0.02),
        'a_sink': nrm(ks[11], (n_a, A_HEADS), 0.5),
        'a_w_o': nrm(ks[12], (n_a, d_a, D_MODEL), d_a ** -0.5),
        'b_w_qkv': nrm(ks[13], (n_b, D_MODEL, 3 * d_b), D_MODEL ** -0.5),
        'b_q_gain': 1.0 + nrm(ks[14], (n_b, HEAD_DIM), 0.02),
        'b_k_gain': 1.0 + nrm(ks[15], (n_b, HEAD_DIM), 0.02),
        'b_rpb': nrm(ks[16], (n_b, B_HEADS, 2 * NA_ROWS - 1, 2 * NA_COLS - 1), 0.5),
        'b_w_o': nrm(ks[17], (n_b, d_b, D_MODEL), d_b ** -0.5),
        'moe_router': nrm(ks[18], (DEPTH, D_MODEL, N_EXPERTS), D_MODEL ** -0.5),
        'moe_w_gate': nrm(ks[19], (DEPTH, N_EXPERTS, D_MODEL, EXPERT_FF), D_MODEL ** -0.5),
        'moe_w_up': nrm(ks[20], (DEPTH, N_EXPERTS, D_MODEL, EXPERT_FF), D_MODEL ** -0.5),
        'moe_w_down': nrm(ks[21], (DEPTH, N_EXPERTS, EXPERT_FF, D_MODEL), EXPERT_FF ** -0.5),
    }


def reference(x, c, ctx, c_ctx, w_mod, b_mod, norm_mix, norm_ffn,
              a_w_qkv, a_q_gain, a_k_gain, a_sink, a_w_o,
              b_w_qkv, b_q_gain, b_k_gain, b_rpb, b_w_o,
              moe_router, moe_w_gate, moe_w_up, moe_w_down):
    rope_tabs = axial_rope_tables(x.shape[1])
    xl, xc = x, ctx
    for i in range(DEPTH):
        last = i == DEPTH - 1
        mod_l = jax.nn.silu(c) @ w_mod[i] + b_mod[i]
        mod_c = jax.nn.silu(c_ctx)[None] @ w_mod[i] + b_mod[i]
        sh1_l, sc1_l, g1_l, sh2_l, sc2_l, g2_l = jnp.split(mod_l, 6, axis=-1)
        sh1_c, sc1_c, g1_c, sh2_c, sc2_c, g2_c = jnp.split(mod_c, 6, axis=-1)
        hl = modulate(rms_norm(xl, norm_mix[i]), sh1_l, sc1_l)
        hc = modulate(rms_norm(xc, norm_mix[i]), sh1_c, sc1_c)
        j = i // N_MIXERS
        if i % N_MIXERS == 0:
            yl, yc = window_gqa_sink(hl, hc, a_w_qkv[j], a_q_gain[j], a_k_gain[j], a_sink[j],
                                     a_w_o[j], rope_tabs, not last)
        else:
            yl, yc = neighbourhood_attention(hl, hc, b_w_qkv[j], b_q_gain[j], b_k_gain[j], b_rpb[j],
                                             b_w_o[j], not last)
        xl = xl + g1_l[:, None] * yl
        hl = modulate(rms_norm(xl, norm_ffn[i]), sh2_l, sc2_l)
        xl = xl + g2_l[:, None] * ec_moe(hl, moe_router[i], moe_w_gate[i], moe_w_up[i], moe_w_down[i])
        if not last:
            xc = xc + g1_c[:, None] * yc
            hc = modulate(rms_norm(xc, norm_ffn[i]), sh2_c, sc2_c)
            xc = xc + g2_c[:, None] * ec_moe(hc, moe_router[i], moe_w_gate[i], moe_w_up[i], moe_w_down[i])
    return xl
```

```cpp
#include <hip/hip_runtime.h>
#include <cstdio>
#include <cstdint>

#define LAS __attribute__((address_space(3)))
typedef unsigned short bf16;
typedef float f32x4 __attribute__((ext_vector_type(4)));
typedef unsigned u32x4 __attribute__((ext_vector_type(4)));
typedef unsigned u32x2 __attribute__((ext_vector_type(2)));
typedef short bf16x8 __attribute__((ext_vector_type(8)));

constexpr int D = 1024, NB = 4, S = 8192, CTX = 256, NLAT = NB * S, NCTX = NB * CTX, NROWS = NLAT + NCTX;
constexpr int NE = 16, FF = 2048, CAPL = 1024, CAPC = 32;
constexpr int SLOTS_E = 4352, NSLOT = NE * SLOTS_E;
constexpr int QKVA_N = 1536, QKVB_N = 3072;
constexpr float EPS = 1e-6f;
constexpr float LOG2E = 1.4426950408889634f;

constexpr size_t MiB = 1u << 20;
constexpr size_t WS_CTL = 0;
constexpr size_t WS_MOD = 1 * MiB;
constexpr size_t WS_ROPE = 1 * MiB + 512 * 1024;
constexpr size_t WS_AFF = 2 * MiB;
constexpr size_t WS_ROWIDX = 5 * MiB;
constexpr size_t WS_GATE = 5 * MiB + 512 * 1024;
constexpr size_t WS_INV = 6 * MiB;
constexpr size_t WS_XC = 9 * MiB;
constexpr size_t WS_WQKVA = 13 * MiB;
constexpr size_t WS_WOA = 16 * MiB;
constexpr size_t WS_WQKVB = 18 * MiB;
constexpr size_t WS_WOB = 24 * MiB;
constexpr size_t WS_WGU = 26 * MiB;
constexpr size_t WS_WD = 282 * MiB;
constexpr size_t WS_HL = 410 * MiB;
constexpr size_t WS_R1 = 476 * MiB;
constexpr size_t WS_Q = WS_R1, WS_K = WS_R1 + 66 * MiB, WS_V = WS_R1 + 132 * MiB, WS_O = WS_R1 + 198 * MiB;
constexpr size_t WS_H = WS_R1;
constexpr size_t WS_Y = 748 * MiB;
constexpr size_t WS_END = 884 * MiB;

constexpr int NWAVES = 8, NTHREADS = 512;
constexpr int LDS_BYTES = 147456;

__device__ __forceinline__ float bf2f(unsigned h) { return __uint_as_float(h << 16); }
__device__ __forceinline__ unsigned f2bf(float f) { unsigned u = __float_as_uint(f); return (u + 0x7fffu + ((u >> 16) & 1u)) >> 16; }
__device__ __forceinline__ unsigned pk2(float lo, float hi) { return f2bf(lo) | (f2bf(hi) << 16); }
__device__ __forceinline__ float wave_sum(float v) {
#pragma unroll
    for (int o = 32; o >= 1; o >>= 1) v += __shfl_xor(v, o);
    return v;
}
__device__ __forceinline__ float wave_max(float v) {
#pragma unroll
    for (int o = 32; o >= 1; o >>= 1) v = fmaxf(v, __shfl_xor(v, o));
    return v;
}
__device__ __forceinline__ int wave_sum_i(int v) {
#pragma unroll
    for (int o = 32; o >= 1; o >>= 1) v += __shfl_xor(v, o);
    return v;
}
__device__ __forceinline__ float silu_f(float x) { return x / (1.0f + expf(-x)); }

struct Args { const float* in[22]; float* out; unsigned char* ws; int ph_lo, ph_hi; };

__device__ __forceinline__ int qk_rowmap(int n) {
    const int hh = n >> 6, d = n & 63, pn = hh >> 2, wc = hh & 3, bj = d >> 5, dd = d & 31, nn = dd >> 4, fq = (dd & 15) >> 2, i = dd & 3;
    return 256 * pn + 128 * bj + 32 * wc + 8 * fq + 4 * nn + i;
}
__device__ __forceinline__ int conv_rowmap(int mode, int n) {
    switch (mode) {
        case 1: return 256 * (n >> 7) + (n & 127);
        case 2: return 256 * (n >> 7) + 128 + (n & 127);
        case 3: return n < 1280 ? qk_rowmap(n) : n;
        case 4: return n < 2048 ? qk_rowmap(n) : n;
        default: return n;
    }
}
__device__ __forceinline__ void conv_item(const float* __restrict__ W, int K, int N, bf16* __restrict__ Wt, int mode, int item, int lane) {
    const int nblk = N / 32, kb = item / nblk, nbk = item % nblk, k0 = 64 * kb, n0 = 32 * nbk;
    const int nq = lane & 7, kg = lane >> 3;
    f32x4 v[8];
#pragma unroll
    for (int i = 0; i < 8; ++i) v[i] = *(const f32x4*)(W + (size_t)(k0 + 8 * kg + i) * N + n0 + 4 * nq);
#pragma unroll
    for (int c = 0; c < 4; ++c) {
        u32x4 o; o.x = pk2(v[0][c], v[1][c]); o.y = pk2(v[2][c], v[3][c]); o.z = pk2(v[4][c], v[5][c]); o.w = pk2(v[6][c], v[7][c]);
        const int row = conv_rowmap(mode, n0 + 4 * nq + c);
        *(u32x4*)(Wt + (size_t)row * K + k0 + 8 * kg) = o;
    }
}
__device__ __forceinline__ void p0_phase(const Args& a, LAS unsigned char* lds) {
    const int tid = threadIdx.x, lane = tid & 63, wave = tid >> 6;
    unsigned char* ws = a.ws;
    if (blockIdx.x == 0) {
        float* rc = (float*)(ws + WS_ROPE); float* rs = rc + 128 * 16;
        for (int i = tid; i < 128 * 16; i += NTHREADS) { const int v = i >> 4, f = i & 15; const double inv = pow(10000.0, -(double)f / 16.0), ang = (double)v * inv; rc[i] = (float)cos(ang); rs[i] = (float)sin(ang); }
    }
    if (blockIdx.x == 1) {
        int* rowidx = (int*)(ws + WS_ROWIDX); float* gate = (float*)(ws + WS_GATE);
        for (int i = tid; i < NE * 128; i += NTHREADS) { const int e = i >> 7, p = i & 127; rowidx[e * SLOTS_E + 4224 + p] = 0; gate[e * SLOTS_E + 4224 + p] = 0.f; }
    }
    {
        LAS float* sc = (LAS float*)lds;
        LAS float* red = sc + 5 * 1024;
        bool have = false;
        for (int u = blockIdx.x; u < 192; u += gridDim.x) {
            if (!have) {
                for (int i = tid; i < 5 * 1024; i += NTHREADS) { const int r = i >> 10, k = i & 1023; const float cv = r < 4 ? a.in[1][r * 1024 + k] : a.in[3][k]; sc[i] = silu_f(cv); }
                __syncthreads(); have = true;
            }
            const int l = u / 96, cb = u % 96, col = cb * 64 + lane;
            const float* W = a.in[4] + (size_t)l * 1024 * 6144;
            float acc[5] = {0.f, 0.f, 0.f, 0.f, 0.f};
            for (int kk = 0; kk < 128; ++kk) { const int k = wave * 128 + kk; const float wv = W[(size_t)k * 6144 + col];
#pragma unroll
                for (int r = 0; r < 5; ++r) acc[r] += sc[r * 1024 + k] * wv; }
#pragma unroll
            for (int r = 0; r < 5; ++r) red[(wave * 5 + r) * 64 + lane] = acc[r];
            __syncthreads();
            if (tid < 320) { const int r = tid >> 6, ln = tid & 63; float s = 0.f;
#pragma unroll
                for (int w = 0; w < 8; ++w) s += red[(w * 5 + r) * 64 + ln];
                const int cc = cb * 64 + ln;
                ((float*)(ws + WS_MOD))[(l * 5 + r) * 6144 + cc] = s + a.in[5][l * 6144 + cc]; }
            __syncthreads();
        }
    }
    {
        const int gw = blockIdx.x * NWAVES + wave, NGW = gridDim.x * NWAVES;
        constexpr int I_QA = 16 * 48, I_O = 16 * 32, I_QB = 16 * 96, I_SMALL = I_QA + I_O + I_QB + I_O, I_TOT = I_SMALL + 96 * 1024;
        for (int it = gw; it < I_TOT; it += NGW) {
            int r = it;
            if (r < I_QA) { conv_item(a.in[8], 1024, QKVA_N, (bf16*)(ws + WS_WQKVA), 3, r, lane); continue; } r -= I_QA;
            if (r < I_O) { conv_item(a.in[12], 1024, 1024, (bf16*)(ws + WS_WOA), 0, r, lane); continue; } r -= I_O;
            if (r < I_QB) { conv_item(a.in[13], 1024, QKVB_N, (bf16*)(ws + WS_WQKVB), 4, r, lane); continue; } r -= I_QB;
            if (r < I_O) { conv_item(a.in[17], 1024, 1024, (bf16*)(ws + WS_WOB), 0, r, lane); continue; } r -= I_O;
            const int m = r >> 10, item = r & 1023, le = m / 3, which = m % 3;
            if (which == 0) conv_item(a.in[19] + (size_t)le * 1024 * 2048, 1024, 2048, (bf16*)(ws + WS_WGU) + (size_t)le * 4096 * 1024, 1, item, lane);
            else if (which == 1) conv_item(a.in[20] + (size_t)le * 1024 * 2048, 1024, 2048, (bf16*)(ws + WS_WGU) + (size_t)le * 4096 * 1024, 2, item, lane);
            else conv_item(a.in[21] + (size_t)le * 2048 * 1024, 2048, 1024, (bf16*)(ws + WS_WD) + (size_t)le * 1024 * 2048, 0, item, lane);
        }
    }
}

__device__ __forceinline__ void norm_mod(const f32x4 (&v)[4], f32x4 (&y)[4], const float* g, const float* sh, const float* sc, int lane) {
    float ss = 0.f;
#pragma unroll
    for (int j = 0; j < 4; ++j) ss += (v[j][0] * v[j][0] + v[j][1] * v[j][1]) + (v[j][2] * v[j][2] + v[j][3] * v[j][3]);
    ss = wave_sum(ss);
    const float rstd = 1.0f / sqrtf(ss * (1.0f / D) + EPS);
#pragma unroll
    for (int j = 0; j < 4; ++j) { const int col = 4 * lane + 256 * j; const f32x4 gg = *(const f32x4*)(g + col), s0 = *(const f32x4*)(sh + col), s1 = *(const f32x4*)(sc + col);
        y[j] = (v[j] * rstd * gg) * (1.0f + s1) + s0; }
}
__device__ __forceinline__ void store_bf16_row(bf16* orow, const f32x4 (&y)[4], int lane) {
#pragma unroll
    for (int j = 0; j < 4; ++j) { u32x2 w; w.x = pk2(y[j][0], y[j][1]); w.y = pk2(y[j][2], y[j][3]); *(u32x2*)(orow + 4 * lane + 256 * j) = w; }
}
__device__ __forceinline__ void norm1_l0_phase(const Args& a) {
    const int lane = threadIdx.x & 63, wave = threadIdx.x >> 6;
    const int gw = blockIdx.x * NWAVES + wave, NGW = gridDim.x * NWAVES;
    const float* mod = (const float*)(a.ws + WS_MOD); bf16* HL = (bf16*)(a.ws + WS_HL);
    for (int row = gw; row < NROWS; row += NGW) {
        const bool lat = row < NLAT; const int r = lat ? row / S : 4;
        const float* xr = lat ? a.in[0] + (size_t)row * D : a.in[2] + (size_t)(row - NLAT) * D;
        f32x4 v[4], y[4];
#pragma unroll
        for (int j = 0; j < 4; ++j) v[j] = *(const f32x4*)(xr + 4 * lane + 256 * j);
        const float* m = mod + (0 * 5 + r) * 6144;
        norm_mod(v, y, a.in[6], m, m + 1024, lane);
        store_bf16_row(HL + (size_t)row * D, y, lane);
    }
}
__device__ __forceinline__ void norm2_router_phase(const Args& a, int l, int nrows, LAS unsigned char* lds) {
    const int tid = threadIdx.x, lane = tid & 63, wave = tid >> 6;
    LAS float* wT = (LAS float*)lds;
    const float* wr = a.in[18] + (size_t)l * 1024 * 16;
    for (int i = tid; i < 16384; i += NTHREADS) { const int k = i >> 4, e = i & 15; wT[e * 1024 + k] = wr[i]; }
    __syncthreads();
    const float* mod = (const float*)(a.ws + WS_MOD); bf16* HL = (bf16*)(a.ws + WS_HL);
    const float* XC = (const float*)(a.ws + WS_XC); float* AFF = (float*)(a.ws + WS_AFF);
    const float* gn = a.in[7] + l * 1024;
    const int ngroups = nrows / 16;
    const int gw = blockIdx.x * NWAVES + wave, NGW = gridDim.x * NWAVES;
    for (int grp = gw; grp < ngroups; grp += NGW) {
        const int row0 = grp * 16; const bool lat = row0 < NLAT; const int b = lat ? row0 / S : (row0 - NLAT) / CTX, r = lat ? b : 4;
        const float* m = mod + (l * 5 + r) * 6144 + 3 * 1024;
        float mine[16];
#pragma unroll
        for (int e = 0; e < 16; ++e) mine[e] = 0.f;
        for (int i = 0; i < 16; ++i) {
            const int row = row0 + i;
            const float* xr = lat ? a.out + (size_t)row * D : XC + (size_t)(row - NLAT) * D;
            f32x4 v[4], y[4];
#pragma unroll
            for (int j = 0; j < 4; ++j) v[j] = *(const f32x4*)(xr + 4 * lane + 256 * j);
            norm_mod(v, y, gn, m, m + 1024, lane);
            store_bf16_row(HL + (size_t)row * D, y, lane);
            float lg[16]; float mx = -3.0e38f;
#pragma unroll
            for (int e = 0; e < 16; ++e) { float s = 0.f;
#pragma unroll
                for (int j = 0; j < 4; ++j) { const f32x4 w = *(const LAS f32x4*)(wT + e * 1024 + 4 * lane + 256 * j); s += (y[j][0] * w[0] + y[j][1] * w[1]) + (y[j][2] * w[2] + y[j][3] * w[3]); }
                lg[e] = wave_sum(s); mx = fmaxf(mx, lg[e]);
                if (e & 1) asm volatile("" ::: "memory"); }
            float den = 0.f;
#pragma unroll
            for (int e = 0; e < 16; ++e) { lg[e] = expf(lg[e] - mx); den += lg[e]; }
            const float rden = 1.0f / den;
#pragma unroll
            for (int e = 0; e < 16; ++e) if (lane == i) mine[e] = lg[e] * rden;
        }
        if (lane < 16) {
            if (lat) { const int s0 = row0 - b * S;
#pragma unroll
                for (int e = 0; e < 16; ++e) AFF[(size_t)(b * 16 + e) * S + s0 + lane] = mine[e]; }
            else { const int s0 = row0 - NLAT - b * CTX;
#pragma unroll
                for (int e = 0; e < 16; ++e) AFF[(size_t)64 * S + (size_t)(b * 16 + e) * CTX + s0 + lane] = mine[e]; }
        }
    }
}
__device__ __forceinline__ int block_sum_i(int v, LAS int* sm, int lane, int wave) {
    v = wave_sum_i(v);
    if (lane == 0) sm[wave] = v;
    __syncthreads();
    int t = 0;
#pragma unroll
    for (int w = 0; w < NWAVES; ++w) t += sm[w];
    __syncthreads();
    return t;
}
__device__ __forceinline__ void select_phase(const Args& a, int npairs, LAS unsigned char* lds) {
    const int tid = threadIdx.x, lane = tid & 63, wave = tid >> 6;
    LAS int* sm = (LAS int*)lds;
    const float* AFF = (const float*)(a.ws + WS_AFF);
    int* ROWIDX = (int*)(a.ws + WS_ROWIDX); float* GATE = (float*)(a.ws + WS_GATE); int* INV = (int*)(a.ws + WS_INV);
    for (int p = blockIdx.x; p < npairs; p += gridDim.x) {
        const bool lat = p < 64; const int pp = lat ? p : p - 64, b = pp >> 4, e = pp & 15;
        const int n = lat ? S : CTX, cap = lat ? CAPL : CAPC;
        const float* aff = lat ? AFF + (size_t)pp * S : AFF + (size_t)64 * S + (size_t)pp * CTX;
        const int slot_base = lat ? e * SLOTS_E + b * CAPL : e * SLOTS_E + 4096 + b * CAPC;
        const int row_base = lat ? b * S : NLAT + b * CTX;
        unsigned key[16]; const int base = tid * 16;
        if (base < n) {
#pragma unroll
            for (int j = 0; j < 4; ++j) { const f32x4 t = *(const f32x4*)(aff + base + 4 * j); key[4 * j] = __float_as_uint(t[0]); key[4 * j + 1] = __float_as_uint(t[1]); key[4 * j + 2] = __float_as_uint(t[2]); key[4 * j + 3] = __float_as_uint(t[3]); }
        } else {
#pragma unroll
            for (int j = 0; j < 16; ++j) key[j] = 0u;
        }
        unsigned T = 0u;
        for (int bit = 30; bit >= 0; --bit) {
            const unsigned cand = T | (1u << bit); int cnt = 0;
#pragma unroll
            for (int j = 0; j < 16; ++j) cnt += (key[j] >= cand) ? 1 : 0;
            const int tot = block_sum_i(cnt, sm, lane, wave);
            if (tot >= cap) T = cand;
        }
        int cgt = 0, ceq = 0;
#pragma unroll
        for (int j = 0; j < 16; ++j) { cgt += (key[j] > T) ? 1 : 0; ceq += (key[j] == T) ? 1 : 0; }
        int igt = cgt, ieq = ceq;
#pragma unroll
        for (int o = 1; o < 64; o <<= 1) { const int t1 = __shfl_up(igt, o), t2 = __shfl_up(ieq, o); if (lane >= o) { igt += t1; ieq += t2; } }
        if (lane == 63) { sm[16 + wave] = igt; sm[32 + wave] = ieq; }
        __syncthreads();
        int pgt = igt - cgt, peq = ieq - ceq, totgt = 0;
#pragma unroll
        for (int w = 0; w < NWAVES; ++w) { const int g = sm[16 + w], q = sm[32 + w]; if (w < wave) { pgt += g; peq += q; } totgt += g; }
        __syncthreads();
        const int need = cap - totgt;
        if (base < n) {
            int g = pgt, q = peq;
#pragma unroll
            for (int j = 0; j < 16; ++j) {
                const unsigned k = key[j]; const int row = row_base + base + j;
                const bool sel = (k > T) || (k == T && q < need);
                int slot = -1;
                if (sel) { slot = slot_base + g + (q < need ? q : need); ROWIDX[slot] = row; GATE[slot] = __uint_as_float(k); }
                INV[(size_t)row * 16 + e] = slot;
                g += (k > T) ? 1 : 0; q += (k == T) ? 1 : 0;
            }
        }
    }
}
__device__ __forceinline__ void combine_phase(const Args& a, int l) {
    const int lane = threadIdx.x & 63, wave = threadIdx.x >> 6;
    const int gw = blockIdx.x * NWAVES + wave, NGW = gridDim.x * NWAVES;
    const float* mod = (const float*)(a.ws + WS_MOD); bf16* HL = (bf16*)(a.ws + WS_HL);
    const float* XC = (const float*)(a.ws + WS_XC); const int* INV = (const int*)(a.ws + WS_INV); const bf16* Y = (const bf16*)(a.ws + WS_Y);
    const int nrows = (l == 0) ? NROWS : NLAT;
    for (int row = gw; row < nrows; row += NGW) {
        const bool lat = row < NLAT; const int r = lat ? row / S : 4;
        const int inv = (lane < 16) ? INV[(size_t)row * 16 + lane] : -1;
        float* xr = lat ? a.out + (size_t)row * D : (float*)XC + (size_t)(row - NLAT) * D;
        f32x4 v[4], acc[4];
#pragma unroll
        for (int j = 0; j < 4; ++j) { v[j] = *(const f32x4*)(xr + 4 * lane + 256 * j); acc[j] = (f32x4){0.f, 0.f, 0.f, 0.f}; }
        for (int e = 0; e < 16; ++e) {
            const int s = __shfl(inv, e);
            if (s >= 0) {
                const bf16* yr = Y + (size_t)s * D;
#pragma unroll
                for (int j = 0; j < 4; ++j) { const u32x2 w = *(const u32x2*)(yr + 4 * lane + 256 * j);
                    acc[j][0] += bf2f(w.x & 0xffffu); acc[j][1] += bf2f(w.x >> 16); acc[j][2] += bf2f(w.y & 0xffffu); acc[j][3] += bf2f(w.y >> 16); }
            }
        }
        const float* g2 = mod + (l * 5 + r) * 6144 + 5 * 1024;
#pragma unroll
        for (int j = 0; j < 4; ++j) { const f32x4 gg = *(const f32x4*)(g2 + 4 * lane + 256 * j); v[j] = v[j] + gg * acc[j]; }
        if (lat) {
#pragma unroll
            for (int j = 0; j < 4; ++j) *(f32x4*)(xr + 4 * lane + 256 * j) = v[j];
        }
        if (l == 0) {
            f32x4 y[4]; const float* m = mod + (1 * 5 + r) * 6144;
            norm_mod(v, y, a.in[6] + 1024, m, m + 1024, lane);
            store_bf16_row(HL + (size_t)row * D, y, lane);
        }
    }
}

__global__ void __launch_bounds__(NTHREADS, 2) mega(Args a) {
    extern __shared__ __attribute__((aligned(16))) unsigned char lds_raw[];
    LAS unsigned char* lds = (LAS unsigned char*)lds_raw;
    const int lo = a.ph_lo, hi = a.ph_hi;
#define IN(k) (lo <= (k) && (k) < hi)
    if (IN(0)) p0_phase(a, lds);
    if (IN(1)) norm1_l0_phase(a);
    if (IN(5)) norm2_router_phase(a, 0, NROWS, lds);
    if (IN(6)) select_phase(a, 128, lds);
    if (IN(9)) combine_phase(a, 0);
    if (IN(13)) norm2_router_phase(a, 1, NLAT, lds);
    if (IN(14)) select_phase(a, 64, lds);
    if (IN(17)) combine_phase(a, 1);
#undef IN
}

struct NaiveG {
    const bf16* A; int lda; const int* rowidx;
    const float* W; const float* W2; int ldw; size_t wstride_e;
    int M, N, K, mode;
    bf16* o0; bf16* o1; bf16* o2; int kvw;
    const float* base_lat; const float* base_ctx; float* out_lat; float* out_ctx; const float* g1;
    const float* gate;
};
__global__ void __launch_bounds__(256) naive_gemm(NaiveG g) {
    const int lane = threadIdx.x & 63, wave = threadIdx.x >> 6;
    const int tiles_n = g.N / 64; const long ntiles = (long)(g.M / 32) * tiles_n;
    const int fr = lane & 15, fq = lane >> 4;
    for (long wt = (long)blockIdx.x * 4 + wave; wt < ntiles; wt += (long)gridDim.x * 4) {
        const int tm = (int)(wt / tiles_n), tn = (int)(wt % tiles_n), r0 = tm * 32, c0 = tn * 64;
        const int e = g.wstride_e ? r0 / SLOTS_E : 0;
        const float* W = g.W + (size_t)e * g.wstride_e; const float* W2 = g.W2 ? g.W2 + (size_t)e * g.wstride_e : nullptr;
        const bf16* arow[2];
#pragma unroll
        for (int mi = 0; mi < 2; ++mi) { const int m = r0 + 16 * mi + fr; const int ar = g.rowidx ? g.rowidx[m] : m; arow[mi] = g.A + (size_t)ar * g.lda + 8 * fq; }
        f32x4 acc[2][4], acc2[2][4];
#pragma unroll
        for (int mi = 0; mi < 2; ++mi)
#pragma unroll
            for (int ni = 0; ni < 4; ++ni) { acc[mi][ni] = (f32x4){0.f, 0.f, 0.f, 0.f}; acc2[mi][ni] = (f32x4){0.f, 0.f, 0.f, 0.f}; }
        for (int k0 = 0; k0 < g.K; k0 += 32) {
            bf16x8 af[2];
#pragma unroll
            for (int mi = 0; mi < 2; ++mi) af[mi] = *(const bf16x8*)(arow[mi] + k0);
#pragma unroll
            for (int ni = 0; ni < 4; ++ni) {
                const float* wp = W + (size_t)(k0 + 8 * fq) * g.ldw + c0 + 16 * ni + fr;
                bf16x8 bfr;
#pragma unroll
                for (int j = 0; j < 8; ++j) bfr[j] = (short)f2bf(wp[(size_t)j * g.ldw]);
#pragma unroll
                for (int mi = 0; mi < 2; ++mi) acc[mi][ni] = __builtin_amdgcn_mfma_f32_16x16x32_bf16(af[mi], bfr, acc[mi][ni], 0, 0, 0);
                if (W2) {
                    const float* wp2 = W2 + (size_t)(k0 + 8 * fq) * g.ldw + c0 + 16 * ni + fr;
#pragma unroll
                    for (int j = 0; j < 8; ++j) bfr[j] = (short)f2bf(wp2[(size_t)j * g.ldw]);
#pragma unroll
                    for (int mi = 0; mi < 2; ++mi) acc2[mi][ni] = __builtin_amdgcn_mfma_f32_16x16x32_bf16(af[mi], bfr, acc2[mi][ni], 0, 0, 0);
                }
            }
        }
#pragma unroll
        for (int mi = 0; mi < 2; ++mi)
#pragma unroll
            for (int ni = 0; ni < 4; ++ni)
#pragma unroll
                for (int i = 0; i < 4; ++i) {
                    const int row = r0 + 16 * mi + 4 * fq + i, col = c0 + 16 * ni + fr; const float v = acc[mi][ni][i];
                    if (g.mode == 0) {
                        const int nq = 1024;
                        if (col < nq) g.o0[(size_t)row * 1024 + col] = (bf16)f2bf(v);
                        else if (col < nq + g.kvw) g.o1[(size_t)row * g.kvw + col - nq] = (bf16)f2bf(v);
                        else g.o2[(size_t)row * g.kvw + col - nq - g.kvw] = (bf16)f2bf(v);
                    } else if (g.mode == 1) {
                        const bool lat = row < NLAT; const int r = lat ? row / S : 4;
                        const size_t off = lat ? (size_t)row * D + col : (size_t)(row - NLAT) * D + col;
                        const float bs = lat ? g.base_lat[off] : g.base_ctx[off];
                        (lat ? g.out_lat : g.out_ctx)[off] = bs + g.g1[r * 6144 + col] * v;
                    } else if (g.mode == 2) {
                        const float u = acc2[mi][ni][i]; g.o0[(size_t)row * FF + col] = (bf16)f2bf(silu_f(v) * u);
                    } else {
                        g.o0[(size_t)row * D + col] = (bf16)f2bf(v * g.gate[row]);
                    }
                }
    }
}
__global__ void __launch_bounds__(256) naive_qknorm(bf16* Q, bf16* Kb, int kvw, const float* qg, const float* kg, const float* ropet, int rope) {
    const int lane = threadIdx.x & 63, wave = threadIdx.x >> 6;
    const int nkh = kvw / 64;
    for (int row = blockIdx.x * 4 + wave; row < NROWS; row += gridDim.x * 4) {
        const bool lat = row < NLAT; const int pos = row % S;
        for (int h = 0; h < 16 + nkh; ++h) {
            bf16* p = h < 16 ? Q + (size_t)row * 1024 + h * 64 + lane : Kb + (size_t)row * kvw + (h - 16) * 64 + lane;
            const float x = bf2f(*p);
            const float ss = wave_sum(x * x);
            float y = x * (1.0f / sqrtf(ss * (1.0f / 64.0f) + EPS)) * (h < 16 ? qg[lane] : kg[lane]);
            if (rope && lat) {
                const int half = lane >> 5, dd = lane & 31, f = dd & 15; const int v = half == 0 ? pos / 64 : pos % 64;
                const float cs = ropet[v * 16 + f], sn = ropet[128 * 16 + v * 16 + f];
                const float other = __shfl_xor(y, 16);
                y = (dd < 16) ? y * cs - other * sn : other * sn + y * cs;
            }
            *p = (bf16)f2bf(y);
        }
    }
}
__global__ void __launch_bounds__(256) naive_attn_a(const bf16* Q, const bf16* Kb, const bf16* Vb, bf16* O, const float* sink) {
    const int lane = threadIdx.x & 63, wave = threadIdx.x >> 6;
    const long total = (long)NROWS * 16;
    for (long gw = (long)blockIdx.x * 4 + wave; gw < total; gw += (long)gridDim.x * 4) {
        const int row = (int)(gw >> 4), head = (int)(gw & 15), kvh = head >> 2;
        const bool lat = row < NLAT; const int b = lat ? row / S : (row - NLAT) / CTX, pos = row % S;
        float q[64];
#pragma unroll
        for (int c = 0; c < 8; ++c) { const u32x4 w = *(const u32x4*)(Q + (size_t)row * 1024 + head * 64 + 8 * c);
            q[8 * c] = bf2f(w.x & 0xffffu); q[8 * c + 1] = bf2f(w.x >> 16); q[8 * c + 2] = bf2f(w.y & 0xffffu); q[8 * c + 3] = bf2f(w.y >> 16);
            q[8 * c + 4] = bf2f(w.z & 0xffffu); q[8 * c + 5] = bf2f(w.z >> 16); q[8 * c + 6] = bf2f(w.w & 0xffffu); q[8 * c + 7] = bf2f(w.w >> 16); }
        const int klo = lat ? max(pos - 128, 0) : 0, khi = lat ? min(pos + 128, S - 1) : -1;
        float sc[9]; int krow[9];
        const float sk = sink[head];
        float mx = sk;
#pragma unroll
        for (int t = 0; t < 9; ++t) {
            int kr; bool valid;
            if (t < 5) { const int kp = klo + 64 * t + lane; valid = kp <= khi; kr = b * S + kp; }
            else { valid = true; kr = NLAT + b * CTX + 64 * (t - 5) + lane; }
            krow[t] = valid ? kr : -1; float s = -1e30f;
            if (valid) { const bf16* kp_ = Kb + (size_t)kr * 256 + kvh * 64; float d = 0.f;
#pragma unroll
                for (int c = 0; c < 8; ++c) { const u32x4 w = *(const u32x4*)(kp_ + 8 * c);
                    d += q[8 * c] * bf2f(w.x & 0xffffu) + q[8 * c + 1] * bf2f(w.x >> 16) + q[8 * c + 2] * bf2f(w.y & 0xffffu) + q[8 * c + 3] * bf2f(w.y >> 16)
                       + q[8 * c + 4] * bf2f(w.z & 0xffffu) + q[8 * c + 5] * bf2f(w.z >> 16) + q[8 * c + 6] * bf2f(w.w & 0xffffu) + q[8 * c + 7] * bf2f(w.w >> 16); }
                s = d * 0.125f; }
            sc[t] = s; mx = fmaxf(mx, s);
        }
        mx = wave_max(mx);
        float den = 0.f;
#pragma unroll
        for (int t = 0; t < 9; ++t) { sc[t] = krow[t] >= 0 ? expf(sc[t] - mx) : 0.f; den += sc[t]; }
        den = wave_sum(den) + expf(sk - mx);
        float o = 0.f;
#pragma unroll
        for (int t = 0; t < 9; ++t)
            for (int j = 0; j < 64; ++j) { const int kr = __shfl(krow[t], j); const float p = __shfl(sc[t], j); if (kr >= 0) o += p * bf2f(Vb[(size_t)kr * 256 + kvh * 64 + lane]); }
        O[(size_t)row * 1024 + head * 64 + lane] = (bf16)f2bf(o / den);
    }
}
__global__ void __launch_bounds__(256) naive_attn_b(const bf16* Q, const bf16* Kb, const bf16* Vb, bf16* O, const float* rpb) {
    const int lane = threadIdx.x & 63, wave = threadIdx.x >> 6;
    const long total = (long)NLAT * 16;
    for (long gw = (long)blockIdx.x * 4 + wave; gw < total; gw += (long)gridDim.x * 4) {
        const int row = (int)(gw >> 4), head = (int)(gw & 15);
        const int b = row / S, pos = row % S, r = pos / 64, c = pos % 64;
        const int rs = min(max(r - 4, 0), 120), wst = min(max(c - 8, 0), 48);
        float q[64];
#pragma unroll
        for (int cc = 0; cc < 8; ++cc) { const u32x4 w = *(const u32x4*)(Q + (size_t)row * 1024 + head * 64 + 8 * cc);
            q[8 * cc] = bf2f(w.x & 0xffffu); q[8 * cc + 1] = bf2f(w.x >> 16); q[8 * cc + 2] = bf2f(w.y & 0xffffu); q[8 * cc + 3] = bf2f(w.y >> 16);
            q[8 * cc + 4] = bf2f(w.z & 0xffffu); q[8 * cc + 5] = bf2f(w.z >> 16); q[8 * cc + 6] = bf2f(w.w & 0xffffu); q[8 * cc + 7] = bf2f(w.w >> 16); }
        float sc[6]; int krow[6]; float mx = -1e30f;
#pragma unroll
        for (int t = 0; t < 6; ++t) {
            int kr; float bias = 0.f;
            if (t < 2) { const int j = 64 * t + lane, krr = rs + (j >> 4), kc = wst + (j & 15); kr = b * S + krr * 64 + kc; bias = rpb[(head * 15 + (krr - r + 7)) * 31 + (kc - c + 15)]; }
            else kr = NLAT + b * CTX + 64 * (t - 2) + lane;
            krow[t] = kr;
            const bf16* kp_ = Kb + (size_t)kr * 1024 + head * 64; float d = 0.f;
#pragma unroll
            for (int cc = 0; cc < 8; ++cc) { const u32x4 w = *(const u32x4*)(kp_ + 8 * cc);
                d += q[8 * cc] * bf2f(w.x & 0xffffu) + q[8 * cc + 1] * bf2f(w.x >> 16) + q[8 * cc + 2] * bf2f(w.y & 0xffffu) + q[8 * cc + 3] * bf2f(w.y >> 16)
                   + q[8 * cc + 4] * bf2f(w.z & 0xffffu) + q[8 * cc + 5] * bf2f(w.z >> 16) + q[8 * cc + 6] * bf2f(w.w & 0xffffu) + q[8 * cc + 7] * bf2f(w.w >> 16); }
            sc[t] = d * 0.125f + bias; mx = fmaxf(mx, sc[t]);
        }
        mx = wave_max(mx);
        float den = 0.f;
#pragma unroll
        for (int t = 0; t < 6; ++t) { sc[t] = expf(sc[t] - mx); den += sc[t]; }
        den = wave_sum(den);
        float o = 0.f;
#pragma unroll
        for (int t = 0; t < 6; ++t)
            for (int j = 0; j < 64; ++j) { const int kr = __shfl(krow[t], j); const float p = __shfl(sc[t], j); o += p * bf2f(Vb[(size_t)kr * 1024 + head * 64 + lane]); }
        O[(size_t)row * 1024 + head * 64 + lane] = (bf16)f2bf(o / den);
    }
}

extern "C" void kernel_launch(void* const* d_in, const int* in_sizes, int n_in, void* d_out, int out_size, void* d_ws, size_t ws_size, hipStream_t stream) {
    static int grid = 0;
    if (grid == 0) {
        if (n_in != 22 || out_size != NLAT * D || ws_size < WS_END) { fprintf(stderr, "kernel_launch: unexpected shapes n_in %d out %d ws %zu\n", n_in, out_size, ws_size); grid = -1; return; }
        int dev = 0, cus = 0, per_cu = 0;
        hipGetDevice(&dev); hipDeviceGetAttribute(&cus, hipDeviceAttributeMultiprocessorCount, dev);
        hipFuncSetAttribute((const void*)mega, hipFuncAttributeMaxDynamicSharedMemorySize, LDS_BYTES);
        hipOccupancyMaxActiveBlocksPerMultiprocessor(&per_cu, (const void*)mega, NTHREADS, LDS_BYTES);
        (void)hipGetLastError();
        if (per_cu < 1) fprintf(stderr, "kernel_launch: occupancy query says %d blocks/CU\n", per_cu);
        grid = cus;
    }
    if (grid < 0) return;
    unsigned char* ws = (unsigned char*)d_ws;
    hipMemsetAsync(ws + WS_CTL, 0, 1 * MiB, stream);
    Args a{};
    for (int i = 0; i < 22; ++i) a.in[i] = (const float*)d_in[i];
    a.out = (float*)d_out; a.ws = ws;
    auto run = [&](int p) { a.ph_lo = p; a.ph_hi = p + 1; hipLaunchKernelGGL(mega, dim3(grid), dim3(NTHREADS), LDS_BYTES, stream, a); };
    const float* mod = (const float*)(ws + WS_MOD);
    bf16* HL = (bf16*)(ws + WS_HL); bf16* Qb = (bf16*)(ws + WS_Q); bf16* Kb = (bf16*)(ws + WS_K); bf16* Vb = (bf16*)(ws + WS_V); bf16* Ob = (bf16*)(ws + WS_O);
    bf16* Hb = (bf16*)(ws + WS_H); bf16* Yb = (bf16*)(ws + WS_Y);
    const int NG = 2048;
    run(0); run(1);
    for (int l = 0; l < 2; ++l) {
        { NaiveG g{}; g.A = HL; g.lda = D; g.W = l == 0 ? a.in[8] : a.in[13]; g.ldw = l == 0 ? QKVA_N : QKVB_N; g.M = NROWS; g.N = g.ldw; g.K = D; g.mode = 0;
          g.o0 = Qb; g.o1 = Kb; g.o2 = Vb; g.kvw = l == 0 ? 256 : 1024;
          hipLaunchKernelGGL(naive_gemm, dim3(NG), dim3(256), 0, stream, g); }
        hipLaunchKernelGGL(naive_qknorm, dim3(NG), dim3(256), 0, stream, Qb, Kb, l == 0 ? 256 : 1024, l == 0 ? a.in[9] : a.in[14], l == 0 ? a.in[10] : a.in[15], (const float*)(ws + WS_ROPE), l == 0 ? 1 : 0);
        if (l == 0) hipLaunchKernelGGL(naive_attn_a, dim3(NG), dim3(256), 0, stream, (const bf16*)Qb, (const bf16*)Kb, (const bf16*)Vb, Ob, a.in[11]);
        else hipLaunchKernelGGL(naive_attn_b, dim3(NG), dim3(256), 0, stream, (const bf16*)Qb, (const bf16*)Kb, (const bf16*)Vb, Ob, a.in[16]);
        { NaiveG g{}; g.A = Ob; g.lda = D; g.W = l == 0 ? a.in[12] : a.in[17]; g.ldw = D; g.M = l == 0 ? NROWS : NLAT; g.N = D; g.K = D; g.mode = 1;
          g.base_lat = l == 0 ? a.in[0] : (const float*)d_out; g.base_ctx = a.in[2]; g.out_lat = (float*)d_out; g.out_ctx = (float*)(ws + WS_XC); g.g1 = mod + l * 5 * 6144 + 2 * 1024;
          hipLaunchKernelGGL(naive_gemm, dim3(NG), dim3(256), 0, stream, g); }
        run(l == 0 ? 5 : 13);
        run(l == 0 ? 6 : 14);
        { NaiveG g{}; g.A = HL; g.lda = D; g.rowidx = (const int*)(ws + WS_ROWIDX); g.W = a.in[19] + (size_t)l * 16 * 1024 * 2048; g.W2 = a.in[20] + (size_t)l * 16 * 1024 * 2048; g.ldw = FF; g.wstride_e = (size_t)1024 * 2048;
          g.M = NSLOT; g.N = FF; g.K = D; g.mode = 2; g.o0 = Hb;
          hipLaunchKernelGGL(naive_gemm, dim3(NG), dim3(256), 0, stream, g); }
        { NaiveG g{}; g.A = Hb; g.lda = FF; g.W = a.in[21] + (size_t)l * 16 * 2048 * 1024; g.ldw = D; g.wstride_e = (size_t)2048 * 1024;
          g.M = NSLOT; g.N = D; g.K = FF; g.mode = 3; g.o0 = Yb; g.gate = (const float*)(ws + WS_GATE);
          hipLaunchKernelGGL(naive_gemm, dim3(NG), dim3(256), 0, stream, g); }
        run(l == 0 ? 9 : 17);
    }
}
```

```cpp
#include <hip/hip_runtime.h>
#include <cstdio>
#include <cstdint>

#define LAS __attribute__((address_space(3)))
typedef unsigned short bf16;
typedef float f32x4 __attribute__((ext_vector_type(4)));
typedef unsigned u32x4 __attribute__((ext_vector_type(4)));
typedef unsigned u32x2 __attribute__((ext_vector_type(2)));
typedef short bf16x8 __attribute__((ext_vector_type(8)));

constexpr int D = 1024, NB = 4, S = 8192, CTX = 256, NLAT = NB * S, NCTX = NB * CTX, NROWS = NLAT + NCTX;
constexpr int NE = 16, FF = 2048, CAPL = 1024, CAPC = 32;
constexpr int SLOTS_E = 4352, NSLOT = NE * SLOTS_E;
constexpr int QKVA_N = 1536, QKVB_N = 3072;
constexpr float EPS = 1e-6f;
constexpr float LOG2E = 1.4426950408889634f;

constexpr size_t MiB = 1u << 20;
constexpr size_t WS_CTL = 0;
constexpr size_t WS_MOD = 1 * MiB;
constexpr size_t WS_ROPE = 1 * MiB + 512 * 1024;
constexpr size_t WS_AFF = 2 * MiB;
constexpr size_t WS_ROWIDX = 5 * MiB;
constexpr size_t WS_GATE = 5 * MiB + 512 * 1024;
constexpr size_t WS_INV = 6 * MiB;
constexpr size_t WS_XC = 9 * MiB;
constexpr size_t WS_WQKVA = 13 * MiB;
constexpr size_t WS_WOA = 16 * MiB;
constexpr size_t WS_WQKVB = 18 * MiB;
constexpr size_t WS_WOB = 24 * MiB;
constexpr size_t WS_WGU = 26 * MiB;
constexpr size_t WS_WD = 282 * MiB;
constexpr size_t WS_HL = 410 * MiB;
constexpr size_t WS_R1 = 476 * MiB;
constexpr size_t WS_Q = WS_R1, WS_K = WS_R1 + 66 * MiB, WS_V = WS_R1 + 132 * MiB, WS_O = WS_R1 + 198 * MiB;
constexpr size_t WS_H = WS_R1;
constexpr size_t WS_Y = 748 * MiB;
constexpr size_t WS_END = 884 * MiB;

#ifndef FAST_QKV
#define FAST_QKV 1
#endif
#ifndef FAST_OPROJ
#define FAST_OPROJ 1
#endif
#ifndef FAST_ATTN_A
#define FAST_ATTN_A 1
#endif
#ifndef FAST_ATTN_B
#define FAST_ATTN_B 1
#endif
#ifndef FAST_G1
#define FAST_G1 1
#endif
#ifndef FAST_G2
#define FAST_G2 1
#endif
constexpr int NWAVES = 8, NTHREADS = 512;
constexpr int LDS_BYTES = 163840;
constexpr int IDX_OFF = 131072 + 1024;
constexpr float QSCALE = 0.125f * 1.4426950408889634f;

__device__ __forceinline__ float bf2f(unsigned h) { return __uint_as_float(h << 16); }
__device__ __forceinline__ unsigned f2bf(float f) { unsigned u = __float_as_uint(f); return (u + 0x7fffu + ((u >> 16) & 1u)) >> 16; }
__device__ __forceinline__ unsigned pk2(float lo, float hi) { return f2bf(lo) | (f2bf(hi) << 16); }
__device__ __forceinline__ float wave_sum(float v) {
#pragma unroll
    for (int o = 32; o >= 1; o >>= 1) v += __shfl_xor(v, o);
    return v;
}
__device__ __forceinline__ float wave_max(float v) {
#pragma unroll
    for (int o = 32; o >= 1; o >>= 1) v = fmaxf(v, __shfl_xor(v, o));
    return v;
}
__device__ __forceinline__ int wave_sum_i(int v) {
#pragma unroll
    for (int o = 32; o >= 1; o >>= 1) v += __shfl_xor(v, o);
    return v;
}
__device__ __forceinline__ float silu_f(float x) { return x / (1.0f + expf(-x)); }

struct Args { const float* in[22]; float* out; unsigned char* ws; int ph_lo, ph_hi; };

__device__ __forceinline__ int qk_rowmap(int n) {
    const int hh = n >> 6, d = n & 63, pn = hh >> 2, wc = hh & 3, bj = d >> 5, dd = d & 31, nn = dd >> 4, fq = (dd & 15) >> 2, i = dd & 3;
    return 256 * pn + 128 * bj + 32 * wc + 8 * fq + 4 * nn + i;
}
__device__ __forceinline__ int conv_rowmap(int mode, int n) {
    switch (mode) {
        case 1: return 256 * (n >> 7) + (n & 127);
        case 2: return 256 * (n >> 7) + 128 + (n & 127);
        case 3: return n < 1280 ? qk_rowmap(n) : n;
        case 4: return n < 2048 ? qk_rowmap(n) : n;
        default: return n;
    }
}
__device__ __forceinline__ void conv_item(const float* __restrict__ W, int K, int N, bf16* __restrict__ Wt, int mode, int item, int lane) {
    const int nblk = N / 32, kb = item / nblk, nbk = item % nblk, k0 = 64 * kb, n0 = 32 * nbk;
    const int nq = lane & 7, kg = lane >> 3;
    f32x4 v[8];
#pragma unroll
    for (int i = 0; i < 8; ++i) v[i] = *(const f32x4*)(W + (size_t)(k0 + 8 * kg + i) * N + n0 + 4 * nq);
#pragma unroll
    for (int c = 0; c < 4; ++c) {
        u32x4 o; o.x = pk2(v[0][c], v[1][c]); o.y = pk2(v[2][c], v[3][c]); o.z = pk2(v[4][c], v[5][c]); o.w = pk2(v[6][c], v[7][c]);
        const int row = conv_rowmap(mode, n0 + 4 * nq + c);
        *(u32x4*)(Wt + (size_t)row * K + k0 + 8 * kg) = o;
    }
}
__device__ __forceinline__ void p0_phase(const Args& a, LAS unsigned char* lds) {
    const int tid = threadIdx.x, lane = tid & 63, wave = tid >> 6;
    unsigned char* ws = a.ws;
    if (blockIdx.x == 0) {
        float* rc = (float*)(ws + WS_ROPE); float* rs = rc + 128 * 16;
        for (int i = tid; i < 128 * 16; i += NTHREADS) { const int v = i >> 4, f = i & 15; const double inv = pow(10000.0, -(double)f / 16.0), ang = (double)v * inv; rc[i] = (float)cos(ang); rs[i] = (float)sin(ang); }
    }
    if (blockIdx.x == 1) {
        int* rowidx = (int*)(ws + WS_ROWIDX); float* gate = (float*)(ws + WS_GATE);
        for (int i = tid; i < NE * 128; i += NTHREADS) { const int e = i >> 7, p = i & 127; rowidx[e * SLOTS_E + 4224 + p] = 0; gate[e * SLOTS_E + 4224 + p] = 0.f; }
    }
    {
        LAS float* sc = (LAS float*)lds;
        LAS float* red = sc + 5 * 1024;
        bool have = false;
        for (int u = blockIdx.x; u < 192; u += gridDim.x) {
            if (!have) {
                for (int i = tid; i < 5 * 1024; i += NTHREADS) { const int r = i >> 10, k = i & 1023; const float cv = r < 4 ? a.in[1][r * 1024 + k] : a.in[3][k]; sc[i] = silu_f(cv); }
                __syncthreads(); have = true;
            }
            const int l = u / 96, cb = u % 96, col = cb * 64 + lane;
            const float* W = a.in[4] + (size_t)l * 1024 * 6144;
            float acc[5] = {0.f, 0.f, 0.f, 0.f, 0.f};
            for (int kk = 0; kk < 128; ++kk) { const int k = wave * 128 + kk; const float wv = W[(size_t)k * 6144 + col];
#pragma unroll
                for (int r = 0; r < 5; ++r) acc[r] += sc[r * 1024 + k] * wv; }
#pragma unroll
            for (int r = 0; r < 5; ++r) red[(wave * 5 + r) * 64 + lane] = acc[r];
            __syncthreads();
            if (tid < 320) { const int r = tid >> 6, ln = tid & 63; float s = 0.f;
#pragma unroll
                for (int w = 0; w < 8; ++w) s += red[(w * 5 + r) * 64 + ln];
                const int cc = cb * 64 + ln;
                ((float*)(ws + WS_MOD))[(l * 5 + r) * 6144 + cc] = s + a.in[5][l * 6144 + cc]; }
            __syncthreads();
        }
    }
    {
        const int gw = blockIdx.x * NWAVES + wave, NGW = gridDim.x * NWAVES;
        constexpr int I_QA = 16 * 48, I_O = 16 * 32, I_QB = 16 * 96, I_SMALL = I_QA + I_O + I_QB + I_O, I_TOT = I_SMALL + 96 * 1024;
        for (int it = gw; it < I_TOT; it += NGW) {
            int r = it;
            if (r < I_QA) { conv_item(a.in[8], 1024, QKVA_N, (bf16*)(ws + WS_WQKVA), 3, r, lane); continue; } r -= I_QA;
            if (r < I_O) { conv_item(a.in[12], 1024, 1024, (bf16*)(ws + WS_WOA), 0, r, lane); continue; } r -= I_O;
            if (r < I_QB) { conv_item(a.in[13], 1024, QKVB_N, (bf16*)(ws + WS_WQKVB), 4, r, lane); continue; } r -= I_QB;
            if (r < I_O) { conv_item(a.in[17], 1024, 1024, (bf16*)(ws + WS_WOB), 0, r, lane); continue; } r -= I_O;
            const int m = r >> 10, item = r & 1023, le = m / 3, which = m % 3;
            if (which == 0) conv_item(a.in[19] + (size_t)le * 1024 * 2048, 1024, 2048, (bf16*)(ws + WS_WGU) + (size_t)le * 4096 * 1024, 1, item, lane);
            else if (which == 1) conv_item(a.in[20] + (size_t)le * 1024 * 2048, 1024, 2048, (bf16*)(ws + WS_WGU) + (size_t)le * 4096 * 1024, 2, item, lane);
            else conv_item(a.in[21] + (size_t)le * 2048 * 1024, 2048, 1024, (bf16*)(ws + WS_WD) + (size_t)le * 1024 * 2048, 0, item, lane);
        }
    }
}

__device__ __forceinline__ void norm_mod(const f32x4 (&v)[4], f32x4 (&y)[4], const float* g, const float* sh, const float* sc, int lane) {
    float ss = 0.f;
#pragma unroll
    for (int j = 0; j < 4; ++j) ss += (v[j][0] * v[j][0] + v[j][1] * v[j][1]) + (v[j][2] * v[j][2] + v[j][3] * v[j][3]);
    ss = wave_sum(ss);
    const float rstd = 1.0f / sqrtf(ss * (1.0f / D) + EPS);
#pragma unroll
    for (int j = 0; j < 4; ++j) { const int col = 4 * lane + 256 * j; const f32x4 gg = *(const f32x4*)(g + col), s0 = *(const f32x4*)(sh + col), s1 = *(const f32x4*)(sc + col);
        y[j] = (v[j] * rstd * gg) * (1.0f + s1) + s0; }
}
__device__ __forceinline__ void store_bf16_row(bf16* orow, const f32x4 (&y)[4], int lane) {
#pragma unroll
    for (int j = 0; j < 4; ++j) { u32x2 w; w.x = pk2(y[j][0], y[j][1]); w.y = pk2(y[j][2], y[j][3]); *(u32x2*)(orow + 4 * lane + 256 * j) = w; }
}
__device__ __forceinline__ void norm1_l0_phase(const Args& a) {
    const int lane = threadIdx.x & 63, wave = threadIdx.x >> 6;
    const int gw = blockIdx.x * NWAVES + wave, NGW = gridDim.x * NWAVES;
    const float* mod = (const float*)(a.ws + WS_MOD); bf16* HL = (bf16*)(a.ws + WS_HL);
    for (int row = gw; row < NROWS; row += NGW) {
        const bool lat = row < NLAT; const int r = lat ? row / S : 4;
        const float* xr = lat ? a.in[0] + (size_t)row * D : a.in[2] + (size_t)(row - NLAT) * D;
        f32x4 v[4], y[4];
#pragma unroll
        for (int j = 0; j < 4; ++j) v[j] = *(const f32x4*)(xr + 4 * lane + 256 * j);
        const float* m = mod + (0 * 5 + r) * 6144;
        norm_mod(v, y, a.in[6], m, m + 1024, lane);
        store_bf16_row(HL + (size_t)row * D, y, lane);
    }
}
__device__ __forceinline__ void norm2_router_phase(const Args& a, int l, int nrows, LAS unsigned char* lds) {
    const int tid = threadIdx.x, lane = tid & 63, wave = tid >> 6;
    LAS float* wT = (LAS float*)lds;
    const float* wr = a.in[18] + (size_t)l * 1024 * 16;
    for (int i = tid; i < 16384; i += NTHREADS) { const int k = i >> 4, e = i & 15; wT[e * 1024 + k] = wr[i]; }
    __syncthreads();
    const float* mod = (const float*)(a.ws + WS_MOD); bf16* HL = (bf16*)(a.ws + WS_HL);
    const float* XC = (const float*)(a.ws + WS_XC); float* AFF = (float*)(a.ws + WS_AFF);
    const float* gn = a.in[7] + l * 1024;
    const int ngroups = nrows / 16;
    const int gw = blockIdx.x * NWAVES + wave, NGW = gridDim.x * NWAVES;
    for (int grp = gw; grp < ngroups; grp += NGW) {
        const int row0 = grp * 16; const bool lat = row0 < NLAT; const int b = lat ? row0 / S : (row0 - NLAT) / CTX, r = lat ? b : 4;
        const float* m = mod + (l * 5 + r) * 6144 + 3 * 1024;
        float mine[16];
#pragma unroll
        for (int e = 0; e < 16; ++e) mine[e] = 0.f;
        for (int i = 0; i < 16; ++i) {
            const int row = row0 + i;
            const float* xr = lat ? a.out + (size_t)row * D : XC + (size_t)(row - NLAT) * D;
            f32x4 v[4], y[4];
#pragma unroll
            for (int j = 0; j < 4; ++j) v[j] = *(const f32x4*)(xr + 4 * lane + 256 * j);
            norm_mod(v, y, gn, m, m + 1024, lane);
            store_bf16_row(HL + (size_t)row * D, y, lane);
            float lg[16]; float mx = -3.0e38f;
#pragma unroll
            for (int e = 0; e < 16; ++e) { float s = 0.f;
#pragma unroll
                for (int j = 0; j < 4; ++j) { const f32x4 w = *(const LAS f32x4*)(wT + e * 1024 + 4 * lane + 256 * j); s += (y[j][0] * w[0] + y[j][1] * w[1]) + (y[j][2] * w[2] + y[j][3] * w[3]); }
                lg[e] = wave_sum(s); mx = fmaxf(mx, lg[e]);
                if (e & 1) asm volatile("" ::: "memory"); }
            float den = 0.f;
#pragma unroll
            for (int e = 0; e < 16; ++e) { lg[e] = expf(lg[e] - mx); den += lg[e]; }
            const float rden = 1.0f / den;
#pragma unroll
            for (int e = 0; e < 16; ++e) if (lane == i) mine[e] = lg[e] * rden;
        }
        if (lane < 16) {
            if (lat) { const int s0 = row0 - b * S;
#pragma unroll
                for (int e = 0; e < 16; ++e) AFF[(size_t)(b * 16 + e) * S + s0 + lane] = mine[e]; }
            else { const int s0 = row0 - NLAT - b * CTX;
#pragma unroll
                for (int e = 0; e < 16; ++e) AFF[(size_t)64 * S + (size_t)(b * 16 + e) * CTX + s0 + lane] = mine[e]; }
        }
    }
}
__device__ __forceinline__ int block_sum_i(int v, LAS int* sm, int lane, int wave) {
    v = wave_sum_i(v);
    if (lane == 0) sm[wave] = v;
    __syncthreads();
    int t = 0;
#pragma unroll
    for (int w = 0; w < NWAVES; ++w) t += sm[w];
    __syncthreads();
    return t;
}
__device__ __forceinline__ void select_phase(const Args& a, int npairs, LAS unsigned char* lds) {
    const int tid = threadIdx.x, lane = tid & 63, wave = tid >> 6;
    LAS int* sm = (LAS int*)lds;
    const float* AFF = (const float*)(a.ws + WS_AFF);
    int* ROWIDX = (int*)(a.ws + WS_ROWIDX); float* GATE = (float*)(a.ws + WS_GATE); int* INV = (int*)(a.ws + WS_INV);
    for (int p = blockIdx.x; p < npairs; p += gridDim.x) {
        const bool lat = p < 64; const int pp = lat ? p : p - 64, b = pp >> 4, e = pp & 15;
        const int n = lat ? S : CTX, cap = lat ? CAPL : CAPC;
        const float* aff = lat ? AFF + (size_t)pp * S : AFF + (size_t)64 * S + (size_t)pp * CTX;
        const int slot_base = lat ? e * SLOTS_E + b * CAPL : e * SLOTS_E + 4096 + b * CAPC;
        const int row_base = lat ? b * S : NLAT + b * CTX;
        unsigned key[16]; const int base = tid * 16;
        if (base < n) {
#pragma unroll
            for (int j = 0; j < 4; ++j) { const f32x4 t = *(const f32x4*)(aff + base + 4 * j); key[4 * j] = __float_as_uint(t[0]); key[4 * j + 1] = __float_as_uint(t[1]); key[4 * j + 2] = __float_as_uint(t[2]); key[4 * j + 3] = __float_as_uint(t[3]); }
        } else {
#pragma unroll
            for (int j = 0; j < 16; ++j) key[j] = 0u;
        }
        unsigned T = 0u;
        for (int bit = 30; bit >= 0; --bit) {
            const unsigned cand = T | (1u << bit); int cnt = 0;
#pragma unroll
            for (int j = 0; j < 16; ++j) cnt += (key[j] >= cand) ? 1 : 0;
            const int tot = block_sum_i(cnt, sm, lane, wave);
            if (tot >= cap) T = cand;
        }
        int cgt = 0, ceq = 0;
#pragma unroll
        for (int j = 0; j < 16; ++j) { cgt += (key[j] > T) ? 1 : 0; ceq += (key[j] == T) ? 1 : 0; }
        int igt = cgt, ieq = ceq;
#pragma unroll
        for (int o = 1; o < 64; o <<= 1) { const int t1 = __shfl_up(igt, o), t2 = __shfl_up(ieq, o); if (lane >= o) { igt += t1; ieq += t2; } }
        if (lane == 63) { sm[16 + wave] = igt; sm[32 + wave] = ieq; }
        __syncthreads();
        int pgt = igt - cgt, peq = ieq - ceq, totgt = 0;
#pragma unroll
        for (int w = 0; w < NWAVES; ++w) { const int g = sm[16 + w], q = sm[32 + w]; if (w < wave) { pgt += g; peq += q; } totgt += g; }
        __syncthreads();
        const int need = cap - totgt;
        if (base < n) {
            int g = pgt, q = peq;
#pragma unroll
            for (int j = 0; j < 16; ++j) {
                const unsigned k = key[j]; const int row = row_base + base + j;
                const bool sel = (k > T) || (k == T && q < need);
                int slot = -1;
                if (sel) { slot = slot_base + g + (q < need ? q : need); ROWIDX[slot] = row; GATE[slot] = __uint_as_float(k); }
                INV[(size_t)row * 16 + e] = slot;
                g += (k > T) ? 1 : 0; q += (k == T) ? 1 : 0;
            }
        }
    }
}
__device__ __forceinline__ void combine_phase(const Args& a, int l) {
    const int lane = threadIdx.x & 63, wave = threadIdx.x >> 6;
    const int gw = blockIdx.x * NWAVES + wave, NGW = gridDim.x * NWAVES;
    const float* mod = (const float*)(a.ws + WS_MOD); bf16* HL = (bf16*)(a.ws + WS_HL);
    const float* XC = (const float*)(a.ws + WS_XC); const int* INV = (const int*)(a.ws + WS_INV); const bf16* Y = (const bf16*)(a.ws + WS_Y);
    const int nrows = (l == 0) ? NROWS : NLAT;
    for (int row = gw; row < nrows; row += NGW) {
        const bool lat = row < NLAT; const int r = lat ? row / S : 4;
        const int inv = (lane < 16) ? INV[(size_t)row * 16 + lane] : -1;
        float* xr = lat ? a.out + (size_t)row * D : (float*)XC + (size_t)(row - NLAT) * D;
        f32x4 v[4], acc[4];
#pragma unroll
        for (int j = 0; j < 4; ++j) { v[j] = *(const f32x4*)(xr + 4 * lane + 256 * j); acc[j] = (f32x4){0.f, 0.f, 0.f, 0.f}; }
        for (int e = 0; e < 16; ++e) {
            const int s = __shfl(inv, e);
            if (s >= 0) {
                const bf16* yr = Y + (size_t)s * D;
#pragma unroll
                for (int j = 0; j < 4; ++j) { const u32x2 w = *(const u32x2*)(yr + 4 * lane + 256 * j);
                    acc[j][0] += bf2f(w.x & 0xffffu); acc[j][1] += bf2f(w.x >> 16); acc[j][2] += bf2f(w.y & 0xffffu); acc[j][3] += bf2f(w.y >> 16); }
            }
        }
        const float* g2 = mod + (l * 5 + r) * 6144 + 5 * 1024;
#pragma unroll
        for (int j = 0; j < 4; ++j) { const f32x4 gg = *(const f32x4*)(g2 + 4 * lane + 256 * j); v[j] = v[j] + gg * acc[j]; }
        if (lat) {
#pragma unroll
            for (int j = 0; j < 4; ++j) *(f32x4*)(xr + 4 * lane + 256 * j) = v[j];
        }
        if (l == 0) {
            f32x4 y[4]; const float* m = mod + (1 * 5 + r) * 6144;
            norm_mod(v, y, a.in[6] + 1024, m, m + 1024, lane);
            store_bf16_row(HL + (size_t)row * D, y, lane);
        }
    }
}


namespace pg8 {
constexpr int BM = 256, BK = 64, HALF = 128, HTB = HALF * BK * 2, STAGE_BYTES = 8 * HTB, NXCD = 8, WGM = 8;
__host__ __device__ __forceinline__ int lds_byte(int r, int c) { const int st = (r >> 4) * 2 + (c >> 5), rr = r & 15, cc = c & 31, ob = rr * 64 + cc * 2; return st * 1024 + (ob ^ (((ob >> 9) & 1) << 5)); }
__host__ __device__ __forceinline__ void stage_rc(int b, int& R, int& C) { const int st = b / 1024, sb = b % 1024, swz = sb ^ (((sb >> 9) & 1) << 5); R = (st >> 1) * 16 + swz / 64; C = (st & 1) * 32 + (swz % 64) / 2; }
__host__ __device__ __forceinline__ int perm32(int rho) { const int n = rho >> 4, i = rho & 15; return 8 * (i >> 2) + 4 * n + (i & 3); }
struct Unit { int pm, pn; };
struct Sched {
    int nM, nN, nwg, G, c, mpe;
    const char* Bt; size_t b_estride, b_tstride;
    __device__ __forceinline__ void init(int nM_, int nN_, int G_, int c_, int mpe_, const void* Bt_, size_t es, size_t ts) { nM = nM_; nN = nN_; nwg = nM * nN; G = G_; c = c_; mpe = mpe_; Bt = (const char*)Bt_; b_estride = es; b_tstride = ts; }
    __device__ __forceinline__ bool next(int i, Unit& u) const {
        const long L = (long)i * G + c; if (L >= nwg) return false;
        int wgid = (int)L; { const int q = nwg / NXCD, r = nwg % NXCD, xcd = wgid % NXCD, off = wgid / NXCD; wgid = (xcd < r ? xcd * (q + 1) : r * (q + 1) + (xcd - r) * q) + off; }
        const int nig = WGM * nN, gid = wgid / nig, fm = gid * WGM, gsz = (nM - fm) < WGM ? (nM - fm) : WGM;
        int pm = fm + ((wgid % nig) % gsz); u.pn = (wgid % nig) / gsz;
        if (mpe) { const int e = pm / mpe; pm = e * 17 + (pm - e * mpe); }
        u.pm = pm; return true;
    }
    __device__ __forceinline__ const char* b_base(const Unit& u) const { const int e = mpe ? u.pm / 17 : 0; return Bt + (size_t)e * b_estride + (size_t)u.pn * b_tstride; }
};
__device__ __forceinline__ unsigned cvt_pk_bf16(float lo, float hi) { unsigned r; asm volatile("v_cvt_pk_bf16_f32 %0, %1, %2" : "=v"(r) : "v"(lo), "v"(hi)); return r; }

struct EpiQKV {
    static constexpr bool PERM = true;
    bf16* Q; bf16* Kb; bf16* Vb; int kvw, nqt, nkt; const float* qg; const float* kg; const float* ropet; int rope; float qscale;
    __device__ __forceinline__ void operator()(const f32x4 (&acc)[2][2][4][2], const Unit& u, int wr, int wc, int fr, int fq) const {
        const int row0 = u.pm * BM + wr * 64 + fr;
        if (u.pn >= nqt + nkt) {
            const int colt = (u.pn - nqt - nkt) * BM + wc * 32 + 8 * fq;
#pragma unroll
            for (int ai = 0; ai < 2; ++ai)
#pragma unroll
                for (int m = 0; m < 4; ++m) { bf16* rowp = Vb + (size_t)(row0 + ai * HALF + m * 16) * kvw + colt;
#pragma unroll
                    for (int bj = 0; bj < 2; ++bj) { const f32x4 v0 = acc[ai][bj][m][0], v1 = acc[ai][bj][m][1]; u32x4 w; w.x = cvt_pk_bf16(v0[0], v0[1]); w.y = cvt_pk_bf16(v0[2], v0[3]); w.z = cvt_pk_bf16(v1[0], v1[1]); w.w = cvt_pk_bf16(v1[2], v1[3]);
                        *(u32x4*)(rowp + bj * HALF) = w; } }
            return;
        }
        const bool isq = u.pn < nqt; const int head = isq ? 4 * u.pn + wc : 4 * (u.pn - nqt) + wc;
        const float* gain = isq ? qg : kg; const float scale = isq ? qscale : 1.0f;
        bf16* dst = (isq ? Q : Kb) + head * 64 + 4 * fq; const int ld = isq ? 1024 : kvw;
        f32x4 gv[2][2];
#pragma unroll
        for (int bj = 0; bj < 2; ++bj)
#pragma unroll
            for (int n = 0; n < 2; ++n) gv[bj][n] = *(const f32x4*)(gain + 32 * bj + 16 * n + 4 * fq);
        const bool dorope = rope && (u.pm < NLAT / BM);
#pragma unroll
        for (int ai = 0; ai < 2; ++ai)
#pragma unroll
            for (int m = 0; m < 4; ++m) {
                const int row = row0 + ai * HALF + m * 16;
                float ss = 0.f;
#pragma unroll
                for (int bj = 0; bj < 2; ++bj)
#pragma unroll
                    for (int n = 0; n < 2; ++n) { const f32x4 x = acc[ai][bj][m][n]; ss += (x[0] * x[0] + x[1] * x[1]) + (x[2] * x[2] + x[3] * x[3]); }
                ss += __shfl_xor(ss, 16); ss += __shfl_xor(ss, 32);
                const float rstd = scale / sqrtf(ss * (1.0f / 64.0f) + EPS);
                f32x4 y[2][2];
#pragma unroll
                for (int bj = 0; bj < 2; ++bj)
#pragma unroll
                    for (int n = 0; n < 2; ++n) y[bj][n] = acc[ai][bj][m][n] * rstd * gv[bj][n];
                if (dorope) { const int pos = row & (S - 1);
#pragma unroll
                    for (int bj = 0; bj < 2; ++bj) { const int v = bj == 0 ? (pos >> 6) : (pos & 63); const f32x4 cs = *(const f32x4*)(ropet + v * 16 + 4 * fq), sn = *(const f32x4*)(ropet + 2048 + v * 16 + 4 * fq);
                        const f32x4 a0 = y[bj][0], a1 = y[bj][1]; y[bj][0] = a0 * cs - a1 * sn; y[bj][1] = a0 * sn + a1 * cs; } }
                bf16* rowp = dst + (size_t)row * ld;
#pragma unroll
                for (int bj = 0; bj < 2; ++bj)
#pragma unroll
                    for (int n = 0; n < 2; ++n) { u32x2 w; w.x = cvt_pk_bf16(y[bj][n][0], y[bj][n][1]); w.y = cvt_pk_bf16(y[bj][n][2], y[bj][n][3]); *(u32x2*)(rowp + 32 * bj + 16 * n) = w; }
            }
    }
};
struct EpiOproj {
    static constexpr bool PERM = false;
    const float* base_lat; const float* base_ctx; float* out_lat; float* out_ctx; const float* g1;
    __device__ __forceinline__ void operator()(const f32x4 (&acc)[2][2][4][2], const Unit& u, int wr, int wc, int fr, int fq) const {
        const bool lat = u.pm < NLAT / BM; const int r = lat ? (u.pm >> 5) : 4;
        const int col0 = u.pn * BM + wc * 32 + 4 * fq;
        const int row0 = (lat ? u.pm * BM : u.pm * BM - NLAT) + wr * 64 + fr;
        const float* bs = lat ? base_lat : base_ctx; float* os = lat ? out_lat : out_ctx;
        f32x4 gv[2][2];
#pragma unroll
        for (int bj = 0; bj < 2; ++bj)
#pragma unroll
            for (int n = 0; n < 2; ++n) gv[bj][n] = *(const f32x4*)(g1 + r * 6144 + col0 + bj * HALF + n * 16);
#pragma unroll
        for (int ai = 0; ai < 2; ++ai)
#pragma unroll
            for (int m = 0; m < 4; ++m) { const size_t off = (size_t)(row0 + ai * HALF + m * 16) * D + col0;
#pragma unroll
                for (int bj = 0; bj < 2; ++bj)
#pragma unroll
                    for (int n = 0; n < 2; ++n) { const f32x4 b = *(const f32x4*)(bs + off + bj * HALF + n * 16); *(f32x4*)(os + off + bj * HALF + n * 16) = b + gv[bj][n] * acc[ai][bj][m][n]; }
                if (m & 1) asm volatile("" ::: "memory"); }
    }
};
__device__ __forceinline__ float silu_fast(float x) { return x * __builtin_amdgcn_rcpf(1.0f + __expf(-x)); }
struct EpiGU {
    static constexpr bool PERM = true;
    bf16* H;
    __device__ __forceinline__ void operator()(const f32x4 (&acc)[2][2][4][2], const Unit& u, int wr, int wc, int fr, int fq) const {
        const int row0 = u.pm * BM + wr * 64 + fr, col0 = u.pn * HALF + wc * 32 + 8 * fq;
#pragma unroll
        for (int ai = 0; ai < 2; ++ai)
#pragma unroll
            for (int m = 0; m < 4; ++m) { const f32x4 g0 = acc[ai][0][m][0], g1 = acc[ai][0][m][1], u0 = acc[ai][1][m][0], u1 = acc[ai][1][m][1];
                u32x4 w; w.x = cvt_pk_bf16(silu_fast(g0[0]) * u0[0], silu_fast(g0[1]) * u0[1]); w.y = cvt_pk_bf16(silu_fast(g0[2]) * u0[2], silu_fast(g0[3]) * u0[3]);
                w.z = cvt_pk_bf16(silu_fast(g1[0]) * u1[0], silu_fast(g1[1]) * u1[1]); w.w = cvt_pk_bf16(silu_fast(g1[2]) * u1[2], silu_fast(g1[3]) * u1[3]);
                *(u32x4*)(H + (size_t)(row0 + ai * HALF + m * 16) * FF + col0) = w; }
    }
};
struct EpiDown {
    static constexpr bool PERM = true;
    bf16* Y; const float* gate;
    __device__ __forceinline__ void operator()(const f32x4 (&acc)[2][2][4][2], const Unit& u, int wr, int wc, int fr, int fq) const {
        const int row0 = u.pm * BM + wr * 64 + fr, col0 = u.pn * BM + wc * 32 + 8 * fq;
#pragma unroll
        for (int ai = 0; ai < 2; ++ai)
#pragma unroll
            for (int m = 0; m < 4; ++m) { const int row = row0 + ai * HALF + m * 16; const float gt = gate[row];
#pragma unroll
                for (int bj = 0; bj < 2; ++bj) { const f32x4 v0 = acc[ai][bj][m][0] * gt, v1 = acc[ai][bj][m][1] * gt; u32x4 w; w.x = cvt_pk_bf16(v0[0], v0[1]); w.y = cvt_pk_bf16(v0[2], v0[3]); w.z = cvt_pk_bf16(v1[0], v1[1]); w.w = cvt_pk_bf16(v1[2], v1[3]);
                    *(u32x4*)(Y + (size_t)row * D + col0 + bj * HALF) = w; } }
    }
};

template <class Epi, bool GATHER>
__device__ __forceinline__ void gemm_phase(LAS unsigned char* lds, const char* Abase, int K, const Sched& S, const Epi& E, LAS int* ldsidx, const int* rowidx) {
    const int tid = threadIdx.x, wid = __builtin_amdgcn_readfirstlane(tid >> 6), lane = tid & 63, wr = wid >> 2, wc = wid & 3, fr = lane & 15, fq = lane >> 4;
    const int nt = K / BK;
    int Rst[2], Cst[2]; unsigned voffB[2];
#pragma unroll
    for (int i = 0; i < 2; ++i) { int R, C; stage_rc(tid * 16 + i * 8192, R, C); Rst[i] = R; Cst[i] = C; const int Rb = Epi::PERM ? ((R & ~31) + perm32(R & 31)) : R; voffB[i] = (unsigned)(Rb * K + C) * 2u; }
    const size_t kstep = (size_t)(BK * 2);
    const size_t hstep = (size_t)HALF * K * 2;
    const unsigned ldsw = (unsigned)wid * 1024u;
    const int aoff = lds_byte(wr * 64 + fr, fq * 8), boff = lds_byte(wc * 32 + fr, fq * 8);
    Unit cur, nxt; int ui = 0;
    if (!S.next(0, cur)) return;
    if (GATHER) {
        Unit t_; for (int i = 0; S.next(i, t_); ++i) if (tid < 256) ldsidx[i * 256 + tid] = rowidx[t_.pm * 256 + tid];
        __syncthreads();
    }
#define PG8_SA(b, h) (((b) * 2 + (h)) * HTB)
#define PG8_SB(b, h) ((4 + (b) * 2 + (h)) * HTB)
#define PG8_STAGE(bufoff, gbase, voff) do { _Pragma("unroll") for (int _i = 0; _i < 2; ++_i) \
        __builtin_amdgcn_global_load_lds((const unsigned*)((const char*)(gbase) + (voff)[_i]), (LAS unsigned*)(lds + (bufoff) + ldsw + _i * 8192), 16, 0, 0); } while (0)
#define PG8_AOFF(vo, u_, ui_) do { _Pragma("unroll") for (int _h = 0; _h < 2; ++_h) _Pragma("unroll") for (int _i = 0; _i < 2; ++_i) { \
        const int _row = GATHER ? ldsidx[(ui_) * 256 + _h * HALF + Rst[_i]] : (u_).pm * BM + _h * HALF + Rst[_i]; vo[_h][_i] = (unsigned)(_row * K + Cst[_i]) * 2u; } } while (0)
#define PG8_LDA(dst, b, h) do { _Pragma("unroll") for (int m = 0; m < 4; ++m) _Pragma("unroll") for (int k = 0; k < 2; ++k) dst[m][k] = *(const LAS bf16x8*)(lds + PG8_SA(b, h) + aoff + m * 2048 + k * 1024); } while (0)
#define PG8_LDB(dst, b, h) do { _Pragma("unroll") for (int n = 0; n < 2; ++n) _Pragma("unroll") for (int k = 0; k < 2; ++k) dst[n][k] = *(const LAS bf16x8*)(lds + PG8_SB(b, h) + boff + n * 2048 + k * 1024); } while (0)
#define PG8_MMA(ai, bj, At, Bt) do { __builtin_amdgcn_s_setprio(1); _Pragma("unroll") for (int m = 0; m < 4; ++m) _Pragma("unroll") for (int n = 0; n < 2; ++n) _Pragma("unroll") for (int k = 0; k < 2; ++k) \
        acc[ai][bj][m][n] = __builtin_amdgcn_mfma_f32_16x16x32_bf16(Bt[n][k], At[m][k], acc[ai][bj][m][n], 0, 0, 0); __builtin_amdgcn_s_setprio(0); } while (0)
#define PG8_WAIT_V(n) asm volatile("s_waitcnt vmcnt(" #n ")" ::: "memory")
#define PG8_WAIT_L(n) asm volatile("s_waitcnt lgkmcnt(" #n ")" ::: "memory")
#define PG8_BAR __builtin_amdgcn_s_barrier()
#define PG8_SCHED __builtin_amdgcn_sched_barrier(0)
    f32x4 acc[2][2][4][2];
#pragma unroll
    for (int a = 0; a < 2; ++a)
#pragma unroll
        for (int b = 0; b < 2; ++b)
#pragma unroll
            for (int m = 0; m < 4; ++m)
#pragma unroll
                for (int n = 0; n < 2; ++n) acc[a][b][m][n] = (f32x4){0.f, 0.f, 0.f, 0.f};
    bf16x8 At[4][2], B0[2][2], B1[2][2];
    unsigned voC[2][2], voN[2][2];
    PG8_AOFF(voC, cur, 0);
    const char* cB = S.b_base(cur);
    PG8_STAGE(PG8_SB(0, 0), cB, voffB); PG8_STAGE(PG8_SB(0, 1), cB + hstep, voffB); PG8_STAGE(PG8_SA(0, 0), Abase, voC[0]); PG8_STAGE(PG8_SA(0, 1), Abase, voC[1]);
    if (wr == 1) PG8_BAR;
    PG8_WAIT_V(2); PG8_BAR;
    PG8_STAGE(PG8_SB(1, 0), cB + kstep, voffB); PG8_STAGE(PG8_SA(1, 0), Abase + kstep, voC[0]); PG8_STAGE(PG8_SB(1, 1), cB + hstep + kstep, voffB);
    PG8_WAIT_V(6); PG8_BAR;
    for (;;) {
        const bool has_next = S.next(ui + 1, nxt);
        if (has_next) { PG8_AOFF(voN, nxt, ui + 1); }
        else {
#pragma unroll
            for (int h = 0; h < 2; ++h)
#pragma unroll
                for (int i = 0; i < 2; ++i) voN[h][i] = voC[h][i]; }
        const char* nB = has_next ? S.b_base(nxt) : cB;
        for (int t = 0; t < nt; t += 2) {
            const bool last = (t == nt - 2);
            const char* kA1 = Abase + (size_t)(t + 1) * kstep;
            const char* kA2 = last ? Abase : Abase + (size_t)(t + 2) * kstep; const char* kA3 = kA2 + kstep;
            const char* b2 = last ? nB : cB + (size_t)(t + 2) * kstep; const char* b3 = b2 + kstep;
            unsigned o2[2][2];
#pragma unroll
            for (int h = 0; h < 2; ++h)
#pragma unroll
                for (int i = 0; i < 2; ++i) o2[h][i] = last ? voN[h][i] : voC[h][i];
            PG8_LDB(B0, 0, 0); PG8_LDB(B1, 0, 1); PG8_SCHED; PG8_LDA(At, 0, 0); PG8_STAGE(PG8_SA(1, 1), kA1, voC[1]);
            PG8_WAIT_V(8); PG8_WAIT_L(0); PG8_BAR; PG8_MMA(0, 0, At, B0); PG8_MMA(0, 1, At, B1); PG8_BAR; PG8_SCHED;
            PG8_LDA(At, 0, 1); PG8_STAGE(PG8_SB(0, 0), b2, voffB); PG8_STAGE(PG8_SB(0, 1), b2 + hstep, voffB); PG8_STAGE(PG8_SA(0, 0), kA2, o2[0]);
            PG8_WAIT_V(8); PG8_WAIT_L(0); PG8_BAR; PG8_MMA(1, 0, At, B0); PG8_MMA(1, 1, At, B1); PG8_BAR; PG8_SCHED;
            PG8_LDB(B0, 1, 0); PG8_LDB(B1, 1, 1); PG8_SCHED; PG8_LDA(At, 1, 0); PG8_STAGE(PG8_SA(0, 1), kA2, o2[1]);
            PG8_WAIT_V(8); PG8_WAIT_L(0); PG8_BAR; PG8_MMA(0, 0, At, B0); PG8_MMA(0, 1, At, B1); PG8_BAR; PG8_SCHED;
            PG8_LDA(At, 1, 1); PG8_STAGE(PG8_SB(1, 0), b3, voffB); PG8_STAGE(PG8_SB(1, 1), b3 + hstep, voffB); PG8_STAGE(PG8_SA(1, 0), kA3, o2[0]);
            PG8_WAIT_V(8); PG8_WAIT_L(0); PG8_BAR; PG8_MMA(1, 0, At, B0); PG8_MMA(1, 1, At, B1); PG8_BAR; PG8_SCHED;
        }
        if (wr == 0) PG8_BAR;
        E(acc, cur, wr, wc, fr, fq);
        if (!has_next) break;
#pragma unroll
        for (int a = 0; a < 2; ++a)
#pragma unroll
            for (int b = 0; b < 2; ++b)
#pragma unroll
                for (int m = 0; m < 4; ++m)
#pragma unroll
                    for (int n = 0; n < 2; ++n) acc[a][b][m][n] = (f32x4){0.f, 0.f, 0.f, 0.f};
        cur = nxt; cB = nB; ++ui;
#pragma unroll
        for (int h = 0; h < 2; ++h)
#pragma unroll
            for (int i = 0; i < 2; ++i) voC[h][i] = voN[h][i];
        if (wr == 1) PG8_BAR;
    }
    PG8_WAIT_V(0);
    PG8_BAR;
#undef PG8_SA
#undef PG8_SB
#undef PG8_STAGE
#undef PG8_AOFF
#undef PG8_LDA
#undef PG8_LDB
#undef PG8_MMA
#undef PG8_WAIT_V
#undef PG8_WAIT_L
#undef PG8_BAR
#undef PG8_SCHED
}
}


namespace att {
typedef float f32x16 __attribute__((ext_vector_type(16)));
typedef short s16x4 __attribute__((ext_vector_type(4)));
constexpr int TILEB = 8192, OFF_K = 0, OFF_V = 2 * TILEB, OFF_BIAS = 4 * TILEB, BIAS_PITCH = 160, BIAS_ORG = 64;
constexpr float NEG = -1e30f;
__device__ __forceinline__ int crow(int r, int h) { return (r & 3) + 8 * (r >> 2) + 4 * h; }
__device__ __forceinline__ void stage_tile(LAS unsigned char* lds, int buf, const bf16* kbase, const bf16* vbase, int ld, int tid, int wave) {
    const int row = tid >> 3, ch = tid & 7;
    const bf16* ks = kbase + (size_t)row * ld + ((ch ^ ((row >> 1) & 7)) << 3);
    const bf16* vs = vbase + (size_t)row * ld + ((ch ^ (((row >> 1) & 1) << 2)) << 3);
    __builtin_amdgcn_global_load_lds((const unsigned*)ks, (LAS unsigned*)(lds + OFF_K + buf * TILEB + wave * 1024), 16, 0, 0);
    __builtin_amdgcn_global_load_lds((const unsigned*)vs, (LAS unsigned*)(lds + OFF_V + buf * TILEB + wave * 1024), 16, 0, 0);
}
struct WaveCtx { int koff[4]; int vl[2]; bf16x8 qf[4]; f32x16 o[2]; float m, l; };
__device__ __forceinline__ void wave_init(WaveCtx& c, int lane, const bf16* qrow  , float m0, float l0) {
    const int r31 = lane & 31, h = lane >> 5;
#pragma unroll
    for (int ds = 0; ds < 4; ++ds) c.koff[ds] = r31 * 128 + (((2 * ds + h) ^ ((r31 >> 1) & 7)) << 4);
    const int i = lane & 15, qp = i >> 2, pp = i & 3, cb = (lane >> 4) & 1;
#pragma unroll
    for (int db = 0; db < 2; ++db) c.vl[db] = (4 * h + qp) * 128 + ((db ^ ((qp >> 1) & 1)) << 6) + 32 * cb + 8 * pp;
#pragma unroll
    for (int ds = 0; ds < 4; ++ds) c.qf[ds] = *(const bf16x8*)(qrow + 16 * ds + 8 * h);
#pragma unroll
    for (int r = 0; r < 16; ++r) { c.o[0][r] = 0.f; c.o[1][r] = 0.f; }
    c.m = m0; c.l = (h == 0) ? l0 : 0.f;
}
__device__ __forceinline__ void qk(const WaveCtx& c, f32x16& p0, f32x16& p1, const LAS unsigned char* kb) {
#pragma unroll
    for (int r = 0; r < 16; ++r) { p0[r] = 0.f; p1[r] = 0.f; }
#pragma unroll
    for (int ds = 0; ds < 4; ++ds) {
        const bf16x8 a0 = *(const LAS bf16x8*)(kb + c.koff[ds]), a1 = *(const LAS bf16x8*)(kb + 4096 + c.koff[ds]);
        p0 = __builtin_amdgcn_mfma_f32_32x32x16_bf16(a0, c.qf[ds], p0, 0, 0, 0);
        p1 = __builtin_amdgcn_mfma_f32_32x32x16_bf16(a1, c.qf[ds], p1, 0, 0, 0);
    }
}
typedef short v4i16_t __attribute__((ext_vector_type(4)));
__device__ __forceinline__ s16x4 vtr(const LAS unsigned char* p) { return __builtin_bit_cast(s16x4, __builtin_amdgcn_ds_read_tr16_b64_v4i16((LAS v4i16_t*)p)); }
__device__ __forceinline__ unsigned cvtpk(float lo, float hi) { unsigned r; asm("v_cvt_pk_bf16_f32 %0, %1, %2" : "=v"(r) : "v"(lo), "v"(hi)); return r; }
__device__ __forceinline__ void softmax_pv(WaveCtx& c, f32x16& p0, f32x16& p1, const LAS unsigned char* vb) {
    float mx = fmaxf(p0[0], p1[0]);
#pragma unroll
    for (int r = 1; r < 16; ++r) mx = fmaxf(mx, fmaxf(p0[r], p1[r]));
    mx = fmaxf(mx, __shfl_xor(mx, 32));
    const float mn = fmaxf(c.m, mx), alpha = __builtin_amdgcn_exp2f(c.m - mn);
    c.m = mn;
    float ls = 0.f;
#pragma unroll
    for (int r = 0; r < 16; ++r) { p0[r] = __builtin_amdgcn_exp2f(p0[r] - mn); p1[r] = __builtin_amdgcn_exp2f(p1[r] - mn); ls += p0[r] + p1[r]; }
    c.l = c.l * alpha + ls;
#pragma unroll
    for (int r = 0; r < 16; ++r) { c.o[0][r] *= alpha; c.o[1][r] *= alpha; }
    bf16x8 pf[2][2];
#pragma unroll
    for (int s = 0; s < 2; ++s) {
        u32x4 w0, w1;
        w0.x = cvtpk(p0[8 * s], p0[8 * s + 1]); w0.y = cvtpk(p0[8 * s + 2], p0[8 * s + 3]); w0.z = cvtpk(p0[8 * s + 4], p0[8 * s + 5]); w0.w = cvtpk(p0[8 * s + 6], p0[8 * s + 7]);
        w1.x = cvtpk(p1[8 * s], p1[8 * s + 1]); w1.y = cvtpk(p1[8 * s + 2], p1[8 * s + 3]); w1.z = cvtpk(p1[8 * s + 4], p1[8 * s + 5]); w1.w = cvtpk(p1[8 * s + 6], p1[8 * s + 7]);
        pf[0][s] = __builtin_bit_cast(bf16x8, w0); pf[1][s] = __builtin_bit_cast(bf16x8, w1);
    }
#pragma unroll
    for (int db = 0; db < 2; ++db)
#pragma unroll
        for (int kb = 0; kb < 2; ++kb)
#pragma unroll
            for (int s = 0; s < 2; ++s) {
                const LAS unsigned char* p = vb + c.vl[db] + kb * 4096 + s * 2048;
                const s16x4 lo = vtr(p), hi = vtr(p + 1024);
                const bf16x8 vf = (bf16x8){lo[0], lo[1], lo[2], lo[3], hi[0], hi[1], hi[2], hi[3]};
                c.o[db] = __builtin_amdgcn_mfma_f32_32x32x16_bf16(vf, pf[kb][s], c.o[db], 0, 0, 0);
            }
}
__device__ __forceinline__ void wave_store(const WaveCtx& c, int lane, bf16* orow  ) {
    const int h = lane >> 5;
    const float lt = c.l + __shfl_xor(c.l, 32), rl = 1.0f / lt;
#pragma unroll
    for (int db = 0; db < 2; ++db)
#pragma unroll
        for (int g = 0; g < 4; ++g) { u32x2 w; w.x = cvtpk(c.o[db][4 * g] * rl, c.o[db][4 * g + 1] * rl); w.y = cvtpk(c.o[db][4 * g + 2] * rl, c.o[db][4 * g + 3] * rl);
            *(u32x2*)(orow + 32 * db + 8 * g + 4 * h) = w; }
}
#define ATT_WAIT_BAR() do { asm volatile("s_waitcnt vmcnt(0)" ::: "memory"); __syncthreads(); } while (0)

__device__ __forceinline__ void attn_a_unit(LAS unsigned char* lds, int u, const bf16* Q, const bf16* Kt, const bf16* Vt, bf16* O, const float* sink) {
    const int tid = threadIdx.x, lane = tid & 63, wave = __builtin_amdgcn_readfirstlane(tid >> 6);
    const int g = wave >> 1, qs = wave & 1;
    int b, kvh, Q0, qrow0, nl, tl0;
    if (u < 2048) { b = u >> 9; kvh = (u >> 7) & 3; const int hb = u & 127; Q0 = hb * 64; qrow0 = b * S + Q0;
        tl0 = Q0 >= 128 ? 0 : (128 - Q0) / 64; const int tl1 = (S - 64 - (Q0 - 128)) / 64 < 4 ? (S - 64 - (Q0 - 128)) / 64 : 4; nl = tl1 - tl0 + 1; }
    else { const int v = u - 2048; b = v >> 4; kvh = (v >> 2) & 3; Q0 = 0; qrow0 = NLAT + b * CTX + (v & 3) * 64; nl = 0; tl0 = 0; }
    const int head = kvh * 4 + g, nt = nl + 4;
    const int myrow = qrow0 + 32 * qs + (lane & 31);
    WaveCtx c; wave_init(c, lane, Q + (size_t)myrow * 1024 + head * 64, sink[head] * LOG2E, 1.0f);
    const int qq = 32 * qs + (lane & 31), h = lane >> 5;
#define ATT_A_ROWBASE(j) ((j) < nl ? b * S + Q0 - 128 + 64 * (tl0 + (j)) : NLAT + b * CTX + 64 * ((j) - nl))
    { const int rb = ATT_A_ROWBASE(0); stage_tile(lds, 0, Kt + (size_t)rb * 256 + kvh * 64, Vt + (size_t)rb * 256 + kvh * 64, 256, tid, wave); }
    for (int j = 0; j < nt; ++j) {
        ATT_WAIT_BAR();
        if (j + 1 < nt) { const int rb = ATT_A_ROWBASE(j + 1); stage_tile(lds, (j + 1) & 1, Kt + (size_t)rb * 256 + kvh * 64, Vt + (size_t)rb * 256 + kvh * 64, 256, tid, wave); }
        f32x16 p0, p1;
        qk(c, p0, p1, lds + OFF_K + (j & 1) * TILEB);
        if (j < nl) { const int tt = tl0 + j;
            if (tt == 0) {
#pragma unroll
                for (int r = 0; r < 16; ++r) { const int kk = crow(r, h); if (kk < qq) p0[r] = NEG; if (kk + 32 < qq) p1[r] = NEG; } }
            if (tt == 4) {
#pragma unroll
                for (int r = 0; r < 16; ++r) { const int kk = crow(r, h); if (kk > qq) p0[r] = NEG; if (kk + 32 > qq) p1[r] = NEG; } }
        }
        softmax_pv(c, p0, p1, lds + OFF_V + (j & 1) * TILEB);
    }
#undef ATT_A_ROWBASE
    wave_store(c, lane, O + (size_t)myrow * 1024 + head * 64);
    __syncthreads();
}
__device__ __forceinline__ void attn_b_unit(LAS unsigned char* lds, int u, const bf16* Q, const bf16* Kt, const bf16* Vt, bf16* O, const float* rpb) {
    const int tid = threadIdx.x, lane = tid & 63, wave = __builtin_amdgcn_readfirstlane(tid >> 6);
    const int b = u >> 9, head = (u >> 5) & 15, r0 = (u & 31) * 4;
    const int rq = r0 + (wave >> 1), a = wave & 1, h = lane >> 5;
    const int klo = min(max(r0 - 4, 0), 120), khi = min(max(r0 - 1, 0), 120) + 7, nt = 4 + (khi - klo + 1);
    const int rs = min(max(rq - 4, 0), 120);
    LAS float* bt = (LAS float*)(lds + OFF_BIAS);
    for (int i = tid; i < 15 * 31; i += NTHREADS) { const int dr = i / 31, dc = i - dr * 31; bt[dr * BIAS_PITCH + BIAS_ORG + dc] = rpb[(head * 15 + dr) * 31 + dc] * LOG2E; }
    const int myrow = b * S + rq * 64 + 32 * a + (lane & 31);
    WaveCtx c; wave_init(c, lane, Q + (size_t)myrow * 1024 + head * 64, NEG, 0.0f);
    const int qc = 32 * a + (lane & 31), wst = min(max(qc - 8, 0), 48);
#define ATT_B_ROWBASE(j) ((j) < 4 ? NLAT + b * CTX + 64 * (j) : b * S + (klo + (j) - 4) * 64)
    { const int rb = ATT_B_ROWBASE(0); stage_tile(lds, 0, Kt + (size_t)rb * 1024 + head * 64, Vt + (size_t)rb * 1024 + head * 64, 1024, tid, wave); }
    for (int j = 0; j < nt; ++j) {
        ATT_WAIT_BAR();
        if (j + 1 < nt) { const int rb = ATT_B_ROWBASE(j + 1); stage_tile(lds, (j + 1) & 1, Kt + (size_t)rb * 1024 + head * 64, Vt + (size_t)rb * 1024 + head * 64, 1024, tid, wave); }
        const int kr = klo + j - 4;
        if (j < 4 || (kr >= rs && kr <= rs + 7)) {
            f32x16 p0, p1;
            qk(c, p0, p1, lds + OFF_K + (j & 1) * TILEB);
            if (j >= 4) {
                const LAS float* brow = bt + (kr - rq + 7) * BIAS_PITCH + BIAS_ORG + 15 - qc + 4 * h;
#pragma unroll
                for (int r = 0; r < 16; ++r) { const int kc = crow(r, h), ko = (r & 3) + 8 * (r >> 2);
                    const float b0 = brow[ko], b1 = brow[ko + 32];
                    p0[r] = (kc >= wst && kc < wst + 16) ? p0[r] + b0 : NEG;
                    p1[r] = (kc + 32 >= wst && kc + 32 < wst + 16) ? p1[r] + b1 : NEG; }
            }
            softmax_pv(c, p0, p1, lds + OFF_V + (j & 1) * TILEB);
        }
    }
#undef ATT_B_ROWBASE
    wave_store(c, lane, O + (size_t)myrow * 1024 + head * 64);
    __syncthreads();
}
}

__global__ void __launch_bounds__(NTHREADS, 2) mega(Args a) {
    extern __shared__ __attribute__((aligned(16))) unsigned char lds_raw[];
    LAS unsigned char* lds = (LAS unsigned char*)lds_raw;
    const int lo = a.ph_lo, hi = a.ph_hi;
#define IN(k) (lo <= (k) && (k) < hi)
    unsigned char* ws = a.ws;
    const float* mod = (const float*)(ws + WS_MOD);
    LAS int* ldsidx = (LAS int*)(lds + IDX_OFF);
    const int G = gridDim.x, bx = blockIdx.x;
    if (IN(0)) p0_phase(a, lds);
    if (IN(1)) norm1_l0_phase(a);
    if (IN(2)) {
        pg8::Sched Sc; Sc.init(NROWS / 256, QKVA_N / 256, G, bx, 0, ws + WS_WQKVA, 0, (size_t)256 * 1024 * 2);
        pg8::EpiQKV E{(bf16*)(ws + WS_Q), (bf16*)(ws + WS_K), (bf16*)(ws + WS_V), 256, 4, 1, a.in[9], a.in[10], (const float*)(ws + WS_ROPE), 1, QSCALE};
        pg8::gemm_phase<pg8::EpiQKV, false>(lds, (const char*)(ws + WS_HL), 1024, Sc, E, ldsidx, nullptr);
    }
    if (IN(3)) {
        const int vcu = (G % 8 == 0) ? (bx % 8) * (G / 8) + bx / 8 : bx;
        for (int u = vcu * 8; u < 2048; u += G * 8) for (int k = 0; k < 8; ++k) att::attn_a_unit(lds, u + k, (const bf16*)(ws + WS_Q), (const bf16*)(ws + WS_K), (const bf16*)(ws + WS_V), (bf16*)(ws + WS_O), a.in[11]);
        for (int u = 2048 + vcu; u < 2112; u += G) att::attn_a_unit(lds, u, (const bf16*)(ws + WS_Q), (const bf16*)(ws + WS_K), (const bf16*)(ws + WS_V), (bf16*)(ws + WS_O), a.in[11]);
    }
    if (IN(4)) {
        pg8::Sched Sc; Sc.init(NROWS / 256, 4, G, bx, 0, ws + WS_WOA, 0, (size_t)256 * 1024 * 2);
        pg8::EpiOproj E{a.in[0], a.in[2], a.out, (float*)(ws + WS_XC), mod + 0 * 5 * 6144 + 2 * 1024};
        pg8::gemm_phase<pg8::EpiOproj, false>(lds, (const char*)(ws + WS_O), 1024, Sc, E, ldsidx, nullptr);
    }
    if (IN(5)) norm2_router_phase(a, 0, NROWS, lds);
    if (IN(6)) select_phase(a, 128, lds);
    if (IN(7)) {
        pg8::Sched Sc; Sc.init(272, 16, G, bx, 17, ws + WS_WGU, (size_t)4096 * 1024 * 2, (size_t)256 * 1024 * 2);
        pg8::EpiGU E{(bf16*)(ws + WS_H)};
        pg8::gemm_phase<pg8::EpiGU, true>(lds, (const char*)(ws + WS_HL), 1024, Sc, E, ldsidx, (const int*)(ws + WS_ROWIDX));
    }
    if (IN(8)) {
        pg8::Sched Sc; Sc.init(272, 4, G, bx, 17, ws + WS_WD, (size_t)1024 * 2048 * 2, (size_t)256 * 2048 * 2);
        pg8::EpiDown E{(bf16*)(ws + WS_Y), (const float*)(ws + WS_GATE)};
        pg8::gemm_phase<pg8::EpiDown, false>(lds, (const char*)(ws + WS_H), 2048, Sc, E, ldsidx, nullptr);
    }
    if (IN(9)) combine_phase(a, 0);
    if (IN(10)) {
        pg8::Sched Sc; Sc.init(NROWS / 256, QKVB_N / 256, G, bx, 0, ws + WS_WQKVB, 0, (size_t)256 * 1024 * 2);
        pg8::EpiQKV E{(bf16*)(ws + WS_Q), (bf16*)(ws + WS_K), (bf16*)(ws + WS_V), 1024, 4, 4, a.in[14], a.in[15], (const float*)(ws + WS_ROPE), 0, QSCALE};
        pg8::gemm_phase<pg8::EpiQKV, false>(lds, (const char*)(ws + WS_HL), 1024, Sc, E, ldsidx, nullptr);
    }
    if (IN(11)) {
        const int vcu = (G % 8 == 0) ? (bx % 8) * (G / 8) + bx / 8 : bx;
        for (int u = vcu * 8; u < 2048; u += G * 8) for (int k = 0; k < 8; ++k) att::attn_b_unit(lds, u + k, (const bf16*)(ws + WS_Q), (const bf16*)(ws + WS_K), (const bf16*)(ws + WS_V), (bf16*)(ws + WS_O), a.in[16]);
    }
    if (IN(12)) {
        pg8::Sched Sc; Sc.init(NLAT / 256, 4, G, bx, 0, ws + WS_WOB, 0, (size_t)256 * 1024 * 2);
        pg8::EpiOproj E{a.out, a.in[2], a.out, (float*)(ws + WS_XC), mod + 1 * 5 * 6144 + 2 * 1024};
        pg8::gemm_phase<pg8::EpiOproj, false>(lds, (const char*)(ws + WS_O), 1024, Sc, E, ldsidx, nullptr);
    }
    if (IN(13)) norm2_router_phase(a, 1, NLAT, lds);
    if (IN(14)) select_phase(a, 64, lds);
    if (IN(15)) {
        pg8::Sched Sc; Sc.init(256, 16, G, bx, 16, ws + WS_WGU + (size_t)16 * 4096 * 1024 * 2, (size_t)4096 * 1024 * 2, (size_t)256 * 1024 * 2);
        pg8::EpiGU E{(bf16*)(ws + WS_H)};
        pg8::gemm_phase<pg8::EpiGU, true>(lds, (const char*)(ws + WS_HL), 1024, Sc, E, ldsidx, (const int*)(ws + WS_ROWIDX));
    }
    if (IN(16)) {
        pg8::Sched Sc; Sc.init(256, 4, G, bx, 16, ws + WS_WD + (size_t)16 * 1024 * 2048 * 2, (size_t)1024 * 2048 * 2, (size_t)256 * 2048 * 2);
        pg8::EpiDown E{(bf16*)(ws + WS_Y), (const float*)(ws + WS_GATE)};
        pg8::gemm_phase<pg8::EpiDown, false>(lds, (const char*)(ws + WS_H), 2048, Sc, E, ldsidx, nullptr);
    }
    if (IN(17)) combine_phase(a, 1);
#undef IN
}

struct NaiveG {
    const bf16* A; int lda; const int* rowidx;
    const float* W; const float* W2; int ldw; size_t wstride_e;
    int M, N, K, mode;
    bf16* o0; bf16* o1; bf16* o2; int kvw;
    const float* base_lat; const float* base_ctx; float* out_lat; float* out_ctx; const float* g1;
    const float* gate;
};
__global__ void __launch_bounds__(256) naive_gemm(NaiveG g) {
    const int lane = threadIdx.x & 63, wave = threadIdx.x >> 6;
    const int tiles_n = g.N / 64; const long ntiles = (long)(g.M / 32) * tiles_n;
    const int fr = lane & 15, fq = lane >> 4;
    for (long wt = (long)blockIdx.x * 4 + wave; wt < ntiles; wt += (long)gridDim.x * 4) {
        const int tm = (int)(wt / tiles_n), tn = (int)(wt % tiles_n), r0 = tm * 32, c0 = tn * 64;
        const int e = g.wstride_e ? r0 / SLOTS_E : 0;
        const float* W = g.W + (size_t)e * g.wstride_e; const float* W2 = g.W2 ? g.W2 + (size_t)e * g.wstride_e : nullptr;
        const bf16* arow[2];
#pragma unroll
        for (int mi = 0; mi < 2; ++mi) { const int m = r0 + 16 * mi + fr; const int ar = g.rowidx ? g.rowidx[m] : m; arow[mi] = g.A + (size_t)ar * g.lda + 8 * fq; }
        f32x4 acc[2][4], acc2[2][4];
#pragma unroll
        for (int mi = 0; mi < 2; ++mi)
#pragma unroll
            for (int ni = 0; ni < 4; ++ni) { acc[mi][ni] = (f32x4){0.f, 0.f, 0.f, 0.f}; acc2[mi][ni] = (f32x4){0.f, 0.f, 0.f, 0.f}; }
        for (int k0 = 0; k0 < g.K; k0 += 32) {
            bf16x8 af[2];
#pragma unroll
            for (int mi = 0; mi < 2; ++mi) af[mi] = *(const bf16x8*)(arow[mi] + k0);
#pragma unroll
            for (int ni = 0; ni < 4; ++ni) {
                const float* wp = W + (size_t)(k0 + 8 * fq) * g.ldw + c0 + 16 * ni + fr;
                bf16x8 bfr;
#pragma unroll
                for (int j = 0; j < 8; ++j) bfr[j] = (short)f2bf(wp[(size_t)j * g.ldw]);
#pragma unroll
                for (int mi = 0; mi < 2; ++mi) acc[mi][ni] = __builtin_amdgcn_mfma_f32_16x16x32_bf16(af[mi], bfr, acc[mi][ni], 0, 0, 0);
                if (W2) {
                    const float* wp2 = W2 + (size_t)(k0 + 8 * fq) * g.ldw + c0 + 16 * ni + fr;
#pragma unroll
                    for (int j = 0; j < 8; ++j) bfr[j] = (short)f2bf(wp2[(size_t)j * g.ldw]);
#pragma unroll
                    for (int mi = 0; mi < 2; ++mi) acc2[mi][ni] = __builtin_amdgcn_mfma_f32_16x16x32_bf16(af[mi], bfr, acc2[mi][ni], 0, 0, 0);
                }
            }
        }
#pragma unroll
        for (int mi = 0; mi < 2; ++mi)
#pragma unroll
            for (int ni = 0; ni < 4; ++ni)
#pragma unroll
                for (int i = 0; i < 4; ++i) {
                    const int row = r0 + 16 * mi + 4 * fq + i, col = c0 + 16 * ni + fr; const float v = acc[mi][ni][i];
                    if (g.mode == 0) {
                        const int nq = 1024;
                        if (col < nq) g.o0[(size_t)row * 1024 + col] = (bf16)f2bf(v);
                        else if (col < nq + g.kvw) g.o1[(size_t)row * g.kvw + col - nq] = (bf16)f2bf(v);
                        else g.o2[(size_t)row * g.kvw + col - nq - g.kvw] = (bf16)f2bf(v);
                    } else if (g.mode == 1) {
                        const bool lat = row < NLAT; const int r = lat ? row / S : 4;
                        const size_t off = lat ? (size_t)row * D + col : (size_t)(row - NLAT) * D + col;
                        const float bs = lat ? g.base_lat[off] : g.base_ctx[off];
                        (lat ? g.out_lat : g.out_ctx)[off] = bs + g.g1[r * 6144 + col] * v;
                    } else if (g.mode == 2) {
                        const float u = acc2[mi][ni][i]; g.o0[(size_t)row * FF + col] = (bf16)f2bf(silu_f(v) * u);
                    } else {
                        g.o0[(size_t)row * D + col] = (bf16)f2bf(v * g.gate[row]);
                    }
                }
    }
}
__global__ void __launch_bounds__(256) naive_qknorm(bf16* Q, bf16* Kb, int kvw, const float* qg, const float* kg, const float* ropet, int rope) {
    const int lane = threadIdx.x & 63, wave = threadIdx.x >> 6;
    const int nkh = kvw / 64;
    for (int row = blockIdx.x * 4 + wave; row < NROWS; row += gridDim.x * 4) {
        const bool lat = row < NLAT; const int pos = row % S;
        for (int h = 0; h < 16 + nkh; ++h) {
            bf16* p = h < 16 ? Q + (size_t)row * 1024 + h * 64 + lane : Kb + (size_t)row * kvw + (h - 16) * 64 + lane;
            const float x = bf2f(*p);
            const float ss = wave_sum(x * x);
            float y = x * (1.0f / sqrtf(ss * (1.0f / 64.0f) + EPS)) * (h < 16 ? qg[lane] : kg[lane]);
            if (rope && lat) {
                const int half = lane >> 5, dd = lane & 31, f = dd & 15; const int v = half == 0 ? pos / 64 : pos % 64;
                const float cs = ropet[v * 16 + f], sn = ropet[128 * 16 + v * 16 + f];
                const float other = __shfl_xor(y, 16);
                y = (dd < 16) ? y * cs - other * sn : other * sn + y * cs;
            }
            *p = (bf16)f2bf(y);
        }
    }
}
__global__ void __launch_bounds__(256) naive_attn_a(const bf16* Q, const bf16* Kb, const bf16* Vb, bf16* O, const float* sink, float sscale) {
    const int lane = threadIdx.x & 63, wave = threadIdx.x >> 6;
    const long total = (long)NROWS * 16;
    for (long gw = (long)blockIdx.x * 4 + wave; gw < total; gw += (long)gridDim.x * 4) {
        const int row = (int)(gw >> 4), head = (int)(gw & 15), kvh = head >> 2;
        const bool lat = row < NLAT; const int b = lat ? row / S : (row - NLAT) / CTX, pos = row % S;
        float q[64];
#pragma unroll
        for (int c = 0; c < 8; ++c) { const u32x4 w = *(const u32x4*)(Q + (size_t)row * 1024 + head * 64 + 8 * c);
            q[8 * c] = bf2f(w.x & 0xffffu); q[8 * c + 1] = bf2f(w.x >> 16); q[8 * c + 2] = bf2f(w.y & 0xffffu); q[8 * c + 3] = bf2f(w.y >> 16);
            q[8 * c + 4] = bf2f(w.z & 0xffffu); q[8 * c + 5] = bf2f(w.z >> 16); q[8 * c + 6] = bf2f(w.w & 0xffffu); q[8 * c + 7] = bf2f(w.w >> 16); }
        const int klo = lat ? max(pos - 128, 0) : 0, khi = lat ? min(pos + 128, S - 1) : -1;
        float sc[9]; int krow[9];
        const float sk = sink[head];
        float mx = sk;
#pragma unroll
        for (int t = 0; t < 9; ++t) {
            int kr; bool valid;
            if (t < 5) { const int kp = klo + 64 * t + lane; valid = kp <= khi; kr = b * S + kp; }
            else { valid = true; kr = NLAT + b * CTX + 64 * (t - 5) + lane; }
            krow[t] = valid ? kr : -1; float s = -1e30f;
            if (valid) { const bf16* kp_ = Kb + (size_t)kr * 256 + kvh * 64; float d = 0.f;
#pragma unroll
                for (int c = 0; c < 8; ++c) { const u32x4 w = *(const u32x4*)(kp_ + 8 * c);
                    d += q[8 * c] * bf2f(w.x & 0xffffu) + q[8 * c + 1] * bf2f(w.x >> 16) + q[8 * c + 2] * bf2f(w.y & 0xffffu) + q[8 * c + 3] * bf2f(w.y >> 16)
                       + q[8 * c + 4] * bf2f(w.z & 0xffffu) + q[8 * c + 5] * bf2f(w.z >> 16) + q[8 * c + 6] * bf2f(w.w & 0xffffu) + q[8 * c + 7] * bf2f(w.w >> 16); }
                s = d * sscale; }
            sc[t] = s; mx = fmaxf(mx, s);
        }
        mx = wave_max(mx);
        float den = 0.f;
#pragma unroll
        for (int t = 0; t < 9; ++t) { sc[t] = krow[t] >= 0 ? expf(sc[t] - mx) : 0.f; den += sc[t]; }
        den = wave_sum(den) + expf(sk - mx);
        float o = 0.f;
#pragma unroll
        for (int t = 0; t < 9; ++t)
            for (int j = 0; j < 64; ++j) { const int kr = __shfl(krow[t], j); const float p = __shfl(sc[t], j); if (kr >= 0) o += p * bf2f(Vb[(size_t)kr * 256 + kvh * 64 + lane]); }
        O[(size_t)row * 1024 + head * 64 + lane] = (bf16)f2bf(o / den);
    }
}
__global__ void __launch_bounds__(256) naive_attn_b(const bf16* Q, const bf16* Kb, const bf16* Vb, bf16* O, const float* rpb, float sscale) {
    const int lane = threadIdx.x & 63, wave = threadIdx.x >> 6;
    const long total = (long)NLAT * 16;
    for (long gw = (long)blockIdx.x * 4 + wave; gw < total; gw += (long)gridDim.x * 4) {
        const int row = (int)(gw >> 4), head = (int)(gw & 15);
        const int b = row / S, pos = row % S, r = pos / 64, c = pos % 64;
        const int rs = min(max(r - 4, 0), 120), wst = min(max(c - 8, 0), 48);
        float q[64];
#pragma unroll
        for (int cc = 0; cc < 8; ++cc) { const u32x4 w = *(const u32x4*)(Q + (size_t)row * 1024 + head * 64 + 8 * cc);
            q[8 * cc] = bf2f(w.x & 0xffffu); q[8 * cc + 1] = bf2f(w.x >> 16); q[8 * cc + 2] = bf2f(w.y & 0xffffu); q[8 * cc + 3] = bf2f(w.y >> 16);
            q[8 * cc + 4] = bf2f(w.z & 0xffffu); q[8 * cc + 5] = bf2f(w.z >> 16); q[8 * cc + 6] = bf2f(w.w & 0xffffu); q[8 * cc + 7] = bf2f(w.w >> 16); }
        float sc[6]; int krow[6]; float mx = -1e30f;
#pragma unroll
        for (int t = 0; t < 6; ++t) {
            int kr; float bias = 0.f;
            if (t < 2) { const int j = 64 * t + lane, krr = rs + (j >> 4), kc = wst + (j & 15); kr = b * S + krr * 64 + kc; bias = rpb[(head * 15 + (krr - r + 7)) * 31 + (kc - c + 15)]; }
            else kr = NLAT + b * CTX + 64 * (t - 2) + lane;
            krow[t] = kr;
            const bf16* kp_ = Kb + (size_t)kr * 1024 + head * 64; float d = 0.f;
#pragma unroll
            for (int cc = 0; cc < 8; ++cc) { const u32x4 w = *(const u32x4*)(kp_ + 8 * cc);
                d += q[8 * cc] * bf2f(w.x & 0xffffu) + q[8 * cc + 1] * bf2f(w.x >> 16) + q[8 * cc + 2] * bf2f(w.y & 0xffffu) + q[8 * cc + 3] * bf2f(w.y >> 16)
                   + q[8 * cc + 4] * bf2f(w.z & 0xffffu) + q[8 * cc + 5] * bf2f(w.z >> 16) + q[8 * cc + 6] * bf2f(w.w & 0xffffu) + q[8 * cc + 7] * bf2f(w.w >> 16); }
            sc[t] = d * sscale + bias; mx = fmaxf(mx, sc[t]);
        }
        mx = wave_max(mx);
        float den = 0.f;
#pragma unroll
        for (int t = 0; t < 6; ++t) { sc[t] = expf(sc[t] - mx); den += sc[t]; }
        den = wave_sum(den);
        float o = 0.f;
#pragma unroll
        for (int t = 0; t < 6; ++t)
            for (int j = 0; j < 64; ++j) { const int kr = __shfl(krow[t], j); const float p = __shfl(sc[t], j); o += p * bf2f(Vb[(size_t)kr * 1024 + head * 64 + lane]); }
        O[(size_t)row * 1024 + head * 64 + lane] = (bf16)f2bf(o / den);
    }
}

extern "C" void kernel_launch(void* const* d_in, const int* in_sizes, int n_in, void* d_out, int out_size, void* d_ws, size_t ws_size, hipStream_t stream) {
    static int grid = 0;
    if (grid == 0) {
        if (n_in != 22 || out_size != NLAT * D || ws_size < WS_END) { fprintf(stderr, "kernel_launch: unexpected shapes n_in %d out %d ws %zu\n", n_in, out_size, ws_size); grid = -1; return; }
        int dev = 0, cus = 0, per_cu = 0;
        hipGetDevice(&dev); hipDeviceGetAttribute(&cus, hipDeviceAttributeMultiprocessorCount, dev);
        hipFuncSetAttribute((const void*)mega, hipFuncAttributeMaxDynamicSharedMemorySize, LDS_BYTES);
        hipOccupancyMaxActiveBlocksPerMultiprocessor(&per_cu, (const void*)mega, NTHREADS, LDS_BYTES);
        (void)hipGetLastError();
        if (per_cu < 1) fprintf(stderr, "kernel_launch: occupancy query says %d blocks/CU\n", per_cu);
        grid = cus;
    }
    if (grid < 0) return;
    unsigned char* ws = (unsigned char*)d_ws;
    hipMemsetAsync(ws + WS_CTL, 0, 1 * MiB, stream);
    Args a{};
    for (int i = 0; i < 22; ++i) a.in[i] = (const float*)d_in[i];
    a.out = (float*)d_out; a.ws = ws;
    auto run = [&](int p) { a.ph_lo = p; a.ph_hi = p + 1; hipLaunchKernelGGL(mega, dim3(grid), dim3(NTHREADS), LDS_BYTES, stream, a); };
    const float* mod = (const float*)(ws + WS_MOD);
    bf16* HL = (bf16*)(ws + WS_HL); bf16* Qb = (bf16*)(ws + WS_Q); bf16* Kb = (bf16*)(ws + WS_K); bf16* Vb = (bf16*)(ws + WS_V); bf16* Ob = (bf16*)(ws + WS_O);
    bf16* Hb = (bf16*)(ws + WS_H); bf16* Yb = (bf16*)(ws + WS_Y);
    const int NG = 2048;
    run(0); run(1);
    for (int l = 0; l < 2; ++l) {
#if FAST_QKV
        run(l == 0 ? 2 : 10);
        const float sscale = 1.0f / LOG2E;
#else
        { NaiveG g{}; g.A = HL; g.lda = D; g.W = l == 0 ? a.in[8] : a.in[13]; g.ldw = l == 0 ? QKVA_N : QKVB_N; g.M = NROWS; g.N = g.ldw; g.K = D; g.mode = 0;
          g.o0 = Qb; g.o1 = Kb; g.o2 = Vb; g.kvw = l == 0 ? 256 : 1024;
          hipLaunchKernelGGL(naive_gemm, dim3(NG), dim3(256), 0, stream, g); }
        hipLaunchKernelGGL(naive_qknorm, dim3(NG), dim3(256), 0, stream, Qb, Kb, l == 0 ? 256 : 1024, l == 0 ? a.in[9] : a.in[14], l == 0 ? a.in[10] : a.in[15], (const float*)(ws + WS_ROPE), l == 0 ? 1 : 0);
        const float sscale = 0.125f;
#endif
#if FAST_ATTN_A
        if (l == 0) run(3);
#else
        if (l == 0) hipLaunchKernelGGL(naive_attn_a, dim3(NG), dim3(256), 0, stream, (const bf16*)Qb, (const bf16*)Kb, (const bf16*)Vb, Ob, a.in[11], sscale);
#endif
#if FAST_ATTN_B
        if (l == 1) run(11);
#else
        if (l == 1) hipLaunchKernelGGL(naive_attn_b, dim3(NG), dim3(256), 0, stream, (const bf16*)Qb, (const bf16*)Kb, (const bf16*)Vb, Ob, a.in[16], sscale);
#endif
#if FAST_OPROJ
        run(l == 0 ? 4 : 12);
#else
        { NaiveG g{}; g.A = Ob; g.lda = D; g.W = l == 0 ? a.in[12] : a.in[17]; g.ldw = D; g.M = l == 0 ? NROWS : NLAT; g.N = D; g.K = D; g.mode = 1;
          g.base_lat = l == 0 ? a.in[0] : (const float*)d_out; g.base_ctx = a.in[2]; g.out_lat = (float*)d_out; g.out_ctx = (float*)(ws + WS_XC); g.g1 = mod + l * 5 * 6144 + 2 * 1024;
          hipLaunchKernelGGL(naive_gemm, dim3(NG), dim3(256), 0, stream, g); }
#endif
        run(l == 0 ? 5 : 13);
        run(l == 0 ? 6 : 14);
#if FAST_G1
        run(l == 0 ? 7 : 15);
#else
        { NaiveG g{}; g.A = HL; g.lda = D; g.rowidx = (const int*)(ws + WS_ROWIDX); g.W = a.in[19] + (size_t)l * 16 * 1024 * 2048; g.W2 = a.in[20] + (size_t)l * 16 * 1024 * 2048; g.ldw = FF; g.wstride_e = (size_t)1024 * 2048;
          g.M = NSLOT; g.N = FF; g.K = D; g.mode = 2; g.o0 = Hb;
          hipLaunchKernelGGL(naive_gemm, dim3(NG), dim3(256), 0, stream, g); }
#endif
#if FAST_G2
        run(l == 0 ? 8 : 16);
#else
        { NaiveG g{}; g.A = Hb; g.lda = FF; g.W = a.in[21] + (size_t)l * 16 * 2048 * 1024; g.ldw = D; g.wstride_e = (size_t)2048 * 1024;
          g.M = NSLOT; g.N = D; g.K = FF; g.mode = 3; g.o0 = Yb; g.gate = (const float*)(ws + WS_GATE);
          hipLaunchKernelGGL(naive_gemm, dim3(NG), dim3(256), 0, stream, g); }
#endif
        run(l == 0 ? 9 : 17);
    }
}
```

```cpp
#include <hip/hip_runtime.h>
#include <cstdio>
#include <cstdint>

#define LAS __attribute__((address_space(3)))
typedef unsigned short bf16;
typedef float f32x4 __attribute__((ext_vector_type(4)));
typedef unsigned u32x4 __attribute__((ext_vector_type(4)));
typedef unsigned u32x2 __attribute__((ext_vector_type(2)));
typedef short bf16x8 __attribute__((ext_vector_type(8)));

constexpr int D = 1024, NB = 4, S = 8192, CTX = 256, NLAT = NB * S, NCTX = NB * CTX, NROWS = NLAT + NCTX;
constexpr int NE = 16, FF = 2048, CAPL = 1024, CAPC = 32;
constexpr int SLOTS_E = 4352, NSLOT = NE * SLOTS_E;
constexpr int QKVA_N = 1536, QKVB_N = 3072;
constexpr float EPS = 1e-6f;
constexpr float LOG2E = 1.4426950408889634f;

constexpr size_t MiB = 1u << 20;
constexpr size_t WS_CTL = 0;
constexpr size_t WS_MOD = 1 * MiB;
constexpr size_t WS_ROPE = 1 * MiB + 512 * 1024;
constexpr size_t WS_AFF = 2 * MiB;
constexpr size_t WS_ROWIDX = 5 * MiB;
constexpr size_t WS_GATE = 5 * MiB + 512 * 1024;
constexpr size_t WS_INV = 6 * MiB;
constexpr size_t WS_XC = 9 * MiB;
constexpr size_t WS_WQKVA = 13 * MiB;
constexpr size_t WS_WOA = 16 * MiB;
constexpr size_t WS_WQKVB = 18 * MiB;
constexpr size_t WS_WOB = 24 * MiB;
constexpr size_t WS_WGU = 26 * MiB;
constexpr size_t WS_WD = 282 * MiB;
constexpr size_t WS_HL = 410 * MiB;
constexpr size_t WS_R1 = 476 * MiB;
constexpr size_t WS_Q = WS_R1, WS_K = WS_R1 + 66 * MiB, WS_V = WS_R1 + 132 * MiB, WS_O = WS_R1 + 198 * MiB;
constexpr size_t WS_H = WS_R1;
constexpr size_t WS_Y = 748 * MiB;
constexpr size_t WS_END = 884 * MiB;

#ifndef FAST_QKV
#define FAST_QKV 1
#endif
#ifndef FAST_OPROJ
#define FAST_OPROJ 1
#endif
#ifndef PROBE_MASK
#define PROBE_MASK 0
#endif
#ifndef PROBE_GEMM
#define PROBE_GEMM -1
#endif
#ifndef PROBE_REPH
#define PROBE_REPH 4
#endif
#define GREPH(k) ((k) == PROBE_GEMM ? PROBE_REPH : 2)
#define NREP(k) (((PROBE_MASK >> (k)) & 1) ? 2 : 1)
#ifndef FP8_DOWN
#define FP8_DOWN 1
#endif
#ifndef FP8_Y
#define FP8_Y 1
#endif
constexpr float Y8_SCALE = 32.0f;
#ifndef FP8_O
#define FP8_O 1
#endif
constexpr float O8_SCALE = 16.0f;
#ifndef FP8_GU
#define FP8_GU 1
#endif
constexpr float W8_SCALE = 32.0f, W8_INV = 1.0f / 32.0f;
#ifndef ONE_LAUNCH
#define ONE_LAUNCH 1
#endif
#ifndef FAST_ATTN_A
#define FAST_ATTN_A 1
#endif
#ifndef FAST_ATTN_B
#define FAST_ATTN_B 1
#endif
#ifndef FAST_G1
#define FAST_G1 1
#endif
#ifndef FAST_G2
#define FAST_G2 1
#endif
constexpr int NWAVES = 8, NTHREADS = 512;
constexpr int LDS_BYTES = 163840;
constexpr int IDX_OFF = 131072 + 1024;
constexpr float QSCALE = 0.125f * 1.4426950408889634f;

__device__ __forceinline__ float bf2f(unsigned h) { return __uint_as_float(h << 16); }
__device__ __forceinline__ unsigned f2bf(float f) { unsigned u = __float_as_uint(f); return (u + 0x7fffu + ((u >> 16) & 1u)) >> 16; }
__device__ __forceinline__ unsigned pk2(float lo, float hi) { return f2bf(lo) | (f2bf(hi) << 16); }
__device__ __forceinline__ float wave_sum(float v) {
#pragma unroll
    for (int o = 32; o >= 1; o >>= 1) v += __shfl_xor(v, o);
    return v;
}
__device__ __forceinline__ float wave_max(float v) {
#pragma unroll
    for (int o = 32; o >= 1; o >>= 1) v = fmaxf(v, __shfl_xor(v, o));
    return v;
}
__device__ __forceinline__ int wave_sum_i(int v) {
#pragma unroll
    for (int o = 32; o >= 1; o >>= 1) v += __shfl_xor(v, o);
    return v;
}
__device__ __forceinline__ int lane_now() { int l; asm volatile("v_mbcnt_lo_u32_b32 %0, -1, 0\n\tv_mbcnt_hi_u32_b32 %0, -1, %0" : "=v"(l)); return l; }
#define TIDX (kwave * 64 + lane_now())
__device__ __forceinline__ float silu_f(float x) { return x / (1.0f + expf(-x)); }

struct Args { const float* in[22]; float* out; unsigned char* ws; int ph_lo, ph_hi; };

__device__ __forceinline__ int qk_rowmap(int n) {
    const int hh = n >> 6, d = n & 63, pn = hh >> 2, wc = hh & 3, bj = d >> 5, dd = d & 31, nn = dd >> 4, fq = (dd & 15) >> 2, i = dd & 3;
    return 256 * pn + 128 * bj + 32 * wc + 8 * fq + 4 * nn + i;
}
__device__ __forceinline__ int conv_rowmap(int mode, int n) {
    switch (mode) {
        case 1: return 256 * (n >> 7) + (n & 127);
        case 2: return 256 * (n >> 7) + 128 + (n & 127);
        case 3: return n < 1280 ? qk_rowmap(n) : n;
        case 4: return n < 2048 ? qk_rowmap(n) : n;
        default: return n;
    }
}
struct ConvJob { const float* W; bf16* Wt; int K, N, mode, item; };
__device__ __forceinline__ void conv_load(const ConvJob& j, f32x4 (&v)[8], int lane) {
    const int nblk = j.N / 32, kb = j.item / nblk, nbk = j.item % nblk, k0 = 64 * kb, n0 = 32 * nbk;
    const int nq = lane & 7, kg = lane >> 3;
#pragma unroll
    for (int i = 0; i < 8; ++i) v[i] = __builtin_nontemporal_load((const f32x4*)(j.W + (size_t)(k0 + 8 * kg + i) * j.N + n0 + 4 * nq));
}
__device__ __forceinline__ void conv_store(const ConvJob& j, const f32x4 (&v)[8], int lane) {
    const int nblk = j.N / 32, kb = j.item / nblk, nbk = j.item % nblk, k0 = 64 * kb, n0 = 32 * nbk;
    const int nq = lane & 7, kg = lane >> 3;
#pragma unroll
    for (int c = 0; c < 4; ++c) {
        u32x4 o; o.x = pk2(v[0][c], v[1][c]); o.y = pk2(v[2][c], v[3][c]); o.z = pk2(v[4][c], v[5][c]); o.w = pk2(v[6][c], v[7][c]);
        const int row = conv_rowmap(j.mode, n0 + 4 * nq + c);
        __builtin_nontemporal_store(o, (u32x4*)(j.Wt + (size_t)row * j.K + k0 + 8 * kg));
    }
}
__device__ __forceinline__ void p0_phase(const Args& a, LAS unsigned char* lds, const int kwave) {
    const int tid = TIDX, lane = tid & 63, wave = tid >> 6;
    unsigned char* ws = a.ws;
    {
        float* rc = (float*)(ws + WS_ROPE); float* rs = rc + 128 * 16;
        const int per = (128 * 16 + (int)gridDim.x - 1) / (int)gridDim.x, i = blockIdx.x * per + tid;
        if (tid < per && i < 128 * 16) { const int v = i >> 4, f = i & 15; const double inv = pow(10000.0, -(double)f / 16.0), ang = (double)v * inv; rc[i] = (float)cos(ang); rs[i] = (float)sin(ang); }
    }
    if (blockIdx.x == 1) {
        int* rowidx = (int*)(ws + WS_ROWIDX); float* gate = (float*)(ws + WS_GATE);
        for (int i = tid; i < NE * 128; i += NTHREADS) { const int e = i >> 7, p = i & 127; rowidx[e * SLOTS_E + 4224 + p] = 0; gate[e * SLOTS_E + 4224 + p] = 0.f; }
    }
    {
        LAS float* sc = (LAS float*)lds;
        LAS float* red = sc + 5 * 1024;
        bool have = false;
        for (int u = blockIdx.x; u < 192; u += gridDim.x) {
            if (!have) {
                for (int i = tid; i < 5 * 1024; i += NTHREADS) { const int r = i >> 10, k = i & 1023; const float cv = r < 4 ? a.in[1][r * 1024 + k] : a.in[3][k]; sc[i] = silu_f(cv); }
                __syncthreads(); have = true;
            }
            const int l = u / 96, cb = u % 96, col = cb * 64 + lane;
            const float* W = a.in[4] + (size_t)l * 1024 * 6144;
            float acc[5] = {0.f, 0.f, 0.f, 0.f, 0.f};
            for (int kk = 0; kk < 128; ++kk) { const int k = wave * 128 + kk; const float wv = W[(size_t)k * 6144 + col];
#pragma unroll
                for (int r = 0; r < 5; ++r) acc[r] += sc[r * 1024 + k] * wv; }
#pragma unroll
            for (int r = 0; r < 5; ++r) red[(wave * 5 + r) * 64 + lane] = acc[r];
            __syncthreads();
            if (tid < 320) { const int r = tid >> 6, ln = tid & 63; float s = 0.f;
#pragma unroll
                for (int w = 0; w < 8; ++w) s += red[(w * 5 + r) * 64 + ln];
                const int cc = cb * 64 + ln;
                ((float*)(ws + WS_MOD))[(l * 5 + r) * 6144 + cc] = s + a.in[5][l * 6144 + cc]; }
            __syncthreads();
        }
    }
}

__device__ __forceinline__ void norm_mod(const f32x4 (&v)[4], f32x4 (&y)[4], const float* g, const float* sh, const float* sc, int lane) {
    float ss = 0.f;
#pragma unroll
    for (int j = 0; j < 4; ++j) ss += (v[j][0] * v[j][0] + v[j][1] * v[j][1]) + (v[j][2] * v[j][2] + v[j][3] * v[j][3]);
    ss = wave_sum(ss);
    const float rstd = 1.0f / sqrtf(ss * (1.0f / D) + EPS);
#pragma unroll
    for (int j = 0; j < 4; ++j) { const int col = 4 * lane + 256 * j; const f32x4 gg = *(const f32x4*)(g + col), s0 = *(const f32x4*)(sh + col), s1 = *(const f32x4*)(sc + col);
        y[j] = (v[j] * rstd * gg) * (1.0f + s1) + s0; }
}
__device__ __forceinline__ void store_bf16_row(bf16* orow, const f32x4 (&y)[4], int lane) {
#pragma unroll
    for (int j = 0; j < 4; ++j) { u32x2 w; w.x = pk2(y[j][0], y[j][1]); w.y = pk2(y[j][2], y[j][3]); *(u32x2*)(orow + 4 * lane + 256 * j) = w; }
}
__device__ __forceinline__ void norm1_l0_phase(const Args& a, const int kwave) {
    const int lane = TIDX & 63, wave = TIDX >> 6;
    const int gw = blockIdx.x * NWAVES + wave, NGW = gridDim.x * NWAVES;
    const float* mod = (const float*)(a.ws + WS_MOD); bf16* HL = (bf16*)(a.ws + WS_HL);
    for (int row = gw; row < NROWS; row += NGW) {
        const bool lat = row < NLAT; const int r = lat ? row / S : 4;
        const float* xr = lat ? a.in[0] + (size_t)row * D : a.in[2] + (size_t)(row - NLAT) * D;
        f32x4 v[4], y[4];
#pragma unroll
        for (int j = 0; j < 4; ++j) v[j] = *(const f32x4*)(xr + 4 * lane + 256 * j);
        const float* m = mod + (0 * 5 + r) * 6144;
        norm_mod(v, y, a.in[6], m, m + 1024, lane);
        store_bf16_row(HL + (size_t)row * D, y, lane);
    }
}
template <int CTRL> __device__ __forceinline__ float dppf(float v) { return __builtin_bit_cast(float, __builtin_amdgcn_update_dpp(0, __builtin_bit_cast(int, v), CTRL, 0xF, 0xF, true)); }
__device__ __forceinline__ float row16_max(float v) { v = fmaxf(v, dppf<0xB1>(v)); v = fmaxf(v, dppf<0x4E>(v)); v = fmaxf(v, dppf<0x141>(v)); v = fmaxf(v, dppf<0x140>(v)); return v; }
__device__ __forceinline__ float row16_sum(float v) { v += dppf<0xB1>(v); v += dppf<0x4E>(v); v += dppf<0x141>(v); v += dppf<0x140>(v); return v; }
__device__ __forceinline__ void norm2_router_phase(const Args& a, int l, int nrows, LAS unsigned char* lds, const int kwave) {
    const int tid = TIDX, lane = tid & 63, wave = __builtin_amdgcn_readfirstlane(tid >> 6);
    constexpr int WP = 1028;
    LAS float* WT = (LAS float*)lds;
    LAS float* plog = (LAS float*)(lds + 16 * WP * 4);
    LAS float* pss = plog + 2 * 8 * 256;
    LAS float* part = pss + 2 * 8 * 16;
    LAS float* csh = part + 32 * 16;
    const float* wr = a.in[18] + (size_t)l * 1024 * 16;
    const float* mod = (const float*)(a.ws + WS_MOD); bf16* HL = (bf16*)(a.ws + WS_HL);
    const float* XC = (const float*)(a.ws + WS_XC); float* AFF = (float*)(a.ws + WS_AFF);
    const float* gn = a.in[7] + l * 1024;
    const int ngroups = nrows / 16, G = gridDim.x;
    const int g_lo = (int)(((long)blockIdx.x * ngroups) / G), g_hi = (int)(((long)(blockIdx.x + 1) * ngroups) / G);
    const int rowl = lane & 15, kq = lane >> 4, colb = 128 * wave + 4 * kq;
    int cur_r = -1; f32x4 Gv[8], Sv[8], xn[8];
    for (int grp = g_lo; grp < g_hi; ++grp) {
        const int row0 = grp * 16; const bool lat = row0 < NLAT; const int b = lat ? row0 / S : (row0 - NLAT) / CTX, r = lat ? b : 4;
        const float* m = mod + (l * 5 + r) * 6144 + 3 * 1024;
        if (r != cur_r) {
            __syncthreads();
            const int e = tid & 15; float ps = 0.f;
#pragma unroll 16
            for (int it = 0; it < 32; ++it) { const int k = (tid >> 4) + 32 * it; const float w = wr[k * 16 + e]; WT[e * WP + k] = w * gn[k] * (1.0f + m[1024 + k]); ps += m[k] * w; }
            part[(tid >> 4) * 16 + e] = ps;
            __syncthreads();
            if (tid < 16) { float s = 0.f;
#pragma unroll 4
                for (int j = 0; j < 32; ++j) s += part[j * 16 + tid];
                csh[tid] = s; }
            __syncthreads();
#pragma unroll
            for (int c = 0; c < 8; ++c) { const int col = colb + 16 * c; const f32x4 g4 = *(const f32x4*)(gn + col), s1 = *(const f32x4*)(m + 1024 + col); Gv[c] = g4 * (1.0f + s1); Sv[c] = *(const f32x4*)(m + col); }
            cur_r = r;
        }
        const int par = grp & 1;
        f32x4 x[8];
        if (grp == g_lo) { const float* xr = (lat ? a.out + (size_t)(row0 + rowl) * D : XC + (size_t)(row0 + rowl - NLAT) * D) + colb;
#pragma unroll
            for (int c = 0; c < 8; ++c) xn[c] = *(const f32x4*)(xr + 16 * c); }
#pragma unroll
        for (int c = 0; c < 8; ++c) x[c] = xn[c];
        if (grp + 1 < g_hi) { const int rown = (grp + 1) * 16 + rowl; const float* xr = (rown < NLAT ? a.out + (size_t)rown * D : XC + (size_t)(rown - NLAT) * D) + colb;
#pragma unroll
            for (int c = 0; c < 8; ++c) xn[c] = *(const f32x4*)(xr + 16 * c); }
        float ss = 0.f; f32x4 acc0 = {0.f, 0.f, 0.f, 0.f}, acc1 = {0.f, 0.f, 0.f, 0.f};
#pragma unroll
        for (int c = 0; c < 8; ++c) {
            const f32x4 w4 = *(const LAS f32x4*)(WT + rowl * WP + colb + 16 * c);
            ss += (x[c][0] * x[c][0] + x[c][1] * x[c][1]) + (x[c][2] * x[c][2] + x[c][3] * x[c][3]);
            acc0 = __builtin_amdgcn_mfma_f32_16x16x4f32(x[c][0], w4[0], acc0, 0, 0, 0);
            acc1 = __builtin_amdgcn_mfma_f32_16x16x4f32(x[c][1], w4[1], acc1, 0, 0, 0);
            acc0 = __builtin_amdgcn_mfma_f32_16x16x4f32(x[c][2], w4[2], acc0, 0, 0, 0);
            acc1 = __builtin_amdgcn_mfma_f32_16x16x4f32(x[c][3], w4[3], acc1, 0, 0, 0);
        }
        ss += __shfl_xor(ss, 16); ss += __shfl_xor(ss, 32);
        *(LAS f32x4*)(plog + (par * 8 + wave) * 256 + lane * 4) = acc0 + acc1;
        if (kq == 0) pss[(par * 8 + wave) * 16 + rowl] = ss;
        asm volatile("s_waitcnt lgkmcnt(0)" ::: "memory"); __builtin_amdgcn_s_barrier(); asm volatile("" ::: "memory");
        float st = 0.f;
#pragma unroll
        for (int w = 0; w < 8; ++w) st += pss[(par * 8 + w) * 16 + rowl];
        const float rstd = 1.0f / sqrtf(st * (1.0f / D) + EPS);
        if (wave < 4) {
            const int t = 4 * kq + wave;
            float stt = 0.f, lg = 0.f;
#pragma unroll
            for (int w = 0; w < 8; ++w) { stt += pss[(par * 8 + w) * 16 + t]; lg += plog[(par * 8 + w) * 256 + lane * 4 + wave]; }
            const float rj = 1.0f / sqrtf(stt * (1.0f / D) + EPS);
            const float v = lg * rj + csh[rowl];
            const float mx = row16_max(v);
            const float p = expf(v - mx);
            const float af = p / row16_sum(p);
            if (lat) AFF[(size_t)(b * 16 + rowl) * S + (row0 - b * S) + t] = af;
            else AFF[(size_t)64 * S + (size_t)(b * 16 + rowl) * CTX + (row0 - NLAT - b * CTX) + t] = af;
        }
        if (FP8_GU) {
            unsigned char* orow8 = (unsigned char*)HL + (size_t)(row0 + rowl) * D + 128 * wave + 16 * kq;
            unsigned d[8];
#pragma unroll
            for (int c = 0; c < 8; ++c) { const f32x4 y = (x[c] * rstd) * Gv[c] + Sv[c]; int w = 0; w = __builtin_amdgcn_cvt_pk_fp8_f32(y[0], y[1], w, false); w = __builtin_amdgcn_cvt_pk_fp8_f32(y[2], y[3], w, true); d[c] = (unsigned)w; }
#pragma unroll
            for (int q = 0; q < 2; ++q) {
                { auto t = __builtin_amdgcn_permlane16_swap(d[4 * q], d[4 * q + 1], false, false); d[4 * q] = t[0]; d[4 * q + 1] = t[1]; }
                { auto t = __builtin_amdgcn_permlane16_swap(d[4 * q + 2], d[4 * q + 3], false, false); d[4 * q + 2] = t[0]; d[4 * q + 3] = t[1]; }
                { auto t = __builtin_amdgcn_permlane32_swap(d[4 * q], d[4 * q + 2], false, false); d[4 * q] = t[0]; d[4 * q + 2] = t[1]; }
                { auto t = __builtin_amdgcn_permlane32_swap(d[4 * q + 1], d[4 * q + 3], false, false); d[4 * q + 1] = t[0]; d[4 * q + 3] = t[1]; }
                u32x4 w; w.x = d[4 * q]; w.y = d[4 * q + 1]; w.z = d[4 * q + 2]; w.w = d[4 * q + 3];
                *(u32x4*)(orow8 + 64 * q) = w;
            }
        } else {
            bf16* orow = HL + (size_t)(row0 + rowl) * D + colb;
#pragma unroll
            for (int c = 0; c < 8; ++c) { const f32x4 y = (x[c] * rstd) * Gv[c] + Sv[c]; u32x2 w; w.x = pk2(y[0], y[1]); w.y = pk2(y[2], y[3]); *(u32x2*)(orow + 16 * c) = w; }
        }
    }
}
__device__ __forceinline__ int block_sum_i(int v, LAS int* sm, int lane, int wave) {
    v = wave_sum_i(v);
    if (lane == 0) sm[wave] = v;
    __syncthreads();
    int t = 0;
#pragma unroll
    for (int w = 0; w < NWAVES; ++w) t += sm[w];
    __syncthreads();
    return t;
}
__device__ __forceinline__ void select_phase(const Args& a, int npairs, LAS unsigned char* lds, const int kwave) {
    const int tid = TIDX, lane = tid & 63, wave = tid >> 6;
    LAS int* sm = (LAS int*)lds;
    const float* AFF = (const float*)(a.ws + WS_AFF);
    int* ROWIDX = (int*)(a.ws + WS_ROWIDX); float* GATE = (float*)(a.ws + WS_GATE); int* INV = (int*)(a.ws + WS_INV);
    for (int p = blockIdx.x; p < npairs; p += gridDim.x) {
        const bool lat = p < 64; const int pp = lat ? p : p - 64, b = pp >> 4, e = pp & 15;
        const int n = lat ? S : CTX, cap = lat ? CAPL : CAPC;
        const float* aff = lat ? AFF + (size_t)pp * S : AFF + (size_t)64 * S + (size_t)pp * CTX;
        const int slot_base = lat ? e * SLOTS_E + b * CAPL : e * SLOTS_E + 4096 + b * CAPC;
        const int row_base = lat ? b * S : NLAT + b * CTX;
        unsigned key[16]; const int base = tid * 16;
        if (base < n) {
#pragma unroll
            for (int j = 0; j < 4; ++j) { const f32x4 t = *(const f32x4*)(aff + base + 4 * j); key[4 * j] = __float_as_uint(t[0]); key[4 * j + 1] = __float_as_uint(t[1]); key[4 * j + 2] = __float_as_uint(t[2]); key[4 * j + 3] = __float_as_uint(t[3]); }
        } else {
#pragma unroll
            for (int j = 0; j < 16; ++j) key[j] = 0u;
        }
        unsigned kor = 0u, kand = ~0u;
        if (base < n) {
#pragma unroll
            for (int j = 0; j < 16; ++j) { kor |= key[j]; kand &= key[j]; } }
#pragma unroll
        for (int o = 32; o >= 1; o >>= 1) { kor |= (unsigned)__shfl_xor((int)kor, o); kand &= (unsigned)__shfl_xor((int)kand, o); }
        if (lane == 0) { sm[48 + wave] = (int)kor; sm[56 + wave] = (int)kand; }
        __syncthreads();
#pragma unroll
        for (int w = 0; w < NWAVES; ++w) { kor |= (unsigned)sm[48 + w]; kand &= (unsigned)sm[56 + w]; }
        const unsigned same = ~(kor ^ kand);
        unsigned T = kand & same;
        int it = 0;
        for (int bit = 30; bit >= 0; --bit) {
            if ((same >> bit) & 1u) continue;
            const unsigned cand = T | (1u << bit); int cnt = 0;
#pragma unroll
            for (int j = 0; j < 16; ++j) cnt += (key[j] >= cand) ? 1 : 0;
            cnt = wave_sum_i(cnt);
            LAS int* buf = sm + 64 + (it & 1) * 8;
            if (lane == 0) buf[wave] = cnt;
            __syncthreads();
            int tot = 0;
#pragma unroll
            for (int w = 0; w < NWAVES; ++w) tot += buf[w];
            if (tot >= cap) T = cand;
            ++it;
        }
        __syncthreads();
        int cgt = 0, ceq = 0;
#pragma unroll
        for (int j = 0; j < 16; ++j) { cgt += (key[j] > T) ? 1 : 0; ceq += (key[j] == T) ? 1 : 0; }
        int igt = cgt, ieq = ceq;
#pragma unroll
        for (int o = 1; o < 64; o <<= 1) { const int t1 = __shfl_up(igt, o), t2 = __shfl_up(ieq, o); if (lane >= o) { igt += t1; ieq += t2; } }
        if (lane == 63) { sm[16 + wave] = igt; sm[32 + wave] = ieq; }
        __syncthreads();
        int pgt = igt - cgt, peq = ieq - ceq, totgt = 0;
#pragma unroll
        for (int w = 0; w < NWAVES; ++w) { const int g = sm[16 + w], q = sm[32 + w]; if (w < wave) { pgt += g; peq += q; } totgt += g; }
        __syncthreads();
        const int need = cap - totgt;
        if (base < n) {
            int g = pgt, q = peq;
#pragma unroll
            for (int j = 0; j < 16; ++j) {
                const unsigned k = key[j]; const int row = row_base + base + j;
                const bool sel = (k > T) || (k == T && q < need);
                int slot = -1;
                if (sel) { slot = slot_base + g + (q < need ? q : need); ROWIDX[slot] = row; GATE[slot] = __uint_as_float(k); }
                INV[(size_t)row * 16 + e] = slot;
                g += (k > T) ? 1 : 0; q += (k == T) ? 1 : 0;
            }
        }
    }
}
__device__ __forceinline__ void combine_phase(const Args& a, int l, const int kwave) {
    const int lane = TIDX & 63, wave = TIDX >> 6;
    const int gw = blockIdx.x * NWAVES + wave, NGW = gridDim.x * NWAVES;
    const float* mod = (const float*)(a.ws + WS_MOD); bf16* HL = (bf16*)(a.ws + WS_HL);
    const float* XC = (const float*)(a.ws + WS_XC); const int* INV = (const int*)(a.ws + WS_INV); const bf16* Y = (const bf16*)(a.ws + WS_Y);
    const int nrows = (l == 0) ? NROWS : NLAT;
    int row = gw;
    int inv_n = -1; f32x4 vn[4];
    if (row < nrows) { inv_n = (lane < 16) ? INV[(size_t)row * 16 + lane] : -1; const float* xr0 = row < NLAT ? a.out + (size_t)row * D : XC + (size_t)(row - NLAT) * D;
#pragma unroll
        for (int j = 0; j < 4; ++j) vn[j] = *(const f32x4*)(xr0 + 4 * lane + 256 * j); }
    for (; row < nrows; row += NGW) {
        const bool lat = row < NLAT; const int r = lat ? row / S : 4;
        const int inv = inv_n; f32x4 v[4], acc[4];
#pragma unroll
        for (int j = 0; j < 4; ++j) { v[j] = vn[j]; acc[j] = (f32x4){0.f, 0.f, 0.f, 0.f}; }
        float* xr = lat ? a.out + (size_t)row * D : (float*)XC + (size_t)(row - NLAT) * D;
        const int nrow = row + NGW;
        if (nrow < nrows) { inv_n = (lane < 16) ? INV[(size_t)nrow * 16 + lane] : -1; const float* xrn = nrow < NLAT ? a.out + (size_t)nrow * D : XC + (size_t)(nrow - NLAT) * D;
#pragma unroll
            for (int j = 0; j < 4; ++j) vn[j] = *(const f32x4*)(xrn + 4 * lane + 256 * j); }
        unsigned long long mask = __ballot(inv >= 0);
        while (mask) {
            int sl[4];
#pragma unroll
            for (int q = 0; q < 4; ++q) { if (mask) { const int e = __builtin_ctzll(mask); mask &= mask - 1; sl[q] = __shfl(inv, e); } else sl[q] = -1; }
            if (FP8_Y) {
                unsigned w[4][4];
#pragma unroll
                for (int q = 0; q < 4; ++q) if (sl[q] >= 0) { const unsigned char* yr = (const unsigned char*)Y + (size_t)sl[q] * D;
#pragma unroll
                    for (int j = 0; j < 4; ++j) w[q][j] = *(const unsigned*)(yr + 4 * lane + 256 * j); }
#pragma unroll
                for (int q = 0; q < 4; ++q) if (sl[q] >= 0) {
#pragma unroll
                    for (int j = 0; j < 4; ++j) { acc[j][0] += __builtin_amdgcn_cvt_f32_fp8((int)w[q][j], 0); acc[j][1] += __builtin_amdgcn_cvt_f32_fp8((int)w[q][j], 1); acc[j][2] += __builtin_amdgcn_cvt_f32_fp8((int)w[q][j], 2); acc[j][3] += __builtin_amdgcn_cvt_f32_fp8((int)w[q][j], 3); } }
            } else {
                u32x2 w[4][4];
#pragma unroll
                for (int q = 0; q < 4; ++q) if (sl[q] >= 0) { const bf16* yr = Y + (size_t)sl[q] * D;
#pragma unroll
                    for (int j = 0; j < 4; ++j) w[q][j] = *(const u32x2*)(yr + 4 * lane + 256 * j); }
#pragma unroll
                for (int q = 0; q < 4; ++q) if (sl[q] >= 0) {
#pragma unroll
                    for (int j = 0; j < 4; ++j) { acc[j][0] += bf2f(w[q][j].x & 0xffffu); acc[j][1] += bf2f(w[q][j].x >> 16); acc[j][2] += bf2f(w[q][j].y & 0xffffu); acc[j][3] += bf2f(w[q][j].y >> 16); } }
            }
        }
        const float* g2 = mod + (l * 5 + r) * 6144 + 5 * 1024;
#pragma unroll
        for (int j = 0; j < 4; ++j) { const f32x4 gg = *(const f32x4*)(g2 + 4 * lane + 256 * j) * (FP8_Y ? 1.0f / Y8_SCALE : 1.0f); v[j] = v[j] + gg * acc[j]; }
        if (lat) {
#pragma unroll
            for (int j = 0; j < 4; ++j) *(f32x4*)(xr + 4 * lane + 256 * j) = v[j];
        }
        if (l == 0) {
            f32x4 y[4]; const float* m = mod + (1 * 5 + r) * 6144;
            norm_mod(v, y, a.in[6] + 1024, m, m + 1024, lane);
            store_bf16_row(HL + (size_t)row * D, y, lane);
        }
    }
}

namespace pg8 {
constexpr int BM = 256, BK = 64, HALF = 128, HTB = HALF * BK * 2, STAGE_BYTES = 8 * HTB, NXCD = 8, WGM = 8;
__host__ __device__ __forceinline__ int lds_byte(int r, int c) { const int st = (r >> 4) * 2 + (c >> 5), rr = r & 15, cc = c & 31, ob = rr * 64 + cc * 2; return st * 1024 + (ob ^ (((ob >> 9) & 1) << 5)); }
__host__ __device__ __forceinline__ void stage_rc(int b, int& R, int& C) { const int st = b / 1024, sb = b % 1024, swz = sb ^ (((sb >> 9) & 1) << 5); R = (st >> 1) * 16 + swz / 64; C = (st & 1) * 32 + (swz % 64) / 2; }
__host__ __device__ __forceinline__ int perm32(int rho) { const int n = rho >> 4, i = rho & 15; return 8 * (i >> 2) + 4 * n + (i & 3); }
struct Unit { int pm, pn; };
struct Sched {
    int reph = 2;
    int nM, nN, nwg, G, c, mpe;
    const char* Bt; size_t b_estride, b_tstride;
    __device__ __forceinline__ void init(int nM_, int nN_, int G_, int c_, int mpe_, const void* Bt_, size_t es, size_t ts) { nM = nM_; nN = nN_; nwg = nM * nN; G = G_; c = c_; mpe = mpe_; Bt = (const char*)Bt_; b_estride = es; b_tstride = ts; }
    __device__ __forceinline__ bool next(int i, Unit& u) const {
        const long L = (long)i * G + c; if (L >= (long)nwg * reph / 2) return false;
        int wgid = (int)(L % nwg); { const int q = nwg / NXCD, r = nwg % NXCD, xcd = wgid % NXCD, off = wgid / NXCD; wgid = (xcd < r ? xcd * (q + 1) : r * (q + 1) + (xcd - r) * q) + off; }
        const int nig = WGM * nN, gid = wgid / nig, fm = gid * WGM, gsz = (nM - fm) < WGM ? (nM - fm) : WGM;
        int pm = fm + ((wgid % nig) % gsz); u.pn = (wgid % nig) / gsz;
        if (mpe) { const int e = pm / mpe; pm = e * 17 + (pm - e * mpe); }
        u.pm = pm; return true;
    }
    __device__ __forceinline__ const char* b_base(const Unit& u) const { const int e = mpe ? u.pm / 17 : 0; return Bt + (size_t)e * b_estride + (size_t)u.pn * b_tstride; }
};
__device__ __forceinline__ unsigned cvt_pk_bf16(float lo, float hi) { unsigned r; asm volatile("v_cvt_pk_bf16_f32 %0, %1, %2" : "=v"(r) : "v"(lo), "v"(hi)); return r; }

__device__ __forceinline__ u32x4 widen16(u32x2 a, u32x2 b) {
    auto r0 = __builtin_amdgcn_permlane16_swap(a.x, b.x, false, false); auto r1 = __builtin_amdgcn_permlane16_swap(a.y, b.y, false, false);
    u32x4 w; w.x = r0[0]; w.y = r1[0]; w.z = r0[1]; w.w = r1[1]; return w;
}
struct EpiQKV {
    static constexpr bool PERM = true;
    bf16* Q; bf16* Kb; bf16* Vb; int kvw, nqt, nkt; const float* qg; const float* kg; const float* ropet; int rope; float qscale;
    __device__ __forceinline__ void operator()(const f32x4 (&acc)[2][2][4][2], const Unit& u, int wr, int wc, int fr, int fq) const {
        const int row0 = u.pm * BM + wr * 64 + fr;
        if (u.pn >= nqt + nkt) {
            const int colt = (u.pn - nqt - nkt) * BM + wc * 32 + 8 * fq;
#pragma unroll
            for (int ai = 0; ai < 2; ++ai)
#pragma unroll
                for (int m = 0; m < 4; ++m) { bf16* rowp = Vb + (size_t)(row0 + ai * HALF + m * 16) * kvw + colt;
#pragma unroll
                    for (int bj = 0; bj < 2; ++bj) { const f32x4 v0 = acc[ai][bj][m][0], v1 = acc[ai][bj][m][1]; u32x4 w; w.x = cvt_pk_bf16(v0[0], v0[1]); w.y = cvt_pk_bf16(v0[2], v0[3]); w.z = cvt_pk_bf16(v1[0], v1[1]); w.w = cvt_pk_bf16(v1[2], v1[3]);
                        *(u32x4*)(rowp + bj * HALF) = w; } }
            return;
        }
        const bool isq = u.pn < nqt; const int head = isq ? 4 * u.pn + wc : 4 * (u.pn - nqt) + wc;
        const float* gain = isq ? qg : kg; const float scale = isq ? qscale : 1.0f;
        bf16* dst = (isq ? Q : Kb) + head * 64 + 4 * fq; const int ld = isq ? 1024 : kvw;
        f32x4 gv[2][2];
#pragma unroll
        for (int bj = 0; bj < 2; ++bj)
#pragma unroll
            for (int n = 0; n < 2; ++n) gv[bj][n] = *(const f32x4*)(gain + 32 * bj + 16 * n + 4 * fq);
        const bool dorope = rope && (u.pm < NLAT / BM);
#pragma unroll
        for (int ai = 0; ai < 2; ++ai)
#pragma unroll
            for (int m = 0; m < 4; ++m) {
                const int row = row0 + ai * HALF + m * 16;
                float ss = 0.f;
#pragma unroll
                for (int bj = 0; bj < 2; ++bj)
#pragma unroll
                    for (int n = 0; n < 2; ++n) { const f32x4 x = acc[ai][bj][m][n]; ss += (x[0] * x[0] + x[1] * x[1]) + (x[2] * x[2] + x[3] * x[3]); }
                ss += __shfl_xor(ss, 16); ss += __shfl_xor(ss, 32);
                const float rstd = scale / sqrtf(ss * (1.0f / 64.0f) + EPS);
                f32x4 y[2][2];
#pragma unroll
                for (int bj = 0; bj < 2; ++bj)
#pragma unroll
                    for (int n = 0; n < 2; ++n) y[bj][n] = acc[ai][bj][m][n] * rstd * gv[bj][n];
                if (dorope) { const int pos = row & (S - 1);
#pragma unroll
                    for (int bj = 0; bj < 2; ++bj) { const int v = bj == 0 ? (pos >> 6) : (pos & 63); const f32x4 cs = *(const f32x4*)(ropet + v * 16 + 4 * fq), sn = *(const f32x4*)(ropet + 2048 + v * 16 + 4 * fq);
                        const f32x4 a0 = y[bj][0], a1 = y[bj][1]; y[bj][0] = a0 * cs - a1 * sn; y[bj][1] = a0 * sn + a1 * cs; } }
                bf16* rowp = dst + (size_t)row * ld - 4 * fq + ((fq & 1) ? 16 + 4 * (fq - 1) : 4 * fq);
#pragma unroll
                for (int bj = 0; bj < 2; ++bj) {
                    u32x2 wa, wb; wa.x = cvt_pk_bf16(y[bj][0][0], y[bj][0][1]); wa.y = cvt_pk_bf16(y[bj][0][2], y[bj][0][3]); wb.x = cvt_pk_bf16(y[bj][1][0], y[bj][1][1]); wb.y = cvt_pk_bf16(y[bj][1][2], y[bj][1][3]);
                    *(u32x4*)(rowp + 32 * bj) = widen16(wa, wb); }
            }
    }
};
struct EpiOproj {
    static constexpr bool PERM = false;
    const float* base_lat; const float* base_ctx; float* out_lat; float* out_ctx; const float* g1; float accscale;
    __device__ __forceinline__ void operator()(const f32x4 (&acc)[2][2][4][2], const Unit& u, int wr, int wc, int fr, int fq) const {
        const bool lat = u.pm < NLAT / BM; const int r = lat ? (u.pm >> 5) : 4;
        const int col0 = u.pn * BM + wc * 32 + 4 * fq;
        const int row0 = (lat ? u.pm * BM : u.pm * BM - NLAT) + wr * 64 + fr;
        const float* bs = lat ? base_lat : base_ctx; float* os = lat ? out_lat : out_ctx;
        f32x4 gv[2][2];
#pragma unroll
        for (int bj = 0; bj < 2; ++bj)
#pragma unroll
            for (int n = 0; n < 2; ++n) gv[bj][n] = *(const f32x4*)(g1 + r * 6144 + col0 + bj * HALF + n * 16) * accscale;
#pragma unroll
        for (int ai = 0; ai < 2; ++ai)
#pragma unroll
            for (int mp = 0; mp < 2; ++mp) {
                f32x4 pre[2][2][2];
#pragma unroll
                for (int mm = 0; mm < 2; ++mm) { const size_t off = (size_t)(row0 + ai * HALF + (2 * mp + mm) * 16) * D + col0;
#pragma unroll
                    for (int bj = 0; bj < 2; ++bj)
#pragma unroll
                        for (int n = 0; n < 2; ++n) pre[mm][bj][n] = *(const f32x4*)(bs + off + bj * HALF + n * 16); }
                asm volatile("" ::: "memory");
#pragma unroll
                for (int mm = 0; mm < 2; ++mm) { const size_t off = (size_t)(row0 + ai * HALF + (2 * mp + mm) * 16) * D + col0;
#pragma unroll
                    for (int bj = 0; bj < 2; ++bj)
#pragma unroll
                        for (int n = 0; n < 2; ++n) *(f32x4*)(os + off + bj * HALF + n * 16) = pre[mm][bj][n] + gv[bj][n] * acc[ai][bj][2 * mp + mm][n]; }
                asm volatile("" ::: "memory");
            }
    }
};
__device__ __forceinline__ float silu_fast(float x) { return x * __builtin_amdgcn_rcpf(1.0f + __expf(-x)); }
struct EpiGU {
    static constexpr bool PERM = true;
    bf16* H; float inscale;
    __device__ __forceinline__ void operator()(const f32x4 (&acc)[2][2][4][2], const Unit& u, int wr, int wc, int fr, int fq) const {
        const int row0 = u.pm * BM + wr * 64 + fr, col0 = u.pn * HALF + wc * 32 + 8 * fq;
#pragma unroll
        for (int ai = 0; ai < 2; ++ai)
#pragma unroll
            for (int mp = 0; mp < 2; ++mp) {
                u32x2 w8[2]; u32x4 wb[2];
#pragma unroll
                for (int mm = 0; mm < 2; ++mm) { const int m = 2 * mp + mm;
                    const f32x4 g0 = acc[ai][0][m][0], g1 = acc[ai][0][m][1], u0 = acc[ai][1][m][0], u1 = acc[ai][1][m][1];
                    const float ce = -inscale * LOG2E, cs = inscale * inscale;
                    float hv[8];
#pragma unroll
                    for (int i = 0; i < 4; ++i) {
                        hv[i] = (g0[i] * u0[i]) * (cs * __builtin_amdgcn_rcpf(1.0f + __builtin_amdgcn_exp2f(g0[i] * ce)));
                        hv[4 + i] = (g1[i] * u1[i]) * (cs * __builtin_amdgcn_rcpf(1.0f + __builtin_amdgcn_exp2f(g1[i] * ce))); }
                    if (FP8_DOWN) {
                        int w0 = 0, w1 = 0;
                        w0 = __builtin_amdgcn_cvt_pk_fp8_f32(hv[0], hv[1], w0, false); w0 = __builtin_amdgcn_cvt_pk_fp8_f32(hv[2], hv[3], w0, true);
                        w1 = __builtin_amdgcn_cvt_pk_fp8_f32(hv[4], hv[5], w1, false); w1 = __builtin_amdgcn_cvt_pk_fp8_f32(hv[6], hv[7], w1, true);
                        w8[mm].x = (unsigned)w0; w8[mm].y = (unsigned)w1;
                    } else { wb[mm].x = cvt_pk_bf16(hv[0], hv[1]); wb[mm].y = cvt_pk_bf16(hv[2], hv[3]); wb[mm].z = cvt_pk_bf16(hv[4], hv[5]); wb[mm].w = cvt_pk_bf16(hv[6], hv[7]); }
                }
                if (FP8_DOWN) {
                    const int m = 2 * mp + (fq & 1);
                    *(u32x4*)((unsigned char*)H + (size_t)(row0 + ai * HALF + m * 16) * FF + col0 - 8 * (fq & 1)) = widen16(w8[0], w8[1]);
                } else {
#pragma unroll
                    for (int mm = 0; mm < 2; ++mm) *(u32x4*)(H + (size_t)(row0 + ai * HALF + (2 * mp + mm) * 16) * FF + col0) = wb[mm];
                }
            }
    }
};
struct EpiDown {
    static constexpr bool PERM = true;
    bf16* Y; const float* gate;
    __device__ __forceinline__ void operator()(const f32x4 (&acc)[2][2][4][2], const Unit& u, int wr, int wc, int fr, int fq) const {
        const int row0 = u.pm * BM + wr * 64 + fr, col0 = u.pn * BM + wc * 32 + 8 * fq;
        static_assert(FP8_Y, "fp8 Y only");
        const float gsc = (FP8_DOWN ? W8_INV : 1.0f) * Y8_SCALE;
#pragma unroll
        for (int ai = 0; ai < 2; ++ai) {
            float gt4[4];
#pragma unroll
            for (int m = 0; m < 4; ++m) gt4[m] = gate[row0 + ai * HALF + m * 16] * gsc;
#pragma unroll
            for (int mp = 0; mp < 2; ++mp) {
#pragma unroll
                for (int bj = 0; bj < 2; ++bj) {
                    u32x2 w8[2];
#pragma unroll
                    for (int mm = 0; mm < 2; ++mm) { const int m = 2 * mp + mm; const float gt = gt4[m];
                        const f32x4 v0 = acc[ai][bj][m][0] * gt, v1 = acc[ai][bj][m][1] * gt;
                        int w0 = 0, w1 = 0;
                        w0 = __builtin_amdgcn_cvt_pk_fp8_f32(v0[0], v0[1], w0, false); w0 = __builtin_amdgcn_cvt_pk_fp8_f32(v0[2], v0[3], w0, true);
                        w1 = __builtin_amdgcn_cvt_pk_fp8_f32(v1[0], v1[1], w1, false); w1 = __builtin_amdgcn_cvt_pk_fp8_f32(v1[2], v1[3], w1, true);
                        w8[mm].x = (unsigned)w0; w8[mm].y = (unsigned)w1; }
                    *(u32x4*)((unsigned char*)Y + (size_t)(row0 + ai * HALF + (2 * mp + (fq & 1)) * 16) * D + col0 - 8 * (fq & 1) + bj * HALF) = widen16(w8[0], w8[1]);
                }
            }
        }
    }
};
typedef int v8i32 __attribute__((ext_vector_type(8)));
typedef int v4i32 __attribute__((ext_vector_type(4)));
template <class Epi, bool GATHER, bool FP8 = false>
__device__ __forceinline__ void gemm_phase(LAS unsigned char* lds, const char* Abase, int K, const Sched& S, const Epi& E, LAS int* ldsidx, const int* rowidx, const int kwave) {
    const int tid = TIDX, wid = __builtin_amdgcn_readfirstlane(tid >> 6), lane = tid & 63, wr = wid >> 2, wc = wid & 3, fr = lane & 15, fq = lane >> 4;
    const int nt = K / BK;
    int Rst[2], Cst[2]; unsigned voffB[2];
#pragma unroll
    for (int i = 0; i < 2; ++i) { int R, C; stage_rc(tid * 16 + i * 8192, R, C); Rst[i] = R; Cst[i] = C; const int Rb = Epi::PERM ? ((R & ~31) + perm32(R & 31)) : R; voffB[i] = (unsigned)(Rb * K + C) * 2u; }
    const size_t kstep = (size_t)(BK * 2);
    const size_t hstep = (size_t)HALF * K * 2;
    const unsigned ldsw = (unsigned)wid * 1024u;
    constexpr bool ASM_STAGE = FP8;
    const unsigned ldsbase = (unsigned)__builtin_amdgcn_readfirstlane((int)((unsigned)(uintptr_t)lds + ldsw));
    const int aoff = lds_byte(wr * 64 + fr, fq * 8), boff = lds_byte(wc * 32 + fr, fq * 8);
    Unit cur, nxt; int ui = 0;
    if (!S.next(0, cur)) return;
    if (GATHER) {
        Unit t_; for (int i = 0; S.next(i, t_); ++i) if (tid < 256) ldsidx[i * 256 + tid] = rowidx[t_.pm * 256 + tid];
        __syncthreads();
    }
#define PG8_SA(b, h) (((b) * 2 + (h)) * HTB)
#define PG8_SB(b, h) ((4 + (b) * 2 + (h)) * HTB)
#define PG8_GLDS_ASM(off32, gbase, ldsdst) do { unsigned keep_; asm volatile("s_nop 4\n\ts_mov_b32 %0, m0\n\ts_mov_b32 m0, %3\n\ts_nop 0\n\tglobal_load_lds_dwordx4 %1, %2\n\ts_mov_b32 m0, %0" \
        : "=&s"(keep_) : "v"(off32), "s"((const char*)(gbase)), "s"(ldsdst) : "memory"); } while (0)
#define PG8_STAGE(bufoff, gbase, voff) do { if constexpr (ASM_STAGE) { PG8_GLDS_ASM((voff)[0], gbase, ldsbase + (unsigned)(bufoff)); PG8_GLDS_ASM((voff)[1], gbase, ldsbase + (unsigned)((bufoff) + 8192)); } \
        else { _Pragma("unroll") for (int _i = 0; _i < 2; ++_i) \
        __builtin_amdgcn_global_load_lds((const unsigned*)((const char*)(gbase) + (voff)[_i]), (LAS unsigned*)(lds + (bufoff) + ldsw + _i * 8192), 16, 0, 0); } } while (0)
#define PG8_AOFF(vo, u_, ui_) do { const int _t = TIDX; _Pragma("unroll") for (int _i = 0; _i < 2; ++_i) { int _R, _C; stage_rc(_t * 16 + _i * 8192, _R, _C); _Pragma("unroll") for (int _h = 0; _h < 2; ++_h) { \
        const int _row = GATHER ? ldsidx[(ui_) * 256 + _h * HALF + _R] : (u_).pm * BM + _h * HALF + _R; vo[_h][_i] = (unsigned)(_row * K + _C) * 2u; } } } while (0)
#define PG8_LD2(p) __builtin_shufflevector(*(const LAS v4i32*)(p), *(const LAS v4i32*)((p) + 1024), 0, 1, 2, 3, 4, 5, 6, 7)
#define PG8_LDA(dst, b, h) do { _Pragma("unroll") for (int m = 0; m < 4; ++m) dst[m] = PG8_LD2(lds + PG8_SA(b, h) + aoff + m * 2048); } while (0)
#define PG8_LDB(dst, b, h) do { _Pragma("unroll") for (int n = 0; n < 2; ++n) dst[n] = PG8_LD2(lds + PG8_SB(b, h) + boff + n * 2048); } while (0)
#define PG8_H0(x) __builtin_bit_cast(bf16x8, __builtin_shufflevector(x, x, 0, 1, 2, 3))
#define PG8_H1(x) __builtin_bit_cast(bf16x8, __builtin_shufflevector(x, x, 4, 5, 6, 7))
#define PG8_MMA(ai, bj, At, Bt) do { __builtin_amdgcn_s_setprio(1); \
        if constexpr (FP8) { _Pragma("unroll") for (int m = 0; m < 4; ++m) _Pragma("unroll") for (int n = 0; n < 2; ++n) \
            acc[ai][bj][m][n] = __builtin_amdgcn_mfma_scale_f32_16x16x128_f8f6f4(Bt[n], At[m], acc[ai][bj][m][n], 0, 0, 0, 0x7f7f7f7f, 0, 0x7f7f7f7f); } \
        else { _Pragma("unroll") for (int m = 0; m < 4; ++m) _Pragma("unroll") for (int n = 0; n < 2; ++n) { \
            acc[ai][bj][m][n] = __builtin_amdgcn_mfma_f32_16x16x32_bf16(PG8_H0(Bt[n]), PG8_H0(At[m]), acc[ai][bj][m][n], 0, 0, 0); \
            acc[ai][bj][m][n] = __builtin_amdgcn_mfma_f32_16x16x32_bf16(PG8_H1(Bt[n]), PG8_H1(At[m]), acc[ai][bj][m][n], 0, 0, 0); } } \
        __builtin_amdgcn_s_setprio(0); } while (0)
#define PG8_WAIT_V(n) asm volatile("s_waitcnt vmcnt(" #n ")" ::: "memory")
#define PG8_WAIT_L(n) asm volatile("s_waitcnt lgkmcnt(" #n ")" ::: "memory")
#define PG8_BAR __builtin_amdgcn_s_barrier()
#define PG8_SCHED __builtin_amdgcn_sched_barrier(0)
    f32x4 acc[2][2][4][2];
#pragma unroll
    for (int a = 0; a < 2; ++a)
#pragma unroll
        for (int b = 0; b < 2; ++b)
#pragma unroll
            for (int m = 0; m < 4; ++m)
#pragma unroll
                for (int n = 0; n < 2; ++n) acc[a][b][m][n] = (f32x4){0.f, 0.f, 0.f, 0.f};
    v8i32 At[4], B0[2], B1[2];
    unsigned voC[2][2];
    const size_t hstepA = GATHER ? 0 : hstep;
    const char* cA = Abase; const char* nA = Abase;
    if (GATHER) { PG8_AOFF(voC, cur, 0); }
    else {
#pragma unroll
        for (int i = 0; i < 2; ++i) { voC[0][i] = (unsigned)(Rst[i] * K + Cst[i]) * 2u; voC[1][i] = voC[0][i]; }
        cA = Abase + (size_t)cur.pm * 2 * hstep;
    }
    const char* cB = S.b_base(cur);
    PG8_STAGE(PG8_SB(0, 0), cB, voffB); PG8_STAGE(PG8_SB(0, 1), cB + hstep, voffB); PG8_STAGE(PG8_SA(0, 0), cA, voC[0]); PG8_STAGE(PG8_SA(0, 1), cA + hstepA, voC[1]);
    if (wr == 1) PG8_BAR;
    PG8_WAIT_V(2); PG8_BAR;
    PG8_STAGE(PG8_SB(1, 0), cB + kstep, voffB); PG8_STAGE(PG8_SA(1, 0), cA + kstep, voC[0]); PG8_STAGE(PG8_SB(1, 1), cB + hstep + kstep, voffB);
    PG8_WAIT_V(6); PG8_BAR;
    for (;;) {
        const bool has_next = S.next(ui + 1, nxt);
        if (!GATHER) nA = has_next ? Abase + (size_t)nxt.pm * 2 * hstep : cA;
        const char* nB = has_next ? S.b_base(nxt) : cB;
#pragma nounroll
        for (int t = 0; t < nt; t += 2) {
            const bool last = (t == nt - 2);
            const char* kA1 = cA + (size_t)(t + 1) * kstep;
            const char* kA2 = last ? nA : cA + (size_t)(t + 2) * kstep; const char* kA3 = kA2 + kstep;
            const char* b2 = last ? nB : cB + (size_t)(t + 2) * kstep; const char* b3 = b2 + kstep;
            PG8_LDB(B0, 0, 0); PG8_LDB(B1, 0, 1); PG8_SCHED; PG8_LDA(At, 0, 0); PG8_STAGE(PG8_SA(1, 1), kA1 + hstepA, voC[1]);
            if (GATHER) { if (last && has_next) { PG8_AOFF(voC, nxt, ui + 1); } }
            PG8_WAIT_V(8); PG8_WAIT_L(0); PG8_BAR; PG8_MMA(0, 0, At, B0); PG8_MMA(0, 1, At, B1); PG8_BAR; PG8_SCHED;
            PG8_LDA(At, 0, 1); PG8_STAGE(PG8_SB(0, 0), b2, voffB); PG8_STAGE(PG8_SB(0, 1), b2 + hstep, voffB); PG8_STAGE(PG8_SA(0, 0), kA2, voC[0]);
            PG8_WAIT_V(8); PG8_WAIT_L(0); PG8_BAR; PG8_MMA(1, 0, At, B0); PG8_MMA(1, 1, At, B1); PG8_BAR; PG8_SCHED;
            PG8_LDB(B0, 1, 0); PG8_LDB(B1, 1, 1); PG8_SCHED; PG8_LDA(At, 1, 0); PG8_STAGE(PG8_SA(0, 1), kA2 + hstepA, voC[1]);
            PG8_WAIT_V(8); PG8_WAIT_L(0); PG8_BAR; PG8_MMA(0, 0, At, B0); PG8_MMA(0, 1, At, B1); PG8_BAR; PG8_SCHED;
            PG8_LDA(At, 1, 1); PG8_STAGE(PG8_SB(1, 0), b3, voffB); PG8_STAGE(PG8_SB(1, 1), b3 + hstep, voffB); PG8_STAGE(PG8_SA(1, 0), kA3, voC[0]);
            PG8_WAIT_V(8); PG8_WAIT_L(0); PG8_BAR; PG8_MMA(1, 0, At, B0); PG8_MMA(1, 1, At, B1); PG8_BAR; PG8_SCHED;
        }
        if (wr == 0) PG8_BAR;
        { int fr_e = fr, fq_e = fq; asm volatile("" : "+v"(fr_e), "+v"(fq_e));
          E(acc, cur, wr, wc, fr_e, fq_e); }
        if (!has_next) break;
#pragma unroll
        for (int a = 0; a < 2; ++a)
#pragma unroll
            for (int b = 0; b < 2; ++b)
#pragma unroll
                for (int m = 0; m < 4; ++m)
#pragma unroll
                    for (int n = 0; n < 2; ++n) acc[a][b][m][n] = (f32x4){0.f, 0.f, 0.f, 0.f};
        cur = nxt; cB = nB; ++ui;
        if (!GATHER) cA = nA;
        if (wr == 1) PG8_BAR;
    }
    PG8_WAIT_V(0);
    PG8_BAR;
#undef PG8_SA
#undef PG8_SB
#undef PG8_STAGE
#undef PG8_GLDS_ASM
#undef PG8_AOFF
#undef PG8_LDA
#undef PG8_LDB
#undef PG8_MMA
#undef PG8_LD2
#undef PG8_H0
#undef PG8_H1
#undef PG8_WAIT_V
#undef PG8_WAIT_L
#undef PG8_BAR
#undef PG8_SCHED
}
}


namespace att {
typedef float f32x16 __attribute__((ext_vector_type(16)));
typedef short s16x4 __attribute__((ext_vector_type(4)));
constexpr int TILEB = 8192, OFF_K = 0, OFF_V = 4 * TILEB, OFF_BIAS = 8 * TILEB, BIAS_PITCH = 160, BIAS_ORG = 64, OFF_QBOX = 80 * 1024  ;
constexpr float NEG = -1e30f;
__device__ __forceinline__ int crow(int r, int h) { return (r & 3) + 8 * (r >> 2) + 4 * h; }
struct StageOff { unsigned k, v; };
__device__ __forceinline__ StageOff stage_off(int tid, int ld) {
    const int row = tid >> 3, ch = tid & 7; StageOff o;
    o.k = (unsigned)(row * ld + ((ch ^ ((row >> 1) & 7)) << 3)) * 2u; o.v = (unsigned)(row * ld + ((ch ^ (((row >> 1) & 1) << 2)) << 3)) * 2u; return o;
}
#define ATT_GLDS(voff, gbase, ldsdst, imm) do { unsigned keep_; asm volatile("s_mov_b32 %0, m0\n\ts_mov_b32 m0, %3\n\ts_nop 0\n\tglobal_load_lds_dwordx4 %1, %2 offset:" #imm "\n\ts_mov_b32 m0, %0" \
        : "=&s"(keep_) : "v"(voff), "s"((const char*)(gbase)), "s"(ldsdst) : "memory"); } while (0)
__device__ __forceinline__ void stage_tile_at(LAS unsigned char* kdst, LAS unsigned char* vdst, const bf16* kbase, const bf16* vbase, const StageOff& so, int wave) {
    const unsigned kd = (unsigned)__builtin_amdgcn_readfirstlane((int)(unsigned)(uintptr_t)(kdst + wave * 1024));
    const unsigned vd = (unsigned)__builtin_amdgcn_readfirstlane((int)(unsigned)(uintptr_t)(vdst + wave * 1024));
    ATT_GLDS(so.k, kbase, kd, 0);
    ATT_GLDS(so.v, vbase, vd, 0);
}
__device__ __forceinline__ void stage_tile(LAS unsigned char* lds, int slot, const bf16* kbase, const bf16* vbase, const StageOff& so, int wave) {
    const unsigned kd = (unsigned)__builtin_amdgcn_readfirstlane((int)(unsigned)(uintptr_t)(lds + OFF_K + slot * TILEB + wave * 1024));
    const unsigned vd = (unsigned)__builtin_amdgcn_readfirstlane((int)(unsigned)(uintptr_t)(lds + OFF_V + slot * TILEB + wave * 1024));
    ATT_GLDS(so.k, kbase, kd, 0);
    ATT_GLDS(so.v, vbase, vd, 0);
}
struct WaveCtx { int koff[4]; int vl[2]; bf16x8 qf[4]; f32x16 o[2]; f32x16 negm; float m, l; };
__device__ __forceinline__ void wave_offsets(WaveCtx& c, int lane, int krow0  ) {
    const int r31 = lane & 31, h = lane >> 5, row = krow0 + r31;
#pragma unroll
    for (int ds = 0; ds < 4; ++ds) c.koff[ds] = row * 128 + (((2 * ds + h) ^ ((row >> 1) & 7)) << 4);
    const int i = lane & 15, qp = i >> 2, pp = i & 3, cb = (lane >> 4) & 1;
#pragma unroll
    for (int db = 0; db < 2; ++db) c.vl[db] = (4 * h + qp) * 128 + ((db ^ ((qp >> 1) & 1)) << 6) + 32 * cb + 8 * pp;
}
__device__ __forceinline__ void load_q(bf16x8 (&qf)[4], int lane, const bf16* qrow) {
#pragma unroll
    for (int ds = 0; ds < 4; ++ds) qf[ds] = *(const bf16x8*)(qrow + 16 * ds + 8 * (lane >> 5));
}
__device__ __forceinline__ void set_negm(WaveCtx& c) {
#pragma unroll
    for (int r = 0; r < 16; ++r) c.negm[r] = -c.m;
    asm volatile("" : "+v"(c.negm));
}
__device__ __forceinline__ void wave_reset(WaveCtx& c, int lane, float m0, float l0, bool need_negm = true) {
#pragma unroll
    for (int r = 0; r < 16; ++r) { c.o[0][r] = 0.f; c.o[1][r] = 0.f; }
    c.m = m0; c.l = (lane < 32) ? l0 : 0.f; if (need_negm) set_negm(c);
}
typedef short v4i16_t __attribute__((ext_vector_type(4)));
__device__ __forceinline__ s16x4 vtr(const LAS unsigned char* p) { return __builtin_bit_cast(s16x4, __builtin_amdgcn_ds_read_tr16_b64_v4i16((LAS v4i16_t*)p)); }
typedef float f32x2_t __attribute__((ext_vector_type(2))); typedef __bf16 bf16x2_t __attribute__((ext_vector_type(2)));
__device__ __forceinline__ unsigned cvtpk(float lo, float hi) { f32x2_t v = {lo, hi}; bf16x2_t b = __builtin_convertvector(v, bf16x2_t); return __builtin_bit_cast(unsigned, b); }
__device__ __forceinline__ float max3f(float a, float b, float c3) { float r; asm("v_max3_f32 %0, %1, %2, %3" : "=v"(r) : "v"(a), "v"(b), "v"(c3)); return r; }
__device__ __forceinline__ float max2f(float a, float b) { float r; asm("v_max_f32_e32 %0, %1, %2" : "=v"(r) : "v"(a), "v"(b)); return r; }
__device__ __forceinline__ bf16x8 pack8(const f32x16& p, int s) {
    u32x4 w; w.x = cvtpk(p[8 * s], p[8 * s + 1]); w.y = cvtpk(p[8 * s + 2], p[8 * s + 3]); w.z = cvtpk(p[8 * s + 4], p[8 * s + 5]); w.w = cvtpk(p[8 * s + 6], p[8 * s + 7]);
    return __builtin_bit_cast(bf16x8, w);
}
constexpr float ATT_THR = 8.0f;
__device__ __forceinline__ bool update_ref(WaveCtx& c, float mx, float& dl) {
    { auto rr = __builtin_amdgcn_permlane32_swap(__float_as_uint(mx), __float_as_uint(mx), false, false); mx = max2f(__uint_as_float(rr[0]), __uint_as_float(rr[1])); }
    dl = 0.f;
    if (__builtin_expect(__any(mx > ATT_THR), 0)) {
        dl = max2f(mx, 0.f);
        const float f = __builtin_amdgcn_exp2f(-dl);
        c.m += dl; c.l *= f;
        c.o[0] = c.o[0] * f; c.o[1] = c.o[1] * f;
        set_negm(c);
        return true;
    }
    return false;
}
#define ATT_SB() __builtin_amdgcn_sched_barrier(0)
struct VFrag { s16x4 lo[4], hi[4]; };
__device__ __forceinline__ void load_v32(const WaveCtx& c, VFrag& f, const LAS unsigned char* vb) {
#pragma unroll
    for (int db = 0; db < 2; ++db)
#pragma unroll
        for (int s = 0; s < 2; ++s) { const LAS unsigned char* p = vb + c.vl[db] + s * 2048; f.lo[db * 2 + s] = vtr(p); f.hi[db * 2 + s] = vtr(p + 1024); }
}
__device__ __forceinline__ void pv32(WaveCtx& c, const f32x16& p, const VFrag& f) {
    const bf16x8 pf0 = pack8(p, 0), pf1 = pack8(p, 1);
#pragma unroll
    for (int db = 0; db < 2; ++db) {
        { const s16x4 lo = f.lo[db * 2], hi = f.hi[db * 2]; const bf16x8 vf = (bf16x8){lo[0], lo[1], lo[2], lo[3], hi[0], hi[1], hi[2], hi[3]}; c.o[db] = __builtin_amdgcn_mfma_f32_32x32x16_bf16(vf, pf0, c.o[db], 0, 0, 0); }
        { const s16x4 lo = f.lo[db * 2 + 1], hi = f.hi[db * 2 + 1]; const bf16x8 vf = (bf16x8){lo[0], lo[1], lo[2], lo[3], hi[0], hi[1], hi[2], hi[3]}; c.o[db] = __builtin_amdgcn_mfma_f32_32x32x16_bf16(vf, pf1, c.o[db], 0, 0, 0); }
    }
}
__device__ __forceinline__ void tile64(WaveCtx& c, const LAS unsigned char* kb, const LAS unsigned char* vb, int qq, int h, int MASK  ) {
    bf16x8 kf[8];
#pragma unroll
    for (int ds = 0; ds < 4; ++ds) { kf[2 * ds] = *(const LAS bf16x8*)(kb + c.koff[ds]); kf[2 * ds + 1] = *(const LAS bf16x8*)(kb + 4096 + c.koff[ds]); }
    ATT_SB();
    f32x16 p0 = __builtin_amdgcn_mfma_f32_32x32x16_bf16(kf[0], c.qf[0], c.negm, 0, 0, 0), p1 = __builtin_amdgcn_mfma_f32_32x32x16_bf16(kf[1], c.qf[0], c.negm, 0, 0, 0);
#pragma unroll
    for (int ds = 1; ds < 4; ++ds) { p0 = __builtin_amdgcn_mfma_f32_32x32x16_bf16(kf[2 * ds], c.qf[ds], p0, 0, 0, 0); p1 = __builtin_amdgcn_mfma_f32_32x32x16_bf16(kf[2 * ds + 1], c.qf[ds], p1, 0, 0, 0); }
    VFrag f0, f1; load_v32(c, f0, vb); load_v32(c, f1, vb + 4096);
    ATT_SB();
    asm volatile("s_nop 15\n\ts_nop 7" : "+v"(p0), "+v"(p1));
    if (MASK == 1) {
#pragma unroll
        for (int r = 0; r < 16; ++r) { const int kk = crow(r, h); if (kk < qq) p0[r] = NEG; if (kk + 32 < qq) p1[r] = NEG; } }
    if (MASK == 2) {
#pragma unroll
        for (int r = 0; r < 16; ++r) { const int kk = crow(r, h); if (kk > qq) p0[r] = NEG; if (kk + 32 > qq) p1[r] = NEG; } }
    float ma = max3f(p0[0], p0[1], p1[0]), mb = max3f(p0[2], p0[3], p1[1]); ma = max3f(ma, p1[2], p1[3]);
#pragma unroll
    for (int r = 4; r < 16; r += 4) { ma = max3f(ma, p0[r], p0[r + 1]); mb = max3f(mb, p0[r + 2], p0[r + 3]); ma = max3f(ma, p1[r], p1[r + 1]); mb = max3f(mb, p1[r + 2], p1[r + 3]); }
    float dl;
    if (update_ref(c, max2f(ma, mb), dl)) {
#pragma unroll
        for (int r = 0; r < 16; ++r) { p0[r] -= dl; p1[r] -= dl; } }
    float ls = 0.f;
#pragma unroll
    for (int r = 0; r < 16; ++r) { p0[r] = __builtin_amdgcn_exp2f(p0[r]); p1[r] = __builtin_amdgcn_exp2f(p1[r]); ls += p0[r] + p1[r]; }
    c.l += ls;
    pv32(c, p0, f0); pv32(c, p1, f1);
}
constexpr float ATT_FAST_BOUND = 60.0f;
__device__ __forceinline__ void tile64_fast(WaveCtx& c, const LAS unsigned char* kb, const LAS unsigned char* vb, int qq, int h, int MASK  ) {
    bf16x8 kf[8];
#pragma unroll
    for (int ds = 0; ds < 4; ++ds) { kf[2 * ds] = *(const LAS bf16x8*)(kb + c.koff[ds]); kf[2 * ds + 1] = *(const LAS bf16x8*)(kb + 4096 + c.koff[ds]); }
    ATT_SB();
    f32x16 p0, p1;
#pragma unroll
    for (int r = 0; r < 16; ++r) { p0[r] = 0.f; p1[r] = 0.f; }
#pragma unroll
    for (int ds = 0; ds < 4; ++ds) { p0 = __builtin_amdgcn_mfma_f32_32x32x16_bf16(kf[2 * ds], c.qf[ds], p0, 0, 0, 0); p1 = __builtin_amdgcn_mfma_f32_32x32x16_bf16(kf[2 * ds + 1], c.qf[ds], p1, 0, 0, 0); }
    VFrag f0, f1; load_v32(c, f0, vb); load_v32(c, f1, vb + 4096);
    ATT_SB();
    if (MASK == 1) {
#pragma unroll
        for (int r = 0; r < 16; ++r) { const int kk = crow(r, h); if (kk < qq) p0[r] = NEG; if (kk + 32 < qq) p1[r] = NEG; } }
    if (MASK == 2) {
#pragma unroll
        for (int r = 0; r < 16; ++r) { const int kk = crow(r, h); if (kk > qq) p0[r] = NEG; if (kk + 32 > qq) p1[r] = NEG; } }
    float ls = 0.f;
#pragma unroll
    for (int r = 0; r < 16; ++r) { p0[r] = __builtin_amdgcn_exp2f(p0[r]); p1[r] = __builtin_amdgcn_exp2f(p1[r]); ls += p0[r] + p1[r]; }
    c.l += ls;
    pv32(c, p0, f0); pv32(c, p1, f1);
}
__device__ __forceinline__ void ldk64(bf16x8 (&kf)[8], const WaveCtx& c, const LAS unsigned char* kb) {
#pragma unroll
    for (int ds = 0; ds < 4; ++ds) { kf[2 * ds] = *(const LAS bf16x8*)(kb + c.koff[ds]); kf[2 * ds + 1] = *(const LAS bf16x8*)(kb + 4096 + c.koff[ds]); }
}
template <bool PRE>
__device__ __forceinline__ void tile64_fast_core(WaveCtx& c, const bf16x8 (&kf)[8], bf16x8 (&kn)[8], const LAS unsigned char* knb, const LAS unsigned char* vb, int qq, int h, int MASK  ) {
    f32x16 p0, p1;
#pragma unroll
    for (int r = 0; r < 16; ++r) { p0[r] = 0.f; p1[r] = 0.f; }
#pragma unroll
    for (int ds = 0; ds < 4; ++ds) { p0 = __builtin_amdgcn_mfma_f32_32x32x16_bf16(kf[2 * ds], c.qf[ds], p0, 0, 0, 0); p1 = __builtin_amdgcn_mfma_f32_32x32x16_bf16(kf[2 * ds + 1], c.qf[ds], p1, 0, 0, 0); }
    VFrag f0, f1; load_v32(c, f0, vb); load_v32(c, f1, vb + 4096);
    if (PRE) ldk64(kn, c, knb);
    if (MASK == 1) {
#pragma unroll
        for (int r = 0; r < 16; ++r) { const int kk = crow(r, h); if (kk < qq) p0[r] = NEG; if (kk + 32 < qq) p1[r] = NEG; } }
    if (MASK == 2) {
#pragma unroll
        for (int r = 0; r < 16; ++r) { const int kk = crow(r, h); if (kk > qq) p0[r] = NEG; if (kk + 32 > qq) p1[r] = NEG; } }
    float ls = 0.f;
#pragma unroll
    for (int r = 0; r < 16; ++r) { p0[r] = __builtin_amdgcn_exp2f(p0[r]); p1[r] = __builtin_amdgcn_exp2f(p1[r]); ls += p0[r] + p1[r]; }
    c.l += ls;
    pv32(c, p0, f0); pv32(c, p1, f1);
}
__device__ __forceinline__ void tile32_b_fast(WaveCtx& c, const LAS unsigned char* kb, const int (&koffL)[4], const LAS unsigned char* vb, const LAS float* brow, bool rowok, int kstart, int wst, int h) {
    bf16x8 kf[4];
#pragma unroll
    for (int ds = 0; ds < 4; ++ds) kf[ds] = *(const LAS bf16x8*)(kb + koffL[ds]);
    float bv[16];
#pragma unroll
    for (int r = 0; r < 16; ++r) bv[r] = brow[(r & 3) + 8 * (r >> 2)];
    ATT_SB();
    f32x16 p0;
#pragma unroll
    for (int r = 0; r < 16; ++r) p0[r] = 0.f;
#pragma unroll
    for (int ds = 0; ds < 4; ++ds) p0 = __builtin_amdgcn_mfma_f32_32x32x16_bf16(kf[ds], c.qf[ds], p0, 0, 0, 0);
    VFrag f0; load_v32(c, f0, vb);
    ATT_SB();
    float ls = 0.f;
#pragma unroll
    for (int r = 0; r < 16; ++r) { const int kc = kstart + (r & 3) + 8 * (r >> 2) + 4 * h; const float sv = (rowok && kc >= wst && kc < wst + 16) ? p0[r] + bv[r] : NEG; p0[r] = __builtin_amdgcn_exp2f(sv); ls += p0[r]; }
    c.l += ls;
    pv32(c, p0, f0);
}
struct B32In { bf16x8 kf[4]; float bv[16]; };
__device__ __forceinline__ void ld_b32(B32In& in, const LAS unsigned char* kb, const int (&koffL)[4], const LAS float* brow) {
#pragma unroll
    for (int ds = 0; ds < 4; ++ds) in.kf[ds] = *(const LAS bf16x8*)(kb + koffL[ds]);
#pragma unroll
    for (int r = 0; r < 16; ++r) in.bv[r] = brow[(r & 3) + 8 * (r >> 2)];
}
template <bool PRE>
__device__ __forceinline__ void tile32_b_fast_core(WaveCtx& c, const B32In& in, B32In& nx, const LAS unsigned char* knb, const int (&koffL)[4], const LAS float* nbrow, const LAS unsigned char* vb, bool rowok, int kstart, int wst, int h) {
    f32x16 p0;
#pragma unroll
    for (int r = 0; r < 16; ++r) p0[r] = 0.f;
#pragma unroll
    for (int ds = 0; ds < 4; ++ds) p0 = __builtin_amdgcn_mfma_f32_32x32x16_bf16(in.kf[ds], c.qf[ds], p0, 0, 0, 0);
    VFrag f0; load_v32(c, f0, vb);
    if (PRE) ld_b32(nx, knb, koffL, nbrow);
    float ls = 0.f;
#pragma unroll
    for (int r = 0; r < 16; ++r) { const int kc = kstart + (r & 3) + 8 * (r >> 2) + 4 * h; const float sv = (rowok && kc >= wst && kc < wst + 16) ? p0[r] + in.bv[r] : NEG; p0[r] = __builtin_amdgcn_exp2f(sv); ls += p0[r]; }
    c.l += ls;
    pv32(c, p0, f0);
}
__device__ __forceinline__ void ldk32(bf16x8 (&kf)[4], const LAS unsigned char* kb, const int (&koffL)[4]) {
#pragma unroll
    for (int ds = 0; ds < 4; ++ds) kf[ds] = *(const LAS bf16x8*)(kb + koffL[ds]);
}
__device__ __forceinline__ void ldbias(float (&bv)[16], const LAS float* brow) {
#pragma unroll
    for (int r = 0; r < 16; ++r) bv[r] = brow[(r & 3) + 8 * (r >> 2)];
}
template <bool PRE>
__device__ __forceinline__ void tile32_b_fast_core(WaveCtx& c, const bf16x8 (&kf)[4], const float (&bv)[16], bf16x8 (&kn)[4], float (&bvn)[16], const LAS unsigned char* knb, const LAS float* nbrow, const int (&koffL)[4], const LAS unsigned char* vb, bool rowok, int kstart, int wst, int h) {
    f32x16 p0;
#pragma unroll
    for (int r = 0; r < 16; ++r) { const int kc = kstart + (r & 3) + 8 * (r >> 2) + 4 * h; p0[r] = (rowok && kc >= wst && kc < wst + 16) ? bv[r] : NEG; }
#pragma unroll
    for (int ds = 0; ds < 4; ++ds) p0 = __builtin_amdgcn_mfma_f32_32x32x16_bf16(kf[ds], c.qf[ds], p0, 0, 0, 0);
    VFrag f0; load_v32(c, f0, vb);
    if (PRE) { ldk32(kn, knb, koffL); ldbias(bvn, nbrow); }
    float ls = 0.f;
#pragma unroll
    for (int r = 0; r < 16; ++r) { p0[r] = __builtin_amdgcn_exp2f(p0[r]); ls += p0[r]; }
    c.l += ls;
    pv32(c, p0, f0);
}
__device__ __forceinline__ void tile32_b(WaveCtx& c, const LAS unsigned char* kb, const int (&koffL)[4], const LAS unsigned char* vb, const LAS float* brow, bool rowok, int kstart, int wst, int h) {
    bf16x8 kf[4];
#pragma unroll
    for (int ds = 0; ds < 4; ++ds) kf[ds] = *(const LAS bf16x8*)(kb + koffL[ds]);
    float bv[16];
#pragma unroll
    for (int r = 0; r < 16; ++r) bv[r] = brow[(r & 3) + 8 * (r >> 2)];
    ATT_SB();
    f32x16 p0 = __builtin_amdgcn_mfma_f32_32x32x16_bf16(kf[0], c.qf[0], c.negm, 0, 0, 0);
#pragma unroll
    for (int ds = 1; ds < 4; ++ds) p0 = __builtin_amdgcn_mfma_f32_32x32x16_bf16(kf[ds], c.qf[ds], p0, 0, 0, 0);
    VFrag f0; load_v32(c, f0, vb);
    ATT_SB();
    asm volatile("s_nop 15\n\ts_nop 7" : "+v"(p0));
#pragma unroll
    for (int r = 0; r < 16; ++r) { const int kc = kstart + (r & 3) + 8 * (r >> 2) + 4 * h; p0[r] = (rowok && kc >= wst && kc < wst + 16) ? p0[r] + bv[r] : NEG; }
    float ma = max3f(p0[0], p0[1], p0[2]), mb = max3f(p0[3], p0[4], p0[5]);
    ma = max3f(ma, p0[6], p0[7]); mb = max3f(mb, p0[8], p0[9]); ma = max3f(ma, p0[10], p0[11]); mb = max3f(mb, p0[12], p0[13]); ma = max3f(ma, p0[14], p0[15]);
    float dl;
    if (update_ref(c, max2f(ma, mb), dl)) {
#pragma unroll
        for (int r = 0; r < 16; ++r) p0[r] -= dl; }
    float ls = 0.f;
#pragma unroll
    for (int r = 0; r < 16; ++r) { p0[r] = __builtin_amdgcn_exp2f(p0[r]); ls += p0[r]; }
    c.l += ls;
    pv32(c, p0, f0);
}
__device__ __forceinline__ void wave_store(const WaveCtx& c, int lane, bf16* orow  ) {
    const int h = lane >> 5;
    const float lt = c.l + __shfl_xor(c.l, 32), rl = (FP8_O ? O8_SCALE : 1.0f) / lt;
    if (FP8_O) {
#pragma unroll
        for (int db = 0; db < 2; ++db) {
            unsigned d[4];
#pragma unroll
            for (int g = 0; g < 4; ++g) { int w = 0; w = __builtin_amdgcn_cvt_pk_fp8_f32(c.o[db][4 * g] * rl, c.o[db][4 * g + 1] * rl, w, false); w = __builtin_amdgcn_cvt_pk_fp8_f32(c.o[db][4 * g + 2] * rl, c.o[db][4 * g + 3] * rl, w, true); d[g] = (unsigned)w; }
            { auto r = __builtin_amdgcn_permlane32_swap(d[0], d[1], false, false); d[0] = r[0]; d[1] = r[1]; }
            { auto r = __builtin_amdgcn_permlane32_swap(d[2], d[3], false, false); d[2] = r[0]; d[3] = r[1]; }
            { auto r = __builtin_amdgcn_permlane32_swap(d[0], d[2], false, false); d[0] = r[0]; d[2] = r[1]; }
            { auto r = __builtin_amdgcn_permlane32_swap(d[1], d[3], false, false); d[1] = r[0]; d[3] = r[1]; }
            u32x4 w; w.x = d[0]; w.y = d[1]; w.z = d[2]; w.w = d[3];
            *(u32x4*)((unsigned char*)orow + 32 * db + 16 * h) = w;
        }
    } else {
#pragma unroll
        for (int db = 0; db < 2; ++db)
#pragma unroll
            for (int g = 0; g < 4; ++g) { u32x2 w; w.x = cvtpk(c.o[db][4 * g] * rl, c.o[db][4 * g + 1] * rl); w.y = cvtpk(c.o[db][4 * g + 2] * rl, c.o[db][4 * g + 3] * rl);
                *(u32x2*)(orow + 32 * db + 8 * g + 4 * h) = w; }
    }
}
__device__ __forceinline__ void stage_q(LAS unsigned char* qbox, const bf16* qbase, unsigned qoff) {
    const unsigned qd = (unsigned)__builtin_amdgcn_readfirstlane((int)(unsigned)(uintptr_t)qbox);
    ATT_GLDS(qoff, qbase, qd, 0); ATT_GLDS(qoff, qbase + 16, qd + 1024u, 0); ATT_GLDS(qoff, qbase + 32, qd + 2048u, 0); ATT_GLDS(qoff, qbase + 48, qd + 3072u, 0);
}
__device__ __forceinline__ void read_q(bf16x8 (&qf)[4], const LAS unsigned char* qbox, int lane) {
#pragma unroll
    for (int ds = 0; ds < 4; ++ds) qf[ds] = *(const LAS bf16x8*)(qbox + ds * 1024 + lane * 16);
}
__device__ __forceinline__ void wave_pack(const WaveCtx& c, u32x4 (&w)[2]) {
    const float lt = c.l + __shfl_xor(c.l, 32), rl = O8_SCALE / lt;
#pragma unroll
    for (int db = 0; db < 2; ++db) {
        unsigned d[4];
#pragma unroll
        for (int g = 0; g < 4; ++g) { int t = 0; t = __builtin_amdgcn_cvt_pk_fp8_f32(c.o[db][4 * g] * rl, c.o[db][4 * g + 1] * rl, t, false); t = __builtin_amdgcn_cvt_pk_fp8_f32(c.o[db][4 * g + 2] * rl, c.o[db][4 * g + 3] * rl, t, true); d[g] = (unsigned)t; }
        { auto r = __builtin_amdgcn_permlane32_swap(d[0], d[1], false, false); d[0] = r[0]; d[1] = r[1]; }
        { auto r = __builtin_amdgcn_permlane32_swap(d[2], d[3], false, false); d[2] = r[0]; d[3] = r[1]; }
        { auto r = __builtin_amdgcn_permlane32_swap(d[0], d[2], false, false); d[0] = r[0]; d[2] = r[1]; }
        { auto r = __builtin_amdgcn_permlane32_swap(d[1], d[3], false, false); d[1] = r[0]; d[3] = r[1]; }
        w[db].x = d[0]; w[db].y = d[1]; w[db].z = d[2]; w[db].w = d[3];
    }
}
#define ATT_WAIT_BAR() do { asm volatile("s_waitcnt vmcnt(0)" ::: "memory"); __syncthreads(); } while (0)

struct UnitA { int b, kvh, Q0, qrow0, nl, tl0, nt; };
__device__ __forceinline__ UnitA decode_a(int u) {
    UnitA d;
    if (u < 2048) { d.b = u >> 9; d.kvh = (u >> 7) & 3; d.Q0 = (u & 127) * 64; d.qrow0 = d.b * S + d.Q0;
        d.tl0 = d.Q0 >= 128 ? 0 : (128 - d.Q0) / 64; const int t1 = (S + 64 - d.Q0) / 64; d.nl = (t1 < 4 ? t1 : 4) - d.tl0 + 1; }
    else { const int v = u - 2048; d.b = v >> 4; d.kvh = (v >> 2) & 3; d.Q0 = 0; d.qrow0 = NLAT + d.b * CTX + (v & 3) * 64; d.nl = 0; d.tl0 = 0; }
    d.nt = d.nl + 4; return d;
}
__device__ __forceinline__ int rowbase_a(const UnitA& d, int j) { return j < d.nl ? d.b * S + d.Q0 - 128 + 64 * (d.tl0 + j) : NLAT + d.b * CTX + 64 * (j - d.nl); }
__device__ __forceinline__ void stage_step_a(LAS unsigned char* lds, const UnitA& d, int s, int buf, const bf16* Kt, const bf16* Vt, const StageOff& so, int wave) {
#pragma unroll
    for (int sub = 0; sub < 2; ++sub) { const int j = 2 * s + sub; if (j < d.nt) { const size_t o = (size_t)rowbase_a(d, j) * 256 + d.kvh * 64; stage_tile(lds, buf * 2 + sub, Kt + o, Vt + o, so, wave); } }
}
__device__ __forceinline__ void qk64(const WaveCtx& c, const bf16x8 (&kf)[8], f32x16& p0, f32x16& p1) {
#pragma unroll
    for (int r = 0; r < 16; ++r) { p0[r] = 0.f; p1[r] = 0.f; }
#pragma unroll
    for (int ds = 0; ds < 4; ++ds) { p0 = __builtin_amdgcn_mfma_f32_32x32x16_bf16(kf[2 * ds], c.qf[ds], p0, 0, 0, 0); p1 = __builtin_amdgcn_mfma_f32_32x32x16_bf16(kf[2 * ds + 1], c.qf[ds], p1, 0, 0, 0); }
}
template <int MASK>
__device__ __forceinline__ void sm_pv64(WaveCtx& c, f32x16& p0, f32x16& p1, const LAS unsigned char* vb, int qq, int h) {
    VFrag f0; load_v32(c, f0, vb);
    if (MASK == 1) {
#pragma unroll
        for (int r = 0; r < 16; ++r) { const int kk = crow(r, h); if (kk < qq) p0[r] = NEG; if (kk + 32 < qq) p1[r] = NEG; } }
    if (MASK == 2) {
#pragma unroll
        for (int r = 0; r < 16; ++r) { const int kk = crow(r, h); if (kk > qq) p0[r] = NEG; if (kk + 32 > qq) p1[r] = NEG; } }
    float ls = 0.f;
#pragma unroll
    for (int r = 0; r < 16; ++r) { p0[r] = __builtin_amdgcn_exp2f(p0[r]); p1[r] = __builtin_amdgcn_exp2f(p1[r]); ls += p0[r] + p1[r]; }
    c.l += ls;
    VFrag f1; load_v32(c, f1, vb + 4096);
    pv32(c, p0, f0); pv32(c, p1, f1);
}
__device__ __forceinline__ LAS unsigned char* ringk(LAS unsigned char* lds, int r) { return lds + (r < 4 ? 65536 + r * TILEB : 135168); }
__device__ __forceinline__ LAS unsigned char* ringv(LAS unsigned char* lds, int r) { return lds + (r < 4 ? 98304 + r * TILEB : 143360); }
template <bool FAST>
__device__ __forceinline__ void attn_a_impl(LAS unsigned char* lds, int u0, int ucount, int uextra, const bf16* Q, const bf16* Kt, const bf16* Vt, bf16* O, const float* sink, const float* qgain, const float* kgain, const int kwave) {
    const int tid = TIDX, lane = tid & 63, wave = __builtin_amdgcn_readfirstlane(tid >> 6);
    const int g = wave >> 1, qs = wave & 1, h = lane >> 5, qq = 32 * qs + (lane & 31);
    const int ntot = ucount + (uextra >= 0 ? 1 : 0);
    if (ntot == 0) return;
    WaveCtx c; wave_offsets(c, lane, 0);
    const StageOff so = stage_off(tid, 256);
    const UnitA first = decode_a(ucount > 0 ? u0 : uextra);
    const int b = first.b, kvh = first.kvh, qb0 = first.Q0 >> 6;
    const bf16* Kl = Kt + (size_t)(b * S) * 256 + kvh * 64; const bf16* Vl = Vt + (size_t)(b * S) * 256 + kvh * 64;
    const bf16* Kc = Kt + (size_t)(NLAT + b * CTX) * 256 + kvh * 64; const bf16* Vc = Vt + (size_t)(NLAT + b * CTX) * 256 + kvh * 64;
#pragma unroll
    for (int i = 0; i < 4; ++i) stage_tile_at(lds + i * TILEB, lds + 32768 + i * TILEB, Kc + (size_t)(64 * i) * 256, Vc + (size_t)(64 * i) * 256, so, wave);
    if (ucount > 0) for (int kt = qb0 - 2; kt <= qb0 + 2; ++kt) if (kt >= 0 && kt < S / 64) stage_tile_at(ringk(lds, kt % 5), ringv(lds, kt % 5), Kl + (size_t)(64 * kt) * 256, Vl + (size_t)(64 * kt) * 256, so, wave);
    bf16x8 qn[4]; load_q(qn, lane, Q + (size_t)(first.qrow0 + qq) * 1024 + (kvh * 4 + g) * 64);
    u32x4 pend[2]; unsigned pend_off = 0u;
    ATT_WAIT_BAR();
    for (int ui = 0; ui < ntot; ++ui) {
        const bool lat = ui < ucount, has_next = ui + 1 < ntot;
        const UnitA cur = decode_a(lat ? u0 + ui : uextra);
        const UnitA nxt = decode_a(has_next ? (ui + 1 < ucount ? u0 + ui + 1 : uextra) : (lat ? u0 + ui : uextra));
        const int head = kvh * 4 + g, qb = cur.Q0 >> 6;
#pragma unroll
        for (int ds = 0; ds < 4; ++ds) c.qf[ds] = qn[ds];
        if (FP8_O && ui > 0) { *(u32x4*)((unsigned char*)O + pend_off) = pend[0]; *(u32x4*)((unsigned char*)O + pend_off + 32u) = pend[1]; }
        if (FAST) wave_reset(c, lane, 0.0f, __builtin_amdgcn_exp2f(sink[head] * LOG2E), false); else wave_reset(c, lane, sink[head] * LOG2E, 1.0f);
#define ATT_A_VALID(t) ((t) >= 4 || (lat && qb - 2 + (t) >= 0 && qb - 2 + (t) < S / 64))
#define ATT_A_KB(t) ((t) >= 4 ? lds + ((t) - 4) * TILEB : ringk(lds, (qb + 3 + (t)) % 5))
#define ATT_A_VB(t) ((t) >= 4 ? lds + 32768 + ((t) - 4) * TILEB : ringv(lds, (qb + 3 + (t)) % 5))
        const bool interior = FAST && lat && qb >= 2 && qb + 2 < S / 64;
        if (interior) {
            const int r0 = (qb + 3) % 5;
#define ATT_I_SLOT(i) (r0 + (i) >= 5 ? r0 + (i) - 5 : r0 + (i))
#define ATT_I_KB(i) ((i) < 5 ? ringk(lds, ATT_I_SLOT(i)) : lds + ((i) - 5) * TILEB)
#define ATT_I_VB(i) ((i) < 5 ? ringv(lds, ATT_I_SLOT(i)) : lds + 32768 + ((i) - 5) * TILEB)
#define ATT_I_ITER(i, P0, P1, N0, N1, MSK) do { \
                if ((i) == 2) { ATT_WAIT_BAR(); \
                    if (has_next && ui + 1 < ucount) { const int kt = qb + 3; if (kt < S / 64) stage_tile_at(ringk(lds, kt % 5), ringv(lds, kt % 5), Kl + (size_t)(64 * kt) * 256, Vl + (size_t)(64 * kt) * 256, so, wave); } \
                    } \
                if ((i) == 7) load_q(qn, lane, Q + (size_t)(nxt.qrow0 + qq) * 1024 + (kvh * 4 + g) * 64); \
                if ((i) < 8) qk64(c, kf, N0, N1); \
                if ((i) < 7) ldk64(kf, c, ATT_I_KB((i) + 2)); \
                sm_pv64<MSK>(c, P0, P1, ATT_I_VB(i), qq, h); ATT_SB(); } while (0)
            bf16x8 kf[8]; f32x16 pa0, pa1, pb0, pb1;
            ldk64(kf, c, ATT_I_KB(0)); qk64(c, kf, pa0, pa1); ldk64(kf, c, ATT_I_KB(1));
            ATT_I_ITER(0, pa0, pa1, pb0, pb1, 1); ATT_I_ITER(1, pb0, pb1, pa0, pa1, 0); ATT_I_ITER(2, pa0, pa1, pb0, pb1, 0); ATT_I_ITER(3, pb0, pb1, pa0, pa1, 0); ATT_I_ITER(4, pa0, pa1, pb0, pb1, 2);
            ATT_I_ITER(5, pb0, pb1, pa0, pa1, 0); ATT_I_ITER(6, pa0, pa1, pb0, pb1, 0); ATT_I_ITER(7, pb0, pb1, pa0, pa1, 0); ATT_I_ITER(8, pa0, pa1, pb0, pb1, 0);
        } else {
        if (FAST) {
            bf16x8 kfa[8], kfb[8];
            ldk64(kfa, c, ATT_A_KB(0));
#pragma nounroll
            for (int tp = 0; tp < 4; ++tp) {
                const int t0 = 2 * tp, t1 = t0 + 1, t2 = (t0 + 2) & 7;
                if (ATT_A_VALID(t0)) tile64_fast_core<true>(c, kfa, kfb, ATT_A_KB(t1), ATT_A_VB(t0), qq, h, t0 == 0 ? 1 : 0); else ldk64(kfb, c, ATT_A_KB(t1));
                if (ATT_A_VALID(t1)) tile64_fast_core<true>(c, kfb, kfa, ATT_A_KB(t2), ATT_A_VB(t1), qq, h, 0); else ldk64(kfa, c, ATT_A_KB(t2));
            }
        } else {
            for (int t = 0; t < 8; ++t) if (ATT_A_VALID(t)) tile64(c, ATT_A_KB(t), ATT_A_VB(t), qq, h, t == 0 ? 1 : 0);
        }
        ATT_WAIT_BAR();
        if (has_next && ui + 1 < ucount) { const int kt = qb + 3; if (kt < S / 64) stage_tile_at(ringk(lds, kt % 5), ringv(lds, kt % 5), Kl + (size_t)(64 * kt) * 256, Vl + (size_t)(64 * kt) * 256, so, wave); }
        load_q(qn, lane, Q + (size_t)(nxt.qrow0 + qq) * 1024 + (kvh * 4 + g) * 64);
        if (lat && qb + 2 < S / 64) {
            if (FAST) { bf16x8 kfa[8], kfb[8]; ldk64(kfa, c, ringk(lds, (qb + 2) % 5)); ATT_SB(); tile64_fast_core<false>(c, kfa, kfb, lds, ringv(lds, (qb + 2) % 5), qq, h, 2); }
            else tile64(c, ringk(lds, (qb + 2) % 5), ringv(lds, (qb + 2) % 5), qq, h, 2);
        }
        }
        if (FP8_O) { wave_pack(c, pend); pend_off = (unsigned)((cur.qrow0 + qq) * 1024 + head * 64 + 16 * h); }
        else wave_store(c, lane, O + (size_t)(cur.qrow0 + qq) * 1024 + head * 64);
    }
    if (FP8_O) { *(u32x4*)((unsigned char*)O + pend_off) = pend[0]; *(u32x4*)((unsigned char*)O + pend_off + 32u) = pend[1]; }
    __syncthreads();
}
__device__ __forceinline__ void attn_a_phase(LAS unsigned char* lds, int u0, int ucount, int uextra, const bf16* Q, const bf16* Kt, const bf16* Vt, bf16* O, const float* sink, const float* qgain, const float* kgain, const int kwave) {
    const int lane = TIDX & 63;
    const float gqm = wave_max(fabsf(qgain[lane])), gkm = wave_max(fabsf(kgain[lane])), skm = wave_max(fabsf(sink[lane & 15]));
    const bool fast = (64.0f * QSCALE * gqm * gkm <= ATT_FAST_BOUND) && (skm * LOG2E <= ATT_FAST_BOUND);
    if (fast) attn_a_impl<true>(lds, u0, ucount, uextra, Q, Kt, Vt, O, sink, qgain, kgain, kwave);
    else attn_a_impl<false>(lds, u0, ucount, uextra, Q, Kt, Vt, O, sink, qgain, kgain, kwave);
}
struct UnitB { int b, head, r0, klo, nt; };
__device__ __forceinline__ UnitB decode_b(int u) {
    UnitB d; d.b = u >> 9; d.head = (u >> 5) & 15; d.r0 = (u & 31) * 4;
    d.klo = min(max(d.r0 - 4, 0), 120); const int khi = min(max(d.r0 - 1, 0), 120) + 7; d.nt = 4 + (khi - d.klo + 1); return d;
}
__device__ __forceinline__ int rowbase_b(const UnitB& d, int j) { return j < 4 ? NLAT + d.b * CTX + 64 * j : d.b * S + (d.klo + j - 4) * 64; }
__device__ __forceinline__ void stage_step_b(LAS unsigned char* lds, const UnitB& d, int s, int buf, const bf16* Kt, const bf16* Vt, const StageOff& so, int wave) {
#pragma unroll
    for (int sub = 0; sub < 2; ++sub) { const int j = 2 * s + sub; if (j < d.nt) { const size_t o = (size_t)rowbase_b(d, j) * 1024 + d.head * 64; stage_tile(lds, buf * 2 + sub, Kt + o, Vt + o, so, wave); } }
}
template <bool FAST>
__device__ __forceinline__ void attn_b_impl(LAS unsigned char* lds, int u0, int ucount, const bf16* Q, const bf16* Kt, const bf16* Vt, bf16* O, const float* rpb, const float* qgain, const float* kgain, const int kwave) {
    const int tid = TIDX, lane = tid & 63, wave = __builtin_amdgcn_readfirstlane(tid >> 6);
    if (ucount <= 0) return;
    const int jb = wave & 3, rp = wave >> 2, h = lane >> 5, q31 = lane & 31;
    const int kstart = jb == 0 ? 0 : (jb == 1 ? 8 : (jb == 2 ? 24 : 32));
    const int qc = 16 * jb + (q31 & 15), wst = min(max(qc - 8, 0), 48);
    UnitB cur = decode_b(u0);
    LAS float* bt = (LAS float*)(lds + OFF_BIAS) + BIAS_PITCH;
    for (int i = tid; i < 15 * 31; i += NTHREADS) { const int dr = i / 31, dc = i - dr * 31; bt[dr * BIAS_PITCH + BIAS_ORG + dc] = rpb[(cur.head * 15 + dr) * 31 + dc] * LOG2E; }
    WaveCtx c; wave_offsets(c, lane, 0);
    LAS unsigned char* qbox = lds + OFF_QBOX + wave * 4096;
    int koffL[4];
    { const int row = kstart + q31;
#pragma unroll
      for (int ds = 0; ds < 4; ++ds) koffL[ds] = row * 128 + (((2 * ds + h) ^ ((row >> 1) & 7)) << 4); }
    const StageOff so = stage_off(tid, 1024); const unsigned qoff = (unsigned)(((2 * rp + (q31 >> 4)) * 64 + qc) * 1024 + 8 * h) * 2u;
    int gs = 0;
    stage_step_b(lds, cur, 0, 0, Kt, Vt, so, wave);
    stage_q(qbox, Q + (size_t)(cur.b * S + cur.r0 * 64) * 1024 + cur.head * 64, qoff);
    u32x4 pend[2]; unsigned pend_off = 0u;
    ATT_WAIT_BAR();
    for (int ui = 0; ui < ucount; ++ui) {
        const bool has_next = ui + 1 < ucount;
        const UnitB nxt = decode_b(has_next ? u0 + ui + 1 : u0);
        const int nsteps = (cur.nt + 1) >> 1;
        const int qrow = cur.r0 + 2 * rp + (q31 >> 4);
        const int rsq = min(max(qrow - 4, 0), 120);
        const int rs_a = min(max(cur.r0 + 2 * rp - 4, 0), 120), rs_b = min(max(cur.r0 + 2 * rp + 1 - 4, 0), 120);
        read_q(c.qf, qbox, lane);
        if (FP8_O && ui > 0) { *(u32x4*)((unsigned char*)O + pend_off) = pend[0]; *(u32x4*)((unsigned char*)O + pend_off + 32u) = pend[1]; }
        wave_reset(c, lane, 0.0f, 0.0f, !FAST);
        for (int s = 0; s < 2; ++s) {
            if (FAST) {
                const int slot = (gs & 1) * 2;
                bf16x8 kfa[8], kfb[8];
                ldk64(kfa, c, lds + OFF_K + slot * TILEB);
                stage_step_b(lds, cur, s + 1, (gs + 1) & 1, Kt, Vt, so, wave);
                ATT_SB();
                tile64_fast_core<true>(c, kfa, kfb, lds + OFF_K + (slot + 1) * TILEB, lds + OFF_V + slot * TILEB, 0, h, 0);
                tile64_fast_core<false>(c, kfb, kfa, lds, lds + OFF_V + (slot + 1) * TILEB, 0, h, 0);
            } else {
                stage_step_b(lds, cur, s + 1, (gs + 1) & 1, Kt, Vt, so, wave);
#pragma unroll
                for (int sub = 0; sub < 2; ++sub) { const int slot = (gs & 1) * 2 + sub; tile64(c, lds + OFF_K + slot * TILEB, lds + OFF_V + slot * TILEB, 0, h, 0); }
            }
            ++gs;
            ATT_WAIT_BAR();
        }
        for (int s = 2; s < nsteps; ++s) {
            if (FAST) {
                const int slot = (gs & 1) * 2, kra = cur.klo + 2 * s - 4, krb = kra + 1;
                const bool acta = kra >= rs_a && kra <= rs_b + 7, actb = (2 * s + 1 < cur.nt) && krb >= rs_a && krb <= rs_b + 7;
                const LAS float* browa = bt + (kra - qrow + 7) * BIAS_PITCH + BIAS_ORG + 15 - qc + kstart + 4 * h;
                bf16x8 kfa[4], kfb[4]; float bva[16], bvb[16];
                if (s + 1 < nsteps) stage_step_b(lds, cur, s + 1, (gs + 1) & 1, Kt, Vt, so, wave);
                else if (has_next) { stage_step_b(lds, nxt, 0, (gs + 1) & 1, Kt, Vt, so, wave); stage_q(qbox, Q + (size_t)(nxt.b * S + nxt.r0 * 64) * 1024 + nxt.head * 64, qoff); }
                if (acta) {
                    ldk32(kfa, lds + OFF_K + slot * TILEB, koffL); ldbias(bva, browa);
                    ATT_SB();
                    tile32_b_fast_core<true>(c, kfa, bva, kfb, bvb, lds + OFF_K + (slot + 1) * TILEB, browa + BIAS_PITCH, koffL, lds + OFF_V + slot * TILEB + kstart * 128, kra >= rsq && kra <= rsq + 7, kstart, wst, h);
                } else if (actb) { ldk32(kfb, lds + OFF_K + (slot + 1) * TILEB, koffL); ldbias(bvb, browa + BIAS_PITCH); }
                if (actb) tile32_b_fast_core<false>(c, kfb, bvb, kfa, bva, lds, browa, koffL, lds + OFF_V + (slot + 1) * TILEB + kstart * 128, krb >= rsq && krb <= rsq + 7, kstart, wst, h);
            } else {
                if (s + 1 < nsteps) stage_step_b(lds, cur, s + 1, (gs + 1) & 1, Kt, Vt, so, wave);
                else if (has_next) { stage_step_b(lds, nxt, 0, (gs + 1) & 1, Kt, Vt, so, wave); stage_q(qbox, Q + (size_t)(nxt.b * S + nxt.r0 * 64) * 1024 + nxt.head * 64, qoff); }
#pragma unroll
                for (int sub = 0; sub < 2; ++sub) {
                    const int j = 2 * s + sub, kr = cur.klo + j - 4;
                    if (j < cur.nt && kr >= rs_a && kr <= rs_b + 7) {
                        const int slot = (gs & 1) * 2 + sub;
                        const bool rowok = kr >= rsq && kr <= rsq + 7;
                        const LAS float* brow = bt + (kr - qrow + 7) * BIAS_PITCH + BIAS_ORG + 15 - qc + kstart + 4 * h;
                        tile32_b(c, lds + OFF_K + slot * TILEB, koffL, lds + OFF_V + slot * TILEB + kstart * 128, brow, rowok, kstart, wst, h);
                    }
                }
            }
            ++gs;
            ATT_WAIT_BAR();
        }
        if (FP8_O) { wave_pack(c, pend); pend_off = (unsigned)((cur.b * S + qrow * 64 + qc) * 1024 + cur.head * 64 + 16 * h); }
        else wave_store(c, lane, O + (size_t)(cur.b * S + qrow * 64 + qc) * 1024 + cur.head * 64);
        cur = nxt;
    }
    if (FP8_O) { *(u32x4*)((unsigned char*)O + pend_off) = pend[0]; *(u32x4*)((unsigned char*)O + pend_off + 32u) = pend[1]; }
    __syncthreads();
}
__device__ __forceinline__ void attn_b_phase(LAS unsigned char* lds, int u0, int ucount, const bf16* Q, const bf16* Kt, const bf16* Vt, bf16* O, const float* rpb, const float* qgain, const float* kgain, const int kwave) {
    const int lane = TIDX & 63;
    float bmx = 0.f;
    {
        const f32x4* r4 = (const f32x4*)rpb; f32x4 bv[30];
#pragma unroll
        for (int k = 0; k < 30; ++k) { const int i = lane + 64 * k; bv[k] = r4[i < 1860 ? i : 1859]; }
#pragma unroll
        for (int k = 0; k < 30; ++k) bmx = fmaxf(fmaxf(bmx, fmaxf(fabsf(bv[k][0]), fabsf(bv[k][1]))), fmaxf(fabsf(bv[k][2]), fabsf(bv[k][3])));
    }
    const float gqm = wave_max(fabsf(qgain[lane])), gkm = wave_max(fabsf(kgain[lane]));
    const bool fast = 64.0f * QSCALE * gqm * gkm + wave_max(bmx) * LOG2E <= ATT_FAST_BOUND;
    if (fast) attn_b_impl<true>(lds, u0, ucount, Q, Kt, Vt, O, rpb, qgain, kgain, kwave);
    else attn_b_impl<false>(lds, u0, ucount, Q, Kt, Vt, O, rpb, qgain, kgain, kwave);
}
}


typedef __attribute__((address_space(1))) unsigned gu32;
#define XB_TMO      128
#define XB_XCNT(j)  (256  + 64 * (j))
#define XB_XSUB(j)  (1280 + 64 * (j))
#define XB_XGEN(j)  (2304 + 64 * (j))
#define XB_TOP      3328
#define XB_TOPGEN   3392
#define XCD_BAR_WORDS 3456
#define XB_SPIN_CAP (1u << 20)
__device__ __forceinline__ unsigned xb_ld(unsigned* p)              { return __hip_atomic_load(p, __ATOMIC_RELAXED, __HIP_MEMORY_SCOPE_AGENT); }
__device__ __forceinline__ unsigned xb_add(unsigned* p, unsigned v) { return __hip_atomic_fetch_add(p, v, __ATOMIC_RELAXED, __HIP_MEMORY_SCOPE_AGENT); }
__device__ __forceinline__ unsigned xb_xcc_id() { return (unsigned)__builtin_amdgcn_s_getreg((3 << 11) | 20) & 0xFu; }
#define XB_SPIN(cond, bar) do { unsigned _sp = 0; while (cond) { __builtin_amdgcn_s_sleep(1); \
    if ((++_sp & 255u) == 0u) { if (xb_ld(&(bar)[XB_TMO])) break; if (_sp > XB_SPIN_CAP) { atomicAdd(&(bar)[XB_TMO], 1u); break; } } } } while (0)
struct XcdBarrier { unsigned* bar; unsigned x; volatile LAS unsigned* st; };
__device__ __forceinline__ XcdBarrier xcd_barrier_post(unsigned* bar, volatile LAS unsigned* st, const int kwave) {
    XcdBarrier b; b.bar = bar; b.x = xb_xcc_id(); b.st = st;
    if (TIDX == 0) (void)xb_add(&bar[XB_XCNT(b.x)], 1u);
    return b;
}
__device__ __forceinline__ void xcd_barrier_complete(unsigned* bar, unsigned x, unsigned& nloc, unsigned& nx) {
    const unsigned G = gridDim.x * gridDim.y * gridDim.z;
    unsigned sum, cnt, mine, sp = 0u;
    for (;;) {
        sum = 0u; cnt = 0u; mine = 0u;
#pragma unroll
        for (unsigned j = 0; j < 16; ++j) { const unsigned c = xb_ld(&bar[XB_XCNT(j)]); sum += c; cnt += (c > 0u) ? 1u : 0u; mine = (j == x) ? c : mine; }
        if (sum == G) break;
        __builtin_amdgcn_s_sleep(1);
        if ((++sp & 255u) == 0u) { if (xb_ld(&bar[XB_TMO])) break; if (sp > XB_SPIN_CAP) { atomicAdd(&bar[XB_TMO], 1u); break; } }
    }
    nloc = mine > 0u ? mine : 1u; nx = cnt > 0u ? cnt : 1u;
}
__device__ __forceinline__ void xcd_barrier(const XcdBarrier& b, const int kwave) {
    asm volatile("s_waitcnt vmcnt(0)" ::: "memory");
    __syncthreads();
    if (TIDX == 0) {
        unsigned* bar = b.bar;
        __builtin_amdgcn_s_waitcnt(0);
        unsigned nloc = b.st[0], nx = b.st[1];
        if (nloc == 0u) { xcd_barrier_complete(bar, b.x, nloc, nx); b.st[0] = nloc; b.st[1] = nx; }
        const unsigned old = xb_add(&bar[XB_XSUB(b.x)], 1u);
        const unsigned gen = old / nloc;
        if (old + 1u == (gen + 1u) * nloc) {
            __builtin_amdgcn_fence(__ATOMIC_RELEASE, "agent");
            asm volatile("s_waitcnt vmcnt(0)" ::: "memory");
            const unsigned og = xb_add(&bar[XB_TOP], 1u);
            const unsigned tg = og / nx;
            if (og + 1u == (tg + 1u) * nx) xb_add(&bar[XB_TOPGEN], 1u);
            else XB_SPIN(xb_ld(&bar[XB_TOPGEN]) == tg, bar);
            __builtin_amdgcn_fence(__ATOMIC_ACQUIRE, "agent");
            xb_add(&bar[XB_XGEN(b.x)], 1u);
            asm volatile("s_waitcnt vmcnt(0)" ::: "memory");
        } else {
            XB_SPIN(xb_ld(&bar[XB_XGEN(b.x)]) == gen, bar);
            __builtin_amdgcn_fence(__ATOMIC_ACQUIRE, "agent");
            asm volatile("s_waitcnt vmcnt(0)" ::: "memory");
        }
    }
    __syncthreads();
}

constexpr int CI_QA = 16 * 48, CI_O = FP8_O ? 8 * 32 : 16 * 32, CI_QB = 16 * 96, WD_IPE = FP8_DOWN ? 512 : 1024  , CI_WD = 16 * WD_IPE, GU_IPM = FP8_GU ? 512 : 1024  , CI_WGU = 32 * GU_IPM;
constexpr int CS0 = 0, CS1 = CS0 + CI_QA + CI_O, CS2 = CS1 + CI_WD, CS3 = CS2 + CI_WGU, CS4 = CS3 + CI_QB + CI_O, CS5 = CS4 + CI_WGU, CS_END = CS5 + CI_WD;
__device__ __forceinline__ void conv_load8(const ConvJob& j, f32x4 (&v)[16], int lane) {
    const int nblk = j.N / 32, kb = j.item / nblk, nbk = j.item % nblk, k0 = 128 * kb, n0 = 32 * nbk;
    const int nq = lane & 7, kg = lane >> 3;
#pragma unroll
    for (int i = 0; i < 16; ++i) v[i] = __builtin_nontemporal_load((const f32x4*)(j.W + (size_t)(k0 + 16 * kg + i) * j.N + n0 + 4 * nq));
}
__device__ __forceinline__ void conv_store8(const ConvJob& j, const f32x4 (&v)[16], int lane) {
    const int nblk = j.N / 32, kb = j.item / nblk, nbk = j.item % nblk, k0 = 128 * kb, n0 = 32 * nbk;
    const int nq = lane & 7, kg = lane >> 3;
    unsigned char* Wt8 = (unsigned char*)j.Wt;
#pragma unroll
    for (int c = 0; c < 4; ++c) {
        u32x4 o;
#pragma unroll
        for (int q = 0; q < 4; ++q) { int w = 0; w = __builtin_amdgcn_cvt_pk_fp8_f32(v[4 * q][c] * W8_SCALE, v[4 * q + 1][c] * W8_SCALE, w, false); w = __builtin_amdgcn_cvt_pk_fp8_f32(v[4 * q + 2][c] * W8_SCALE, v[4 * q + 3][c] * W8_SCALE, w, true); o[q] = (unsigned)w; }
        const int row = conv_rowmap(j.mode & 7, n0 + 4 * nq + c);
        __builtin_nontemporal_store(o, (u32x4*)(Wt8 + (size_t)row * j.K + k0 + 16 * kg));
    }
}
__device__ __forceinline__ ConvJob conv_decode(const Args& a, int it) {
    unsigned char* ws = a.ws; ConvJob j;
    if (it < CS1) { if (it < CI_QA) j = ConvJob{a.in[8], (bf16*)(ws + WS_WQKVA), 1024, QKVA_N, 3, it}; else j = ConvJob{a.in[12], (bf16*)(ws + WS_WOA), 1024, 1024, FP8_O ? 8 : 0, it - CI_QA}; return j; }
    if (it >= CS3 && it < CS4) { const int r = it - CS3; if (r < CI_QB) j = ConvJob{a.in[13], (bf16*)(ws + WS_WQKVB), 1024, QKVB_N, 4, r}; else j = ConvJob{a.in[17], (bf16*)(ws + WS_WOB), 1024, 1024, FP8_O ? 8 : 0, r - CI_QB}; return j; }
    int l, r; bool down;
    if (it < CS2) { l = 0; down = true; r = it - CS1; } else if (it < CS3) { l = 0; down = false; r = it - CS2; } else if (it < CS5) { l = 1; down = false; r = it - CS4; } else { l = 1; down = true; r = it - CS5; }
    if (down) { const int e = r / WD_IPE, item = r % WD_IPE, le = l * 16 + e;
        if (FP8_DOWN) j = ConvJob{a.in[21] + (size_t)le * 2048 * 1024, (bf16*)(ws + WS_WD + (size_t)le * 1024 * 2048), 2048, 1024, 8, item};
        else j = ConvJob{a.in[21] + (size_t)le * 2048 * 1024, (bf16*)(ws + WS_WD) + (size_t)le * 1024 * 2048, 2048, 1024, 0, item}; }
    else { const int e = r / (2 * GU_IPM), which = (r / GU_IPM) & 1, item = r % GU_IPM, le = l * 16 + e;
        if (FP8_GU) j = ConvJob{(which ? a.in[20] : a.in[19]) + (size_t)le * 1024 * 2048, (bf16*)(ws + WS_WGU + (size_t)le * 4096 * 1024), 1024, 2048, 8 + 1 + which, item};
        else j = ConvJob{(which ? a.in[20] : a.in[19]) + (size_t)le * 1024 * 2048, (bf16*)(ws + WS_WGU) + (size_t)le * 4096 * 1024, 1024, 2048, 1 + which, item}; }
    return j;
}
#ifndef CONV_DEPTH
#define CONV_DEPTH 3
#endif
__device__ __forceinline__ void conv_span(const Args& a, int lo, int hi, int nw, int wid, const int kwave) {
    const int lane = TIDX & 63, wave = TIDX >> 6, stride = nw * NWAVES;
    for (int it = lo + wid * NWAVES + wave; it < hi; it += CONV_DEPTH * stride) {
        ConvJob j[CONV_DEPTH]; f32x4 v[CONV_DEPTH][8];
        bool any8 = false;
#pragma unroll
        for (int d = 0; d < CONV_DEPTH; ++d) if (it + d * stride < hi) { j[d] = conv_decode(a, it + d * stride); any8 = any8 || j[d].mode >= 8; }
        if (any8) {
#pragma unroll
            for (int d = 0; d < CONV_DEPTH; ++d) if (it + d * stride < hi) {
                if (j[d].mode >= 8) { f32x4 w[16]; conv_load8(j[d], w, lane); conv_store8(j[d], w, lane); }
                else { conv_load(j[d], v[0], lane); conv_store(j[d], v[0], lane); } }
        } else {
#pragma unroll
            for (int d = 0; d < CONV_DEPTH; ++d) if (it + d * stride < hi) conv_load(j[d], v[d], lane);
#pragma unroll
            for (int d = 0; d < CONV_DEPTH; ++d) if (it + d * stride < hi) conv_store(j[d], v[d], lane);
        }
    }
}
#ifndef Q2
#define Q2 5500
#endif
#ifndef Q4
#define Q4 5500
#endif
#ifndef Q6
#define Q6 5384
#endif
#ifndef Q8
#define Q8 8500
#endif
#ifndef Q10
#define Q10 5000
#endif
#ifndef Q14A
#define Q14A 2884
#endif
#ifndef Q14B
#define Q14B 4096
#endif
constexpr int F_P2_A = CS2, F_P2_B = F_P2_A + Q2, F_P4_A = F_P2_B, F_P4_B = F_P4_A + Q4, F_P6_A = F_P4_B, F_P6_B = F_P6_A + Q6;
constexpr int F_P8_A = CS4, F_P8_B = F_P8_A + Q8, F_P10_A = F_P8_B, F_P10_B = F_P10_A + Q10, F_P14_A = F_P10_B, F_P14_B = F_P14_A + Q14A;
constexpr int F_P14_C = CS5, F_P14_D = CS5 + Q14B;
static_assert(F_P6_B <= CS3 && F_P14_B <= CS5 && F_P14_D <= CS_END, "filler plan");

__global__ void __launch_bounds__(NTHREADS, 2) mega(Args a) {
    extern __shared__ __attribute__((aligned(16))) unsigned char lds_raw[];
    LAS unsigned char* lds = (LAS unsigned char*)lds_raw;
    const int kwave = __builtin_amdgcn_readfirstlane((int)(threadIdx.x >> 6));
    const int lo = a.ph_lo, hi = a.ph_hi;
    volatile LAS unsigned* MISC = (volatile LAS unsigned*)(lds + 131072);
    if (TIDX < 64) MISC[TIDX] = 0u;
    __syncthreads();
    XcdBarrier bar; bar.bar = (unsigned*)(a.ws + WS_CTL) + 4096; bar.x = 0; bar.st = nullptr;
    if (hi - lo > 1) bar = xcd_barrier_post((unsigned*)(a.ws + WS_CTL) + 4096, MISC + 8, kwave);
#define IN(k) (lo <= (k) && (k) < hi)
#define SEAM(k) do { if (IN(k) && IN((k) + 1)) xcd_barrier(bar, kwave); } while (0)
    unsigned char* ws = a.ws;
    const float* mod = (const float*)(ws + WS_MOD);
    LAS int* ldsidx = (LAS int*)(lds + IDX_OFF);
    const int G = gridDim.x, bx = blockIdx.x;
    const bool plan = (G == 256) && (hi - lo == 18);
#define FILL_TAIL(nwg_, A, B) do { if (plan) { const int rem_ = (nwg_) % G; if (rem_ && bx >= rem_) conv_span(a, (A), (B), G - rem_, bx - rem_, kwave); } } while (0)
    if (IN(0)) { p0_phase(a, lds, kwave);
        if (plan) { conv_span(a, CS0, CS2, G, bx, kwave); conv_span(a, F_P6_B, CS4, G, bx, kwave); conv_span(a, F_P14_B, CS5, G, bx, kwave); conv_span(a, F_P14_D, CS_END, G, bx, kwave); } else conv_span(a, 0, CS_END, G, bx, kwave); }
    SEAM(0);
    if (IN(1)) norm1_l0_phase(a, kwave);
    SEAM(1);
    if (IN(2)) {
        pg8::Sched Sc; Sc.init(NROWS / 256, QKVA_N / 256, G, bx, 0, ws + WS_WQKVA, 0, (size_t)256 * 1024 * 2); Sc.reph = GREPH(2);
        pg8::EpiQKV E{(bf16*)(ws + WS_Q), (bf16*)(ws + WS_K), (bf16*)(ws + WS_V), 256, 4, 1, a.in[9], a.in[10], (const float*)(ws + WS_ROPE), 1, QSCALE};
        pg8::gemm_phase<pg8::EpiQKV, false>(lds, (const char*)(ws + WS_HL), 1024, Sc, E, ldsidx, nullptr, kwave);
        FILL_TAIL((NROWS / 256) * (QKVA_N / 256), F_P2_A, F_P2_B);
    }
    SEAM(2);
    if (IN(3)) for (int rep_ = 0; rep_ < NREP(3); ++rep_) { if (rep_) xcd_barrier(bar, kwave);
        const int vcu = (G % 8 == 0) ? (bx % 8) * (G / 8) + bx / 8 : bx;
        att::attn_a_phase(lds, vcu * 8, vcu * 8 < 2048 ? 8 : 0, (vcu & 15) < 4 ? 2048 + (vcu >> 4) * 4 + (vcu & 3) : -1, (const bf16*)(ws + WS_Q), (const bf16*)(ws + WS_K), (const bf16*)(ws + WS_V), (bf16*)(ws + WS_O), a.in[11], a.in[9], a.in[10], kwave);
    }
    SEAM(3);
    if (IN(4)) {
        constexpr int EB = FP8_O ? 1 : 2;
        pg8::Sched Sc; Sc.init(NROWS / 256, 4, G, bx, 0, ws + WS_WOA, 0, (size_t)256 * 1024 * EB); Sc.reph = GREPH(4);
        pg8::EpiOproj E{a.in[0], a.in[2], a.out, (float*)(ws + WS_XC), mod + 0 * 5 * 6144 + 2 * 1024, FP8_O ? W8_INV / O8_SCALE : 1.0f};
        pg8::gemm_phase<pg8::EpiOproj, false, FP8_O != 0>(lds, (const char*)(ws + WS_O), 1024 * EB / 2, Sc, E, ldsidx, nullptr, kwave);
        FILL_TAIL((NROWS / 256) * 4, F_P4_A, F_P4_B);
    }
    SEAM(4);
    if (IN(5)) norm2_router_phase(a, 0, NROWS, lds, kwave);
    SEAM(5);
    if (IN(6)) { select_phase(a, 128, lds, kwave);
        if (plan) { constexpr int E1 = 256, E2 = 1024, M0 = F_P6_A + E1, M1 = F_P6_B - E2;
            if (bx < 64) conv_span(a, F_P6_A, M0, 64, bx, kwave);
            else { conv_span(a, M0, M1, G - 64, bx - 64, kwave); if (bx >= 128) conv_span(a, M1, F_P6_B, G - 128, bx - 128, kwave); } } }
    SEAM(6);
    if (IN(7)) {
        constexpr int EB = FP8_GU ? 1 : 2;
        pg8::Sched Sc; Sc.init(272, 16, G, bx, 17, ws + WS_WGU, (size_t)4096 * 1024 * EB, (size_t)256 * 1024 * EB); Sc.reph = GREPH(7);
        pg8::EpiGU E{(bf16*)(ws + WS_H), FP8_GU ? W8_INV : 1.0f};
        pg8::gemm_phase<pg8::EpiGU, true, FP8_GU != 0>(lds, (const char*)(ws + WS_HL), 1024 * EB / 2, Sc, E, ldsidx, (const int*)(ws + WS_ROWIDX), kwave);
    }
    SEAM(7);
    if (IN(8)) {
        constexpr int EB = FP8_DOWN ? 1 : 2;
        pg8::Sched Sc; Sc.init(272, 4, G, bx, 17, ws + WS_WD, (size_t)1024 * 2048 * EB, (size_t)256 * 2048 * EB); Sc.reph = GREPH(8);
        pg8::EpiDown E{(bf16*)(ws + WS_Y), (const float*)(ws + WS_GATE)};
        pg8::gemm_phase<pg8::EpiDown, false, FP8_DOWN != 0>(lds, (const char*)(ws + WS_H), 2048 * EB / 2, Sc, E, ldsidx, nullptr, kwave);
        FILL_TAIL(272 * 4, F_P8_A, F_P8_B);
    }
    SEAM(8);
    if (IN(9)) combine_phase(a, 0, kwave);
    SEAM(9);
    if (IN(10)) {
        pg8::Sched Sc; Sc.init(NROWS / 256, QKVB_N / 256, G, bx, 0, ws + WS_WQKVB, 0, (size_t)256 * 1024 * 2); Sc.reph = GREPH(10);
        pg8::EpiQKV E{(bf16*)(ws + WS_Q), (bf16*)(ws + WS_K), (bf16*)(ws + WS_V), 1024, 4, 4, a.in[14], a.in[15], (const float*)(ws + WS_ROPE), 0, QSCALE};
        pg8::gemm_phase<pg8::EpiQKV, false>(lds, (const char*)(ws + WS_HL), 1024, Sc, E, ldsidx, nullptr, kwave);
        FILL_TAIL((NROWS / 256) * (QKVB_N / 256), F_P10_A, F_P10_B);
    }
    SEAM(10);
    if (IN(11)) for (int rep_ = 0; rep_ < NREP(11); ++rep_) { if (rep_) xcd_barrier(bar, kwave);
        const int vcu = (G % 8 == 0) ? (bx % 8) * (G / 8) + bx / 8 : bx;
        att::attn_b_phase(lds, vcu * 8, vcu * 8 < 2048 ? 8 : 0, (const bf16*)(ws + WS_Q), (const bf16*)(ws + WS_K), (const bf16*)(ws + WS_V), (bf16*)(ws + WS_O), a.in[16], a.in[14], a.in[15], kwave);
    }
    SEAM(11);
    if (IN(12)) {
        constexpr int EB = FP8_O ? 1 : 2;
        pg8::Sched Sc; Sc.init(NLAT / 256, 4, G, bx, 0, ws + WS_WOB, 0, (size_t)256 * 1024 * EB); Sc.reph = GREPH(12);
        pg8::EpiOproj E{a.out, a.in[2], a.out, (float*)(ws + WS_XC), mod + 1 * 5 * 6144 + 2 * 1024, FP8_O ? W8_INV / O8_SCALE : 1.0f};
        pg8::gemm_phase<pg8::EpiOproj, false, FP8_O != 0>(lds, (const char*)(ws + WS_O), 1024 * EB / 2, Sc, E, ldsidx, nullptr, kwave);
    }
    SEAM(12);
    if (IN(13)) norm2_router_phase(a, 1, NLAT, lds, kwave);
    SEAM(13);
    if (IN(14)) { select_phase(a, 64, lds, kwave);
        if (plan) { constexpr int E1 = 640, C1 = F_P14_D - E1;
            if (bx < 64) conv_span(a, C1, F_P14_D, 64, bx, kwave);
            else { conv_span(a, F_P14_A, F_P14_B, G - 64, bx - 64, kwave); conv_span(a, F_P14_C, C1, G - 64, bx - 64, kwave); } } }
    SEAM(14);
    if (IN(15)) {
        constexpr int EB = FP8_GU ? 1 : 2;
        pg8::Sched Sc; Sc.init(256, 16, G, bx, 16, ws + WS_WGU + (size_t)16 * 4096 * 1024 * EB, (size_t)4096 * 1024 * EB, (size_t)256 * 1024 * EB); Sc.reph = GREPH(15);
        pg8::EpiGU E{(bf16*)(ws + WS_H), FP8_GU ? W8_INV : 1.0f};
        pg8::gemm_phase<pg8::EpiGU, true, FP8_GU != 0>(lds, (const char*)(ws + WS_HL), 1024 * EB / 2, Sc, E, ldsidx, (const int*)(ws + WS_ROWIDX), kwave);
    }
    SEAM(15);
    if (IN(16)) {
        constexpr int EB = FP8_DOWN ? 1 : 2;
        pg8::Sched Sc; Sc.init(256, 4, G, bx, 16, ws + WS_WD + (size_t)16 * 1024 * 2048 * EB, (size_t)1024 * 2048 * EB, (size_t)256 * 2048 * EB); Sc.reph = GREPH(16);
        pg8::EpiDown E{(bf16*)(ws + WS_Y), (const float*)(ws + WS_GATE)};
        pg8::gemm_phase<pg8::EpiDown, false, FP8_DOWN != 0>(lds, (const char*)(ws + WS_H), 2048 * EB / 2, Sc, E, ldsidx, nullptr, kwave);
    }
    SEAM(16);
    if (IN(17)) combine_phase(a, 1, kwave);
#undef IN
#undef SEAM
#undef FILL_TAIL
}

struct NaiveG {
    const bf16* A; int lda; const int* rowidx;
    const float* W; const float* W2; int ldw; size_t wstride_e;
    int M, N, K, mode;
    bf16* o0; bf16* o1; bf16* o2; int kvw;
    const float* base_lat; const float* base_ctx; float* out_lat; float* out_ctx; const float* g1;
    const float* gate;
};
__global__ void __launch_bounds__(256) naive_gemm(NaiveG g) {
    const int lane = threadIdx.x & 63, wave = threadIdx.x >> 6;
    const int tiles_n = g.N / 64; const long ntiles = (long)(g.M / 32) * tiles_n;
    const int fr = lane & 15, fq = lane >> 4;
    for (long wt = (long)blockIdx.x * 4 + wave; wt < ntiles; wt += (long)gridDim.x * 4) {
        const int tm = (int)(wt / tiles_n), tn = (int)(wt % tiles_n), r0 = tm * 32, c0 = tn * 64;
        const int e = g.wstride_e ? r0 / SLOTS_E : 0;
        const float* W = g.W + (size_t)e * g.wstride_e; const float* W2 = g.W2 ? g.W2 + (size_t)e * g.wstride_e : nullptr;
        const bf16* arow[2];
#pragma unroll
        for (int mi = 0; mi < 2; ++mi) { const int m = r0 + 16 * mi + fr; const int ar = g.rowidx ? g.rowidx[m] : m; arow[mi] = g.A + (size_t)ar * g.lda + 8 * fq; }
        f32x4 acc[2][4], acc2[2][4];
#pragma unroll
        for (int mi = 0; mi < 2; ++mi)
#pragma unroll
            for (int ni = 0; ni < 4; ++ni) { acc[mi][ni] = (f32x4){0.f, 0.f, 0.f, 0.f}; acc2[mi][ni] = (f32x4){0.f, 0.f, 0.f, 0.f}; }
        for (int k0 = 0; k0 < g.K; k0 += 32) {
            bf16x8 af[2];
#pragma unroll
            for (int mi = 0; mi < 2; ++mi) af[mi] = *(const bf16x8*)(arow[mi] + k0);
#pragma unroll
            for (int ni = 0; ni < 4; ++ni) {
                const float* wp = W + (size_t)(k0 + 8 * fq) * g.ldw + c0 + 16 * ni + fr;
                bf16x8 bfr;
#pragma unroll
                for (int j = 0; j < 8; ++j) bfr[j] = (short)f2bf(wp[(size_t)j * g.ldw]);
#pragma unroll
                for (int mi = 0; mi < 2; ++mi) acc[mi][ni] = __builtin_amdgcn_mfma_f32_16x16x32_bf16(af[mi], bfr, acc[mi][ni], 0, 0, 0);
                if (W2) {
                    const float* wp2 = W2 + (size_t)(k0 + 8 * fq) * g.ldw + c0 + 16 * ni + fr;
#pragma unroll
                    for (int j = 0; j < 8; ++j) bfr[j] = (short)f2bf(wp2[(size_t)j * g.ldw]);
#pragma unroll
                    for (int mi = 0; mi < 2; ++mi) acc2[mi][ni] = __builtin_amdgcn_mfma_f32_16x16x32_bf16(af[mi], bfr, acc2[mi][ni], 0, 0, 0);
                }
            }
        }
#pragma unroll
        for (int mi = 0; mi < 2; ++mi)
#pragma unroll
            for (int ni = 0; ni < 4; ++ni)
#pragma unroll
                for (int i = 0; i < 4; ++i) {
                    const int row = r0 + 16 * mi + 4 * fq + i, col = c0 + 16 * ni + fr; const float v = acc[mi][ni][i];
                    if (g.mode == 0) {
                        const int nq = 1024;
                        if (col < nq) g.o0[(size_t)row * 1024 + col] = (bf16)f2bf(v);
                        else if (col < nq + g.kvw) g.o1[(size_t)row * g.kvw + col - nq] = (bf16)f2bf(v);
                        else g.o2[(size_t)row * g.kvw + col - nq - g.kvw] = (bf16)f2bf(v);
                    } else if (g.mode == 1) {
                        const bool lat = row < NLAT; const int r = lat ? row / S : 4;
                        const size_t off = lat ? (size_t)row * D + col : (size_t)(row - NLAT) * D + col;
                        const float bs = lat ? g.base_lat[off] : g.base_ctx[off];
                        (lat ? g.out_lat : g.out_ctx)[off] = bs + g.g1[r * 6144 + col] * v;
                    } else if (g.mode == 2) {
                        const float u = acc2[mi][ni][i]; g.o0[(size_t)row * FF + col] = (bf16)f2bf(silu_f(v) * u);
                    } else {
                        g.o0[(size_t)row * D + col] = (bf16)f2bf(v * g.gate[row]);
                    }
                }
    }
}
__global__ void __launch_bounds__(256) naive_qknorm(bf16* Q, bf16* Kb, int kvw, const float* qg, const float* kg, const float* ropet, int rope) {
    const int lane = threadIdx.x & 63, wave = threadIdx.x >> 6;
    const int nkh = kvw / 64;
    for (int row = blockIdx.x * 4 + wave; row < NROWS; row += gridDim.x * 4) {
        const bool lat = row < NLAT; const int pos = row % S;
        for (int h = 0; h < 16 + nkh; ++h) {
            bf16* p = h < 16 ? Q + (size_t)row * 1024 + h * 64 + lane : Kb + (size_t)row * kvw + (h - 16) * 64 + lane;
            const float x = bf2f(*p);
            const float ss = wave_sum(x * x);
            float y = x * (1.0f / sqrtf(ss * (1.0f / 64.0f) + EPS)) * (h < 16 ? qg[lane] : kg[lane]);
            if (rope && lat) {
                const int half = lane >> 5, dd = lane & 31, f = dd & 15; const int v = half == 0 ? pos / 64 : pos % 64;
                const float cs = ropet[v * 16 + f], sn = ropet[128 * 16 + v * 16 + f];
                const float other = __shfl_xor(y, 16);
                y = (dd < 16) ? y * cs - other * sn : other * sn + y * cs;
            }
            *p = (bf16)f2bf(y);
        }
    }
}
__global__ void __launch_bounds__(256) naive_attn_a(const bf16* Q, const bf16* Kb, const bf16* Vb, bf16* O, const float* sink, float sscale) {
    const int lane = threadIdx.x & 63, wave = threadIdx.x >> 6;
    const long total = (long)NROWS * 16;
    for (long gw = (long)blockIdx.x * 4 + wave; gw < total; gw += (long)gridDim.x * 4) {
        const int row = (int)(gw >> 4), head = (int)(gw & 15), kvh = head >> 2;
        const bool lat = row < NLAT; const int b = lat ? row / S : (row - NLAT) / CTX, pos = row % S;
        float q[64];
#pragma unroll
        for (int c = 0; c < 8; ++c) { const u32x4 w = *(const u32x4*)(Q + (size_t)row * 1024 + head * 64 + 8 * c);
            q[8 * c] = bf2f(w.x & 0xffffu); q[8 * c + 1] = bf2f(w.x >> 16); q[8 * c + 2] = bf2f(w.y & 0xffffu); q[8 * c + 3] = bf2f(w.y >> 16);
            q[8 * c + 4] = bf2f(w.z & 0xffffu); q[8 * c + 5] = bf2f(w.z >> 16); q[8 * c + 6] = bf2f(w.w & 0xffffu); q[8 * c + 7] = bf2f(w.w >> 16); }
        const int klo = lat ? max(pos - 128, 0) : 0, khi = lat ? min(pos + 128, S - 1) : -1;
        float sc[9]; int krow[9];
        const float sk = sink[head];
        float mx = sk;
#pragma unroll
        for (int t = 0; t < 9; ++t) {
            int kr; bool valid;
            if (t < 5) { const int kp = klo + 64 * t + lane; valid = kp <= khi; kr = b * S + kp; }
            else { valid = true; kr = NLAT + b * CTX + 64 * (t - 5) + lane; }
            krow[t] = valid ? kr : -1; float s = -1e30f;
            if (valid) { const bf16* kp_ = Kb + (size_t)kr * 256 + kvh * 64; float d = 0.f;
#pragma unroll
                for (int c = 0; c < 8; ++c) { const u32x4 w = *(const u32x4*)(kp_ + 8 * c);
                    d += q[8 * c] * bf2f(w.x & 0xffffu) + q[8 * c + 1] * bf2f(w.x >> 16) + q[8 * c + 2] * bf2f(w.y & 0xffffu) + q[8 * c + 3] * bf2f(w.y >> 16)
                       + q[8 * c + 4] * bf2f(w.z & 0xffffu) + q[8 * c + 5] * bf2f(w.z >> 16) + q[8 * c + 6] * bf2f(w.w & 0xffffu) + q[8 * c + 7] * bf2f(w.w >> 16); }
                s = d * sscale; }
            sc[t] = s; mx = fmaxf(mx, s);
        }
        mx = wave_max(mx);
        float den = 0.f;
#pragma unroll
        for (int t = 0; t < 9; ++t) { sc[t] = krow[t] >= 0 ? expf(sc[t] - mx) : 0.f; den += sc[t]; }
        den = wave_sum(den) + expf(sk - mx);
        float o = 0.f;
#pragma unroll
        for (int t = 0; t < 9; ++t)
            for (int j = 0; j < 64; ++j) { const int kr = __shfl(krow[t], j); const float p = __shfl(sc[t], j); if (kr >= 0) o += p * bf2f(Vb[(size_t)kr * 256 + kvh * 64 + lane]); }
        O[(size_t)row * 1024 + head * 64 + lane] = (bf16)f2bf(o / den);
    }
}
__global__ void __launch_bounds__(256) naive_attn_b(const bf16* Q, const bf16* Kb, const bf16* Vb, bf16* O, const float* rpb, float sscale) {
    const int lane = threadIdx.x & 63, wave = threadIdx.x >> 6;
    const long total = (long)NLAT * 16;
    for (long gw = (long)blockIdx.x * 4 + wave; gw < total; gw += (long)gridDim.x * 4) {
        const int row = (int)(gw >> 4), head = (int)(gw & 15);
        const int b = row / S, pos = row % S, r = pos / 64, c = pos % 64;
        const int rs = min(max(r - 4, 0), 120), wst = min(max(c - 8, 0), 48);
        float q[64];
#pragma unroll
        for (int cc = 0; cc < 8; ++cc) { const u32x4 w = *(const u32x4*)(Q + (size_t)row * 1024 + head * 64 + 8 * cc);
            q[8 * cc] = bf2f(w.x & 0xffffu); q[8 * cc + 1] = bf2f(w.x >> 16); q[8 * cc + 2] = bf2f(w.y & 0xffffu); q[8 * cc + 3] = bf2f(w.y >> 16);
            q[8 * cc + 4] = bf2f(w.z & 0xffffu); q[8 * cc + 5] = bf2f(w.z >> 16); q[8 * cc + 6] = bf2f(w.w & 0xffffu); q[8 * cc + 7] = bf2f(w.w >> 16); }
        float sc[6]; int krow[6]; float mx = -1e30f;
#pragma unroll
        for (int t = 0; t < 6; ++t) {
            int kr; float bias = 0.f;
            if (t < 2) { const int j = 64 * t + lane, krr = rs + (j >> 4), kc = wst + (j & 15); kr = b * S + krr * 64 + kc; bias = rpb[(head * 15 + (krr - r + 7)) * 31 + (kc - c + 15)]; }
            else kr = NLAT + b * CTX + 64 * (t - 2) + lane;
            krow[t] = kr;
            const bf16* kp_ = Kb + (size_t)kr * 1024 + head * 64; float d = 0.f;
#pragma unroll
            for (int cc = 0; cc < 8; ++cc) { const u32x4 w = *(const u32x4*)(kp_ + 8 * cc);
                d += q[8 * cc] * bf2f(w.x & 0xffffu) + q[8 * cc + 1] * bf2f(w.x >> 16) + q[8 * cc + 2] * bf2f(w.y & 0xffffu) + q[8 * cc + 3] * bf2f(w.y >> 16)
                   + q[8 * cc + 4] * bf2f(w.z & 0xffffu) + q[8 * cc + 5] * bf2f(w.z >> 16) + q[8 * cc + 6] * bf2f(w.w & 0xffffu) + q[8 * cc + 7] * bf2f(w.w >> 16); }
            sc[t] = d * sscale + bias; mx = fmaxf(mx, sc[t]);
        }
        mx = wave_max(mx);
        float den = 0.f;
#pragma unroll
        for (int t = 0; t < 6; ++t) { sc[t] = expf(sc[t] - mx); den += sc[t]; }
        den = wave_sum(den);
        float o = 0.f;
#pragma unroll
        for (int t = 0; t < 6; ++t)
            for (int j = 0; j < 64; ++j) { const int kr = __shfl(krow[t], j); const float p = __shfl(sc[t], j); o += p * bf2f(Vb[(size_t)kr * 1024 + head * 64 + lane]); }
        O[(size_t)row * 1024 + head * 64 + lane] = (bf16)f2bf(o / den);
    }
}

extern "C" void kernel_launch(void* const* d_in, const int* in_sizes, int n_in, void* d_out, int out_size, void* d_ws, size_t ws_size, hipStream_t stream) {
    static int grid = 0;
    if (grid == 0) {
        if (n_in != 22 || out_size != NLAT * D || ws_size < WS_END) { fprintf(stderr, "kernel_launch: unexpected shapes n_in %d out %d ws %zu\n", n_in, out_size, ws_size); grid = -1; return; }
        int dev = 0, cus = 0, per_cu = 0;
        hipGetDevice(&dev); hipDeviceGetAttribute(&cus, hipDeviceAttributeMultiprocessorCount, dev);
        hipFuncSetAttribute((const void*)mega, hipFuncAttributeMaxDynamicSharedMemorySize, LDS_BYTES);
        hipOccupancyMaxActiveBlocksPerMultiprocessor(&per_cu, (const void*)mega, NTHREADS, LDS_BYTES);
        (void)hipGetLastError();
        if (per_cu < 1) fprintf(stderr, "kernel_launch: occupancy query says %d blocks/CU\n", per_cu);
        grid = cus;
    }
    if (grid < 0) return;
    unsigned char* ws = (unsigned char*)d_ws;
    hipMemsetAsync(ws + WS_CTL, 0, 1 * MiB, stream);
    Args a{};
    for (int i = 0; i < 22; ++i) a.in[i] = (const float*)d_in[i];
    a.out = (float*)d_out; a.ws = ws;
    auto run = [&](int p) { a.ph_lo = p; a.ph_hi = p + 1; hipLaunchKernelGGL(mega, dim3(grid), dim3(NTHREADS), LDS_BYTES, stream, a); };
    const float* mod = (const float*)(ws + WS_MOD);
    bf16* HL = (bf16*)(ws + WS_HL); bf16* Qb = (bf16*)(ws + WS_Q); bf16* Kb = (bf16*)(ws + WS_K); bf16* Vb = (bf16*)(ws + WS_V); bf16* Ob = (bf16*)(ws + WS_O);
    bf16* Hb = (bf16*)(ws + WS_H); bf16* Yb = (bf16*)(ws + WS_Y);
    const int NG = 2048;
#if ONE_LAUNCH
    a.ph_lo = 0; a.ph_hi = 18; hipLaunchKernelGGL(mega, dim3(grid), dim3(NTHREADS), LDS_BYTES, stream, a);
    (void)run; (void)mod; (void)HL; (void)Qb; (void)Kb; (void)Vb; (void)Ob; (void)Hb; (void)Yb; (void)NG;
#else
    run(0); run(1);
    for (int l = 0; l < 2; ++l) {
#if FAST_QKV
        run(l == 0 ? 2 : 10);
        const float sscale = 1.0f / LOG2E;
#else
        { NaiveG g{}; g.A = HL; g.lda = D; g.W = l == 0 ? a.in[8] : a.in[13]; g.ldw = l == 0 ? QKVA_N : QKVB_N; g.M = NROWS; g.N = g.ldw; g.K = D; g.mode = 0;
          g.o0 = Qb; g.o1 = Kb; g.o2 = Vb; g.kvw = l == 0 ? 256 : 1024;
          hipLaunchKernelGGL(naive_gemm, dim3(NG), dim3(256), 0, stream, g); }
        hipLaunchKernelGGL(naive_qknorm, dim3(NG), dim3(256), 0, stream, Qb, Kb, l == 0 ? 256 : 1024, l == 0 ? a.in[9] : a.in[14], l == 0 ? a.in[10] : a.in[15], (const float*)(ws + WS_ROPE), l == 0 ? 1 : 0);
        const float sscale = 0.125f;
#endif
#if FAST_ATTN_A
        if (l == 0) run(3);
#else
        if (l == 0) hipLaunchKernelGGL(naive_attn_a, dim3(NG), dim3(256), 0, stream, (const bf16*)Qb, (const bf16*)Kb, (const bf16*)Vb, Ob, a.in[11], sscale);
#endif
#if FAST_ATTN_B
        if (l == 1) run(11);
#else
        if (l == 1) hipLaunchKernelGGL(naive_attn_b, dim3(NG), dim3(256), 0, stream, (const bf16*)Qb, (const bf16*)Kb, (const bf16*)Vb, Ob, a.in[16], sscale);
#endif
#if FAST_OPROJ
        run(l == 0 ? 4 : 12);
#else
        { NaiveG g{}; g.A = Ob; g.lda = D; g.W = l == 0 ? a.in[12] : a.in[17]; g.ldw = D; g.M = l == 0 ? NROWS : NLAT; g.N = D; g.K = D; g.mode = 1;
          g.base_lat = l == 0 ? a.in[0] : (const float*)d_out; g.base_ctx = a.in[2]; g.out_lat = (float*)d_out; g.out_ctx = (float*)(ws + WS_XC); g.g1 = mod + l * 5 * 6144 + 2 * 1024;
          hipLaunchKernelGGL(naive_gemm, dim3(NG), dim3(256), 0, stream, g); }
#endif
        run(l == 0 ? 5 : 13);
        run(l == 0 ? 6 : 14);
#if FAST_G1
        run(l == 0 ? 7 : 15);
#else
        { NaiveG g{}; g.A = HL; g.lda = D; g.rowidx = (const int*)(ws + WS_ROWIDX); g.W = a.in[19] + (size_t)l * 16 * 1024 * 2048; g.W2 = a.in[20] + (size_t)l * 16 * 1024 * 2048; g.ldw = FF; g.wstride_e = (size_t)1024 * 2048;
          g.M = NSLOT; g.N = FF; g.K = D; g.mode = 2; g.o0 = Hb;
          hipLaunchKernelGGL(naive_gemm, dim3(NG), dim3(256), 0, stream, g); }
#endif
#if FAST_G2
        run(l == 0 ? 8 : 16);
#else
        { NaiveG g{}; g.A = Hb; g.lda = FF; g.W = a.in[21] + (size_t)l * 16 * 2048 * 1024; g.ldw = D; g.wstride_e = (size_t)2048 * 1024;
          g.M = NSLOT; g.N = D; g.K = FF; g.mode = 3; g.o0 = Yb; g.gate = (const float*)(ws + WS_GATE);
          hipLaunchKernelGGL(naive_gemm, dim3(NG), dim3(256), 0, stream, g); }
#endif
        run(l == 0 ? 9 : 17);
    }
#endif
}
```

```cpp
#include <hip/hip_runtime.h>
#include <cstdio>
#include <cstdint>

#define LAS __attribute__((address_space(3)))
typedef unsigned short bf16;
typedef float f32x4 __attribute__((ext_vector_type(4)));
typedef unsigned u32x4 __attribute__((ext_vector_type(4)));
typedef unsigned u32x2 __attribute__((ext_vector_type(2)));
typedef short bf16x8 __attribute__((ext_vector_type(8)));

constexpr int D = 1024, NB = 4, S = 8192, CTX = 256, NLAT = NB * S, NCTX = NB * CTX, NROWS = NLAT + NCTX;
constexpr int NE = 16, FF = 2048, CAPL = 1024, CAPC = 32;
constexpr int SLOTS_E = 4352, NSLOT = NE * SLOTS_E;
constexpr int QKVA_N = 1536, QKVB_N = 3072;
constexpr float EPS = 1e-6f;
constexpr float LOG2E = 1.4426950408889634f;

constexpr size_t MiB = 1u << 20;
constexpr size_t WS_CTL = 0;
constexpr size_t WS_MOD = 1 * MiB;
constexpr size_t WS_ROPE = 1 * MiB + 512 * 1024;
constexpr size_t WS_AFF = 2 * MiB;
constexpr size_t WS_ROWIDX = 5 * MiB;
constexpr size_t WS_GATE = 5 * MiB + 512 * 1024;
constexpr size_t WS_INV = 6 * MiB;
constexpr size_t WS_XC = 9 * MiB;
constexpr size_t WS_WQKVA = 13 * MiB;
constexpr size_t WS_WOA = 16 * MiB;
constexpr size_t WS_WQKVB = 18 * MiB;
constexpr size_t WS_WOB = 24 * MiB;
constexpr size_t WS_WGU = 26 * MiB;
constexpr size_t WS_WD = 282 * MiB;
constexpr size_t WS_HL = 410 * MiB;
constexpr size_t WS_R1 = 476 * MiB;
constexpr size_t WS_Q = WS_R1, WS_K = WS_R1 + 66 * MiB, WS_V = WS_R1 + 132 * MiB, WS_O = WS_R1 + 198 * MiB;
constexpr size_t WS_H = WS_R1;
constexpr size_t WS_Y = 748 * MiB;
constexpr size_t WS_END = 884 * MiB;

#ifndef FAST_QKV
#define FAST_QKV 1
#endif
#ifndef FAST_OPROJ
#define FAST_OPROJ 1
#endif
#ifndef PROBE_MASK
#define PROBE_MASK 0
#endif
#ifndef PROBE_GEMM
#define PROBE_GEMM -1
#endif
#ifndef PROBE_REPH
#define PROBE_REPH 4
#endif
#define GREPH(k) ((k) == PROBE_GEMM ? PROBE_REPH : 2)
#define NREP(k) (((PROBE_MASK >> (k)) & 1) ? 2 : 1)
#ifndef FP8_DOWN
#define FP8_DOWN 1
#endif
#ifndef FP8_Y
#define FP8_Y 1
#endif
constexpr float Y8_SCALE = 32.0f;
#ifndef FP8_O
#define FP8_O 1
#endif
constexpr float O8_SCALE = 16.0f;
#ifndef FP8_GU
#define FP8_GU 1
#endif
constexpr float W8_SCALE = 32.0f, W8_INV = 1.0f / 32.0f;
#ifndef ONE_LAUNCH
#define ONE_LAUNCH 1
#endif
#ifndef FAST_ATTN_A
#define FAST_ATTN_A 1
#endif
#ifndef FAST_ATTN_B
#define FAST_ATTN_B 1
#endif
#ifndef FAST_G1
#define FAST_G1 1
#endif
#ifndef FAST_G2
#define FAST_G2 1
#endif
constexpr int NWAVES = 8, NTHREADS = 512;
constexpr int LDS_BYTES = 163840;
constexpr int IDX_OFF = 131072 + 1024;
constexpr float QSCALE = 0.125f * 1.4426950408889634f;

__device__ __forceinline__ float bf2f(unsigned h) { return __uint_as_float(h << 16); }
__device__ __forceinline__ unsigned f2bf(float f) { unsigned u = __float_as_uint(f); return (u + 0x7fffu + ((u >> 16) & 1u)) >> 16; }
__device__ __forceinline__ unsigned pk2(float lo, float hi) { return f2bf(lo) | (f2bf(hi) << 16); }
__device__ __forceinline__ float wave_sum(float v) {
#pragma unroll
    for (int o = 32; o >= 1; o >>= 1) v += __shfl_xor(v, o);
    return v;
}
__device__ __forceinline__ float wave_max(float v) {
#pragma unroll
    for (int o = 32; o >= 1; o >>= 1) v = fmaxf(v, __shfl_xor(v, o));
    return v;
}
__device__ __forceinline__ int wave_sum_i(int v) {
#pragma unroll
    for (int o = 32; o >= 1; o >>= 1) v += __shfl_xor(v, o);
    return v;
}
__device__ __forceinline__ int lane_now() { int l; asm volatile("v_mbcnt_lo_u32_b32 %0, -1, 0\n\tv_mbcnt_hi_u32_b32 %0, -1, %0" : "=v"(l)); return l; }
#define TIDX (kwave * 64 + lane_now())
__device__ __forceinline__ float silu_f(float x) { return x / (1.0f + expf(-x)); }

struct Args { const float* in[22]; float* out; unsigned char* ws; int ph_lo, ph_hi; };

__device__ __forceinline__ int qk_rowmap(int n) {
    const int hh = n >> 6, d = n & 63, pn = hh >> 2, wc = hh & 3, bj = d >> 5, dd = d & 31, nn = dd >> 4, fq = (dd & 15) >> 2, i = dd & 3;
    return 256 * pn + 128 * bj + 32 * wc + 8 * fq + 4 * nn + i;
}
__device__ __forceinline__ int conv_rowmap(int mode, int n) {
    switch (mode) {
        case 1: return 256 * (n >> 7) + (n & 127);
        case 2: return 256 * (n >> 7) + 128 + (n & 127);
        case 3: return n < 1280 ? qk_rowmap(n) : n;
        case 4: return n < 2048 ? qk_rowmap(n) : n;
        default: return n;
    }
}
struct ConvJob { const float* W; bf16* Wt; int K, N, mode, item; };
__device__ __forceinline__ void conv_load(const ConvJob& j, f32x4 (&v)[8], int lane) {
    const int nblk = j.N / 32, kb = j.item / nblk, nbk = j.item % nblk, k0 = 64 * kb, n0 = 32 * nbk;
    const int nq = lane & 7, kg = lane >> 3;
#pragma unroll
    for (int i = 0; i < 8; ++i) v[i] = __builtin_nontemporal_load((const f32x4*)(j.W + (size_t)(k0 + 8 * kg + i) * j.N + n0 + 4 * nq));
}
__device__ __forceinline__ void conv_store(const ConvJob& j, const f32x4 (&v)[8], int lane) {
    const int nblk = j.N / 32, kb = j.item / nblk, nbk = j.item % nblk, k0 = 64 * kb, n0 = 32 * nbk;
    const int nq = lane & 7, kg = lane >> 3;
#pragma unroll
    for (int c = 0; c < 4; ++c) {
        u32x4 o; o.x = pk2(v[0][c], v[1][c]); o.y = pk2(v[2][c], v[3][c]); o.z = pk2(v[4][c], v[5][c]); o.w = pk2(v[6][c], v[7][c]);
        const int row = conv_rowmap(j.mode, n0 + 4 * nq + c);
        __builtin_nontemporal_store(o, (u32x4*)(j.Wt + (size_t)row * j.K + k0 + 8 * kg));
    }
}
__device__ __forceinline__ void p0_phase(const Args& a, LAS unsigned char* lds, const int kwave) {
    const int tid = TIDX, lane = tid & 63, wave = tid >> 6;
    unsigned char* ws = a.ws;
    {
        float* rc = (float*)(ws + WS_ROPE); float* rs = rc + 128 * 16;
        const int per = (128 * 16 + (int)gridDim.x - 1) / (int)gridDim.x, i = blockIdx.x * per + tid;
        if (tid < per && i < 128 * 16) { const int v = i >> 4, f = i & 15; const double inv = pow(10000.0, -(double)f / 16.0), ang = (double)v * inv; rc[i] = (float)cos(ang); rs[i] = (float)sin(ang); }
    }
    if (blockIdx.x == 1) {
        int* rowidx = (int*)(ws + WS_ROWIDX); float* gate = (float*)(ws + WS_GATE);
        for (int i = tid; i < NE * 128; i += NTHREADS) { const int e = i >> 7, p = i & 127; rowidx[e * SLOTS_E + 4224 + p] = 0; gate[e * SLOTS_E + 4224 + p] = 0.f; }
    }
    {
        LAS float* sc = (LAS float*)lds;
        LAS float* red = sc + 5 * 1024;
        bool have = false;
        for (int u = blockIdx.x; u < 192; u += gridDim.x) {
            if (!have) {
                for (int i = tid; i < 5 * 1024; i += NTHREADS) { const int r = i >> 10, k = i & 1023; const float cv = r < 4 ? a.in[1][r * 1024 + k] : a.in[3][k]; sc[i] = silu_f(cv); }
                __syncthreads(); have = true;
            }
            const int l = u / 96, cb = u % 96, col = cb * 64 + lane;
            const float* W = a.in[4] + (size_t)l * 1024 * 6144;
            float acc[5] = {0.f, 0.f, 0.f, 0.f, 0.f};
            for (int kk = 0; kk < 128; ++kk) { const int k = wave * 128 + kk; const float wv = W[(size_t)k * 6144 + col];
#pragma unroll
                for (int r = 0; r < 5; ++r) acc[r] += sc[r * 1024 + k] * wv; }
#pragma unroll
            for (int r = 0; r < 5; ++r) red[(wave * 5 + r) * 64 + lane] = acc[r];
            __syncthreads();
            if (tid < 320) { const int r = tid >> 6, ln = tid & 63; float s = 0.f;
#pragma unroll
                for (int w = 0; w < 8; ++w) s += red[(w * 5 + r) * 64 + ln];
                const int cc = cb * 64 + ln;
                ((float*)(ws + WS_MOD))[(l * 5 + r) * 6144 + cc] = s + a.in[5][l * 6144 + cc]; }
            __syncthreads();
        }
    }
}

__device__ __forceinline__ void norm_mod(const f32x4 (&v)[4], f32x4 (&y)[4], const float* g, const float* sh, const float* sc, int lane) {
    float ss = 0.f;
#pragma unroll
    for (int j = 0; j < 4; ++j) ss += (v[j][0] * v[j][0] + v[j][1] * v[j][1]) + (v[j][2] * v[j][2] + v[j][3] * v[j][3]);
    ss = wave_sum(ss);
    const float rstd = 1.0f / sqrtf(ss * (1.0f / D) + EPS);
#pragma unroll
    for (int j = 0; j < 4; ++j) { const int col = 4 * lane + 256 * j; const f32x4 gg = *(const f32x4*)(g + col), s0 = *(const f32x4*)(sh + col), s1 = *(const f32x4*)(sc + col);
        y[j] = (v[j] * rstd * gg) * (1.0f + s1) + s0; }
}
__device__ __forceinline__ void store_bf16_row(bf16* orow, const f32x4 (&y)[4], int lane) {
#pragma unroll
    for (int j = 0; j < 4; ++j) { u32x2 w; w.x = pk2(y[j][0], y[j][1]); w.y = pk2(y[j][2], y[j][3]); *(u32x2*)(orow + 4 * lane + 256 * j) = w; }
}
__device__ __forceinline__ void norm1_l0_phase(const Args& a, const int kwave) {
    const int lane = TIDX & 63, wave = TIDX >> 6;
    const int gw = blockIdx.x * NWAVES + wave, NGW = gridDim.x * NWAVES;
    const float* mod = (const float*)(a.ws + WS_MOD); bf16* HL = (bf16*)(a.ws + WS_HL);
    for (int row = gw; row < NROWS; row += NGW) {
        const bool lat = row < NLAT; const int r = lat ? row / S : 4;
        const float* xr = lat ? a.in[0] + (size_t)row * D : a.in[2] + (size_t)(row - NLAT) * D;
        f32x4 v[4], y[4];
#pragma unroll
        for (int j = 0; j < 4; ++j) v[j] = *(const f32x4*)(xr + 4 * lane + 256 * j);
        const float* m = mod + (0 * 5 + r) * 6144;
        norm_mod(v, y, a.in[6], m, m + 1024, lane);
        store_bf16_row(HL + (size_t)row * D, y, lane);
    }
}
template <int CTRL> __device__ __forceinline__ float dppf(float v) { return __builtin_bit_cast(float, __builtin_amdgcn_update_dpp(0, __builtin_bit_cast(int, v), CTRL, 0xF, 0xF, true)); }
__device__ __forceinline__ float row16_max(float v) { v = fmaxf(v, dppf<0xB1>(v)); v = fmaxf(v, dppf<0x4E>(v)); v = fmaxf(v, dppf<0x141>(v)); v = fmaxf(v, dppf<0x140>(v)); return v; }
__device__ __forceinline__ float row16_sum(float v) { v += dppf<0xB1>(v); v += dppf<0x4E>(v); v += dppf<0x141>(v); v += dppf<0x140>(v); return v; }
__device__ __forceinline__ void norm2_router_phase(const Args& a, int l, int nrows, LAS unsigned char* lds, const int kwave) {
    const int tid = TIDX, lane = tid & 63, wave = __builtin_amdgcn_readfirstlane(tid >> 6);
    constexpr int WP = 1028;
    LAS float* WT = (LAS float*)lds;
    LAS float* plog = (LAS float*)(lds + 16 * WP * 4);
    LAS float* pss = plog + 2 * 8 * 256;
    LAS float* part = pss + 2 * 8 * 16;
    LAS float* csh = part + 32 * 16;
    const float* wr = a.in[18] + (size_t)l * 1024 * 16;
    const float* mod = (const float*)(a.ws + WS_MOD); bf16* HL = (bf16*)(a.ws + WS_HL);
    const float* XC = (const float*)(a.ws + WS_XC); float* AFF = (float*)(a.ws + WS_AFF);
    const float* gn = a.in[7] + l * 1024;
    const int ngroups = nrows / 16, G = gridDim.x;
    const int g_lo = (int)(((long)blockIdx.x * ngroups) / G), g_hi = (int)(((long)(blockIdx.x + 1) * ngroups) / G);
    const int rowl = lane & 15, kq = lane >> 4, colb = 128 * wave + 4 * kq;
    int cur_r = -1; f32x4 Gv[8], Sv[8], xn[8];
    for (int grp = g_lo; grp < g_hi; ++grp) {
        const int row0 = grp * 16; const bool lat = row0 < NLAT; const int b = lat ? row0 / S : (row0 - NLAT) / CTX, r = lat ? b : 4;
        const float* m = mod + (l * 5 + r) * 6144 + 3 * 1024;
        if (r != cur_r) {
            __syncthreads();
            const int e = tid & 15; float ps = 0.f;
#pragma unroll 16
            for (int it = 0; it < 32; ++it) { const int k = (tid >> 4) + 32 * it; const float w = wr[k * 16 + e]; WT[e * WP + k] = w * gn[k] * (1.0f + m[1024 + k]); ps += m[k] * w; }
            part[(tid >> 4) * 16 + e] = ps;
            __syncthreads();
            if (tid < 16) { float s = 0.f;
#pragma unroll 4
                for (int j = 0; j < 32; ++j) s += part[j * 16 + tid];
                csh[tid] = s; }
            __syncthreads();
#pragma unroll
            for (int c = 0; c < 8; ++c) { const int col = colb + 16 * c; const f32x4 g4 = *(const f32x4*)(gn + col), s1 = *(const f32x4*)(m + 1024 + col); Gv[c] = g4 * (1.0f + s1); Sv[c] = *(const f32x4*)(m + col); }
            cur_r = r;
        }
        const int par = grp & 1;
        f32x4 x[8];
        if (grp == g_lo) { const float* xr = (lat ? a.out + (size_t)(row0 + rowl) * D : XC + (size_t)(row0 + rowl - NLAT) * D) + colb;
#pragma unroll
            for (int c = 0; c < 8; ++c) xn[c] = *(const f32x4*)(xr + 16 * c); }
#pragma unroll
        for (int c = 0; c < 8; ++c) x[c] = xn[c];
        if (grp + 1 < g_hi) { const int rown = (grp + 1) * 16 + rowl; const float* xr = (rown < NLAT ? a.out + (size_t)rown * D : XC + (size_t)(rown - NLAT) * D) + colb;
#pragma unroll
            for (int c = 0; c < 8; ++c) xn[c] = *(const f32x4*)(xr + 16 * c); }
        float ss = 0.f; f32x4 acc0 = {0.f, 0.f, 0.f, 0.f}, acc1 = {0.f, 0.f, 0.f, 0.f};
#pragma unroll
        for (int c = 0; c < 8; ++c) {
            const f32x4 w4 = *(const LAS f32x4*)(WT + rowl * WP + colb + 16 * c);
            ss += (x[c][0] * x[c][0] + x[c][1] * x[c][1]) + (x[c][2] * x[c][2] + x[c][3] * x[c][3]);
            acc0 = __builtin_amdgcn_mfma_f32_16x16x4f32(x[c][0], w4[0], acc0, 0, 0, 0);
            acc1 = __builtin_amdgcn_mfma_f32_16x16x4f32(x[c][1], w4[1], acc1, 0, 0, 0);
            acc0 = __builtin_amdgcn_mfma_f32_16x16x4f32(x[c][2], w4[2], acc0, 0, 0, 0);
            acc1 = __builtin_amdgcn_mfma_f32_16x16x4f32(x[c][3], w4[3], acc1, 0, 0, 0);
        }
        ss += __shfl_xor(ss, 16); ss += __shfl_xor(ss, 32);
        *(LAS f32x4*)(plog + (par * 8 + wave) * 256 + lane * 4) = acc0 + acc1;
        if (kq == 0) pss[(par * 8 + wave) * 16 + rowl] = ss;
        asm volatile("s_waitcnt lgkmcnt(0)" ::: "memory"); __builtin_amdgcn_s_barrier(); asm volatile("" ::: "memory");
        float st = 0.f;
#pragma unroll
        for (int w = 0; w < 8; ++w) st += pss[(par * 8 + w) * 16 + rowl];
        const float rstd = 1.0f / sqrtf(st * (1.0f / D) + EPS);
        if (wave < 4) {
            const int t = 4 * kq + wave;
            float stt = 0.f, lg = 0.f;
#pragma unroll
            for (int w = 0; w < 8; ++w) { stt += pss[(par * 8 + w) * 16 + t]; lg += plog[(par * 8 + w) * 256 + lane * 4 + wave]; }
            const float rj = 1.0f / sqrtf(stt * (1.0f / D) + EPS);
            const float v = lg * rj + csh[rowl];
            const float mx = row16_max(v);
            const float p = expf(v - mx);
            const float af = p / row16_sum(p);
            if (lat) AFF[(size_t)(b * 16 + rowl) * S + (row0 - b * S) + t] = af;
            else AFF[(size_t)64 * S + (size_t)(b * 16 + rowl) * CTX + (row0 - NLAT - b * CTX) + t] = af;
        }
        if (FP8_GU) {
            unsigned char* orow8 = (unsigned char*)HL + (size_t)(row0 + rowl) * D + 128 * wave + 16 * kq;
            unsigned d[8];
#pragma unroll
            for (int c = 0; c < 8; ++c) { const f32x4 y = (x[c] * rstd) * Gv[c] + Sv[c]; int w = 0; w = __builtin_amdgcn_cvt_pk_fp8_f32(y[0], y[1], w, false); w = __builtin_amdgcn_cvt_pk_fp8_f32(y[2], y[3], w, true); d[c] = (unsigned)w; }
#pragma unroll
            for (int q = 0; q < 2; ++q) {
                { auto t = __builtin_amdgcn_permlane16_swap(d[4 * q], d[4 * q + 1], false, false); d[4 * q] = t[0]; d[4 * q + 1] = t[1]; }
                { auto t = __builtin_amdgcn_permlane16_swap(d[4 * q + 2], d[4 * q + 3], false, false); d[4 * q + 2] = t[0]; d[4 * q + 3] = t[1]; }
                { auto t = __builtin_amdgcn_permlane32_swap(d[4 * q], d[4 * q + 2], false, false); d[4 * q] = t[0]; d[4 * q + 2] = t[1]; }
                { auto t = __builtin_amdgcn_permlane32_swap(d[4 * q + 1], d[4 * q + 3], false, false); d[4 * q + 1] = t[0]; d[4 * q + 3] = t[1]; }
                u32x4 w; w.x = d[4 * q]; w.y = d[4 * q + 1]; w.z = d[4 * q + 2]; w.w = d[4 * q + 3];
                *(u32x4*)(orow8 + 64 * q) = w;
            }
        } else {
            bf16* orow = HL + (size_t)(row0 + rowl) * D + colb;
#pragma unroll
            for (int c = 0; c < 8; ++c) { const f32x4 y = (x[c] * rstd) * Gv[c] + Sv[c]; u32x2 w; w.x = pk2(y[0], y[1]); w.y = pk2(y[2], y[3]); *(u32x2*)(orow + 16 * c) = w; }
        }
    }
}
__device__ __forceinline__ int block_sum_i(int v, LAS int* sm, int lane, int wave) {
    v = wave_sum_i(v);
    if (lane == 0) sm[wave] = v;
    __syncthreads();
    int t = 0;
#pragma unroll
    for (int w = 0; w < NWAVES; ++w) t += sm[w];
    __syncthreads();
    return t;
}
__device__ __forceinline__ void select_phase(const Args& a, int npairs, LAS unsigned char* lds, const int kwave) {
    const int tid = TIDX, lane = tid & 63, wave = tid >> 6;
    LAS int* sm = (LAS int*)lds;
    const float* AFF = (const float*)(a.ws + WS_AFF);
    int* ROWIDX = (int*)(a.ws + WS_ROWIDX); float* GATE = (float*)(a.ws + WS_GATE); int* INV = (int*)(a.ws + WS_INV);
    for (int p = blockIdx.x; p < npairs; p += gridDim.x) {
        const bool lat = p < 64; const int pp = lat ? p : p - 64, b = pp >> 4, e = pp & 15;
        const int n = lat ? S : CTX, cap = lat ? CAPL : CAPC;
        const float* aff = lat ? AFF + (size_t)pp * S : AFF + (size_t)64 * S + (size_t)pp * CTX;
        const int slot_base = lat ? e * SLOTS_E + b * CAPL : e * SLOTS_E + 4096 + b * CAPC;
        const int row_base = lat ? b * S : NLAT + b * CTX;
        unsigned key[16]; const int base = tid * 16;
        if (base < n) {
#pragma unroll
            for (int j = 0; j < 4; ++j) { const f32x4 t = *(const f32x4*)(aff + base + 4 * j); key[4 * j] = __float_as_uint(t[0]); key[4 * j + 1] = __float_as_uint(t[1]); key[4 * j + 2] = __float_as_uint(t[2]); key[4 * j + 3] = __float_as_uint(t[3]); }
        } else {
#pragma unroll
            for (int j = 0; j < 16; ++j) key[j] = 0u;
        }
        unsigned kor = 0u, kand = ~0u;
        if (base < n) {
#pragma unroll
            for (int j = 0; j < 16; ++j) { kor |= key[j]; kand &= key[j]; } }
#pragma unroll
        for (int o = 32; o >= 1; o >>= 1) { kor |= (unsigned)__shfl_xor((int)kor, o); kand &= (unsigned)__shfl_xor((int)kand, o); }
        if (lane == 0) { sm[48 + wave] = (int)kor; sm[56 + wave] = (int)kand; }
        __syncthreads();
#pragma unroll
        for (int w = 0; w < NWAVES; ++w) { kor |= (unsigned)sm[48 + w]; kand &= (unsigned)sm[56 + w]; }
        const unsigned same = ~(kor ^ kand);
        unsigned T = kand & same;
        int it = 0;
        for (int bit = 30; bit >= 0; --bit) {
            if ((same >> bit) & 1u) continue;
            const unsigned cand = T | (1u << bit); int cnt = 0;
#pragma unroll
            for (int j = 0; j < 16; ++j) cnt += (key[j] >= cand) ? 1 : 0;
            cnt = wave_sum_i(cnt);
            LAS int* buf = sm + 64 + (it & 1) * 8;
            if (lane == 0) buf[wave] = cnt;
            __syncthreads();
            int tot = 0;
#pragma unroll
            for (int w = 0; w < NWAVES; ++w) tot += buf[w];
            if (tot >= cap) T = cand;
            ++it;
        }
        __syncthreads();
        int cgt = 0, ceq = 0;
#pragma unroll
        for (int j = 0; j < 16; ++j) { cgt += (key[j] > T) ? 1 : 0; ceq += (key[j] == T) ? 1 : 0; }
        int igt = cgt, ieq = ceq;
#pragma unroll
        for (int o = 1; o < 64; o <<= 1) { const int t1 = __shfl_up(igt, o), t2 = __shfl_up(ieq, o); if (lane >= o) { igt += t1; ieq += t2; } }
        if (lane == 63) { sm[16 + wave] = igt; sm[32 + wave] = ieq; }
        __syncthreads();
        int pgt = igt - cgt, peq = ieq - ceq, totgt = 0;
#pragma unroll
        for (int w = 0; w < NWAVES; ++w) { const int g = sm[16 + w], q = sm[32 + w]; if (w < wave) { pgt += g; peq += q; } totgt += g; }
        __syncthreads();
        const int need = cap - totgt;
        if (base < n) {
            int g = pgt, q = peq;
#pragma unroll
            for (int j = 0; j < 16; ++j) {
                const unsigned k = key[j]; const int row = row_base + base + j;
                const bool sel = (k > T) || (k == T && q < need);
                int slot = -1;
                if (sel) { slot = slot_base + g + (q < need ? q : need); ROWIDX[slot] = row; GATE[slot] = __uint_as_float(k); }
                INV[(size_t)row * 16 + e] = slot;
                g += (k > T) ? 1 : 0; q += (k == T) ? 1 : 0;
            }
        }
    }
}
__device__ __forceinline__ void combine_phase(const Args& a, int l, const int kwave) {
    const int lane = TIDX & 63, wave = TIDX >> 6;
    const int gw = blockIdx.x * NWAVES + wave, NGW = gridDim.x * NWAVES;
    const float* mod = (const float*)(a.ws + WS_MOD); bf16* HL = (bf16*)(a.ws + WS_HL);
    const float* XC = (const float*)(a.ws + WS_XC); const int* INV = (const int*)(a.ws + WS_INV); const bf16* Y = (const bf16*)(a.ws + WS_Y);
    const int nrows = (l == 0) ? NROWS : NLAT;
    int row = gw;
    int inv_n = -1; f32x4 vn[4];
    if (row < nrows) { inv_n = (lane < 16) ? INV[(size_t)row * 16 + lane] : -1; const float* xr0 = row < NLAT ? a.out + (size_t)row * D : XC + (size_t)(row - NLAT) * D;
#pragma unroll
        for (int j = 0; j < 4; ++j) vn[j] = *(const f32x4*)(xr0 + 4 * lane + 256 * j); }
    for (; row < nrows; row += NGW) {
        const bool lat = row < NLAT; const int r = lat ? row / S : 4;
        const int inv = inv_n; f32x4 v[4], acc[4];
#pragma unroll
        for (int j = 0; j < 4; ++j) { v[j] = vn[j]; acc[j] = (f32x4){0.f, 0.f, 0.f, 0.f}; }
        float* xr = lat ? a.out + (size_t)row * D : (float*)XC + (size_t)(row - NLAT) * D;
        const int nrow = row + NGW;
        if (nrow < nrows) { inv_n = (lane < 16) ? INV[(size_t)nrow * 16 + lane] : -1; const float* xrn = nrow < NLAT ? a.out + (size_t)nrow * D : XC + (size_t)(nrow - NLAT) * D;
#pragma unroll
            for (int j = 0; j < 4; ++j) vn[j] = *(const f32x4*)(xrn + 4 * lane + 256 * j); }
        unsigned long long mask = __ballot(inv >= 0);
        while (mask) {
            int sl[4];
#pragma unroll
            for (int q = 0; q < 4; ++q) { if (mask) { const int e = __builtin_ctzll(mask); mask &= mask - 1; sl[q] = __shfl(inv, e); } else sl[q] = -1; }
            if (FP8_Y) {
                unsigned w[4][4];
#pragma unroll
                for (int q = 0; q < 4; ++q) if (sl[q] >= 0) { const unsigned char* yr = (const unsigned char*)Y + (size_t)sl[q] * D;
#pragma unroll
                    for (int j = 0; j < 4; ++j) w[q][j] = *(const unsigned*)(yr + 4 * lane + 256 * j); }
#pragma unroll
                for (int q = 0; q < 4; ++q) if (sl[q] >= 0) {
#pragma unroll
                    for (int j = 0; j < 4; ++j) { acc[j][0] += __builtin_amdgcn_cvt_f32_fp8((int)w[q][j], 0); acc[j][1] += __builtin_amdgcn_cvt_f32_fp8((int)w[q][j], 1); acc[j][2] += __builtin_amdgcn_cvt_f32_fp8((int)w[q][j], 2); acc[j][3] += __builtin_amdgcn_cvt_f32_fp8((int)w[q][j], 3); } }
            } else {
                u32x2 w[4][4];
#pragma unroll
                for (int q = 0; q < 4; ++q) if (sl[q] >= 0) { const bf16* yr = Y + (size_t)sl[q] * D;
#pragma unroll
                    for (int j = 0; j < 4; ++j) w[q][j] = *(const u32x2*)(yr + 4 * lane + 256 * j); }
#pragma unroll
                for (int q = 0; q < 4; ++q) if (sl[q] >= 0) {
#pragma unroll
                    for (int j = 0; j < 4; ++j) { acc[j][0] += bf2f(w[q][j].x & 0xffffu); acc[j][1] += bf2f(w[q][j].x >> 16); acc[j][2] += bf2f(w[q][j].y & 0xffffu); acc[j][3] += bf2f(w[q][j].y >> 16); } }
            }
        }
        const float* g2 = mod + (l * 5 + r) * 6144 + 5 * 1024;
#pragma unroll
        for (int j = 0; j < 4; ++j) { const f32x4 gg = *(const f32x4*)(g2 + 4 * lane + 256 * j) * (FP8_Y ? 1.0f / Y8_SCALE : 1.0f); v[j] = v[j] + gg * acc[j]; }
        if (lat) {
#pragma unroll
            for (int j = 0; j < 4; ++j) *(f32x4*)(xr + 4 * lane + 256 * j) = v[j];
        }
        if (l == 0) {
            f32x4 y[4]; const float* m = mod + (1 * 5 + r) * 6144;
            norm_mod(v, y, a.in[6] + 1024, m, m + 1024, lane);
            store_bf16_row(HL + (size_t)row * D, y, lane);
        }
    }
}

namespace pg8 {
constexpr int BM = 256, BK = 64, HALF = 128, HTB = HALF * BK * 2, STAGE_BYTES = 8 * HTB, NXCD = 8, WGM = 8;
__host__ __device__ __forceinline__ int lds_byte(int r, int c) { const int st = (r >> 4) * 2 + (c >> 5), rr = r & 15, cc = c & 31, ob = rr * 64 + cc * 2; return st * 1024 + (ob ^ (((ob >> 9) & 1) << 5)); }
__host__ __device__ __forceinline__ void stage_rc(int b, int& R, int& C) { const int st = b / 1024, sb = b % 1024, swz = sb ^ (((sb >> 9) & 1) << 5); R = (st >> 1) * 16 + swz / 64; C = (st & 1) * 32 + (swz % 64) / 2; }
__host__ __device__ __forceinline__ int perm32(int rho) { const int n = rho >> 4, i = rho & 15; return 8 * (i >> 2) + 4 * n + (i & 3); }
struct Unit { int pm, pn; };
struct Sched {
    int reph = 2;
    int nM, nN, nwg, G, c, mpe;
    const char* Bt; size_t b_estride, b_tstride;
    __device__ __forceinline__ void init(int nM_, int nN_, int G_, int c_, int mpe_, const void* Bt_, size_t es, size_t ts) { nM = nM_; nN = nN_; nwg = nM * nN; G = G_; c = c_; mpe = mpe_; Bt = (const char*)Bt_; b_estride = es; b_tstride = ts; }
    __device__ __forceinline__ bool next(int i, Unit& u) const {
        const long L = (long)i * G + c; if (L >= (long)nwg * reph / 2) return false;
        int wgid = (int)(L % nwg); { const int q = nwg / NXCD, r = nwg % NXCD, xcd = wgid % NXCD, off = wgid / NXCD; wgid = (xcd < r ? xcd * (q + 1) : r * (q + 1) + (xcd - r) * q) + off; }
        const int nig = WGM * nN, gid = wgid / nig, fm = gid * WGM, gsz = (nM - fm) < WGM ? (nM - fm) : WGM;
        int pm = fm + ((wgid % nig) % gsz); u.pn = (wgid % nig) / gsz;
        if (mpe) { const int e = pm / mpe; pm = e * 17 + (pm - e * mpe); }
        u.pm = pm; return true;
    }
    __device__ __forceinline__ const char* b_base(const Unit& u) const { const int e = mpe ? u.pm / 17 : 0; return Bt + (size_t)e * b_estride + (size_t)u.pn * b_tstride; }
};
__device__ __forceinline__ unsigned cvt_pk_bf16(float lo, float hi) { unsigned r; asm volatile("v_cvt_pk_bf16_f32 %0, %1, %2" : "=v"(r) : "v"(lo), "v"(hi)); return r; }

__device__ __forceinline__ u32x4 widen16(u32x2 a, u32x2 b) {
    auto r0 = __builtin_amdgcn_permlane16_swap(a.x, b.x, false, false); auto r1 = __builtin_amdgcn_permlane16_swap(a.y, b.y, false, false);
    u32x4 w; w.x = r0[0]; w.y = r1[0]; w.z = r0[1]; w.w = r1[1]; return w;
}
struct EpiQKV {
    static constexpr bool PERM = true;
    bf16* Q; bf16* Kb; bf16* Vb; int kvw, nqt, nkt; const float* qg; const float* kg; const float* ropet; int rope; float qscale;
    __device__ __forceinline__ void operator()(const f32x4 (&acc)[2][2][4][2], const Unit& u, int wr, int wc, int fr, int fq) const {
        const int row0 = u.pm * BM + wr * 64 + fr;
        if (u.pn >= nqt + nkt) {
            const int colt = (u.pn - nqt - nkt) * BM + wc * 32 + 8 * fq;
#pragma unroll
            for (int ai = 0; ai < 2; ++ai)
#pragma unroll
                for (int m = 0; m < 4; ++m) { bf16* rowp = Vb + (size_t)(row0 + ai * HALF + m * 16) * kvw + colt;
#pragma unroll
                    for (int bj = 0; bj < 2; ++bj) { const f32x4 v0 = acc[ai][bj][m][0], v1 = acc[ai][bj][m][1]; u32x4 w; w.x = cvt_pk_bf16(v0[0], v0[1]); w.y = cvt_pk_bf16(v0[2], v0[3]); w.z = cvt_pk_bf16(v1[0], v1[1]); w.w = cvt_pk_bf16(v1[2], v1[3]);
                        *(u32x4*)(rowp + bj * HALF) = w; } }
            return;
        }
        const bool isq = u.pn < nqt; const int head = isq ? 4 * u.pn + wc : 4 * (u.pn - nqt) + wc;
        const float* gain = isq ? qg : kg; const float scale = isq ? qscale : 1.0f;
        bf16* dst = (isq ? Q : Kb) + head * 64 + 4 * fq; const int ld = isq ? 1024 : kvw;
        f32x4 gv[2][2];
#pragma unroll
        for (int bj = 0; bj < 2; ++bj)
#pragma unroll
            for (int n = 0; n < 2; ++n) gv[bj][n] = *(const f32x4*)(gain + 32 * bj + 16 * n + 4 * fq);
        const bool dorope = rope && (u.pm < NLAT / BM);
#pragma unroll
        for (int ai = 0; ai < 2; ++ai)
#pragma unroll
            for (int m = 0; m < 4; ++m) {
                const int row = row0 + ai * HALF + m * 16;
                float ss = 0.f;
#pragma unroll
                for (int bj = 0; bj < 2; ++bj)
#pragma unroll
                    for (int n = 0; n < 2; ++n) { const f32x4 x = acc[ai][bj][m][n]; ss += (x[0] * x[0] + x[1] * x[1]) + (x[2] * x[2] + x[3] * x[3]); }
                ss += __shfl_xor(ss, 16); ss += __shfl_xor(ss, 32);
                const float rstd = scale / sqrtf(ss * (1.0f / 64.0f) + EPS);
                f32x4 y[2][2];
#pragma unroll
                for (int bj = 0; bj < 2; ++bj)
#pragma unroll
                    for (int n = 0; n < 2; ++n) y[bj][n] = acc[ai][bj][m][n] * rstd * gv[bj][n];
                if (dorope) { const int pos = row & (S - 1);
#pragma unroll
                    for (int bj = 0; bj < 2; ++bj) { const int v = bj == 0 ? (pos >> 6) : (pos & 63); const f32x4 cs = *(const f32x4*)(ropet + v * 16 + 4 * fq), sn = *(const f32x4*)(ropet + 2048 + v * 16 + 4 * fq);
                        const f32x4 a0 = y[bj][0], a1 = y[bj][1]; y[bj][0] = a0 * cs - a1 * sn; y[bj][1] = a0 * sn + a1 * cs; } }
                bf16* rowp = dst + (size_t)row * ld - 4 * fq + ((fq & 1) ? 16 + 4 * (fq - 1) : 4 * fq);
#pragma unroll
                for (int bj = 0; bj < 2; ++bj) {
                    u32x2 wa, wb; wa.x = cvt_pk_bf16(y[bj][0][0], y[bj][0][1]); wa.y = cvt_pk_bf16(y[bj][0][2], y[bj][0][3]); wb.x = cvt_pk_bf16(y[bj][1][0], y[bj][1][1]); wb.y = cvt_pk_bf16(y[bj][1][2], y[bj][1][3]);
                    *(u32x4*)(rowp + 32 * bj) = widen16(wa, wb); }
            }
    }
};
struct EpiOproj {
    static constexpr bool PERM = false;
    const float* base_lat; const float* base_ctx; float* out_lat; float* out_ctx; const float* g1; float accscale;
    __device__ __forceinline__ void operator()(const f32x4 (&acc)[2][2][4][2], const Unit& u, int wr, int wc, int fr, int fq) const {
        const bool lat = u.pm < NLAT / BM; const int r = lat ? (u.pm >> 5) : 4;
        const int col0 = u.pn * BM + wc * 32 + 4 * fq;
        const int row0 = (lat ? u.pm * BM : u.pm * BM - NLAT) + wr * 64 + fr;
        const float* bs = lat ? base_lat : base_ctx; float* os = lat ? out_lat : out_ctx;
        f32x4 gv[2][2];
#pragma unroll
        for (int bj = 0; bj < 2; ++bj)
#pragma unroll
            for (int n = 0; n < 2; ++n) gv[bj][n] = *(const f32x4*)(g1 + r * 6144 + col0 + bj * HALF + n * 16) * accscale;
#pragma unroll
        for (int ai = 0; ai < 2; ++ai)
#pragma unroll
            for (int mp = 0; mp < 2; ++mp) {
                f32x4 pre[2][2][2];
#pragma unroll
                for (int mm = 0; mm < 2; ++mm) { const size_t off = (size_t)(row0 + ai * HALF + (2 * mp + mm) * 16) * D + col0;
#pragma unroll
                    for (int bj = 0; bj < 2; ++bj)
#pragma unroll
                        for (int n = 0; n < 2; ++n) pre[mm][bj][n] = *(const f32x4*)(bs + off + bj * HALF + n * 16); }
                asm volatile("" ::: "memory");
#pragma unroll
                for (int mm = 0; mm < 2; ++mm) { const size_t off = (size_t)(row0 + ai * HALF + (2 * mp + mm) * 16) * D + col0;
#pragma unroll
                    for (int bj = 0; bj < 2; ++bj)
#pragma unroll
                        for (int n = 0; n < 2; ++n) *(f32x4*)(os + off + bj * HALF + n * 16) = pre[mm][bj][n] + gv[bj][n] * acc[ai][bj][2 * mp + mm][n]; }
                asm volatile("" ::: "memory");
            }
    }
};
__device__ __forceinline__ float silu_fast(float x) { return x * __builtin_amdgcn_rcpf(1.0f + __expf(-x)); }
struct EpiGU {
    static constexpr bool PERM = true;
    bf16* H; float inscale;
    __device__ __forceinline__ void operator()(const f32x4 (&acc)[2][2][4][2], const Unit& u, int wr, int wc, int fr, int fq) const {
        const int row0 = u.pm * BM + wr * 64 + fr, col0 = u.pn * HALF + wc * 32 + 8 * fq;
#pragma unroll
        for (int ai = 0; ai < 2; ++ai)
#pragma unroll
            for (int mp = 0; mp < 2; ++mp) {
                u32x2 w8[2]; u32x4 wb[2];
#pragma unroll
                for (int mm = 0; mm < 2; ++mm) { const int m = 2 * mp + mm;
                    const f32x4 g0 = acc[ai][0][m][0], g1 = acc[ai][0][m][1], u0 = acc[ai][1][m][0], u1 = acc[ai][1][m][1];
                    const float ce = -inscale * LOG2E, cs = inscale * inscale;
                    float hv[8];
#pragma unroll
                    for (int i = 0; i < 4; ++i) {
                        hv[i] = (g0[i] * u0[i]) * (cs * __builtin_amdgcn_rcpf(1.0f + __builtin_amdgcn_exp2f(g0[i] * ce)));
                        hv[4 + i] = (g1[i] * u1[i]) * (cs * __builtin_amdgcn_rcpf(1.0f + __builtin_amdgcn_exp2f(g1[i] * ce))); }
                    if (FP8_DOWN) {
                        int w0 = 0, w1 = 0;
                        w0 = __builtin_amdgcn_cvt_pk_fp8_f32(hv[0], hv[1], w0, false); w0 = __builtin_amdgcn_cvt_pk_fp8_f32(hv[2], hv[3], w0, true);
                        w1 = __builtin_amdgcn_cvt_pk_fp8_f32(hv[4], hv[5], w1, false); w1 = __builtin_amdgcn_cvt_pk_fp8_f32(hv[6], hv[7], w1, true);
                        w8[mm].x = (unsigned)w0; w8[mm].y = (unsigned)w1;
                    } else { wb[mm].x = cvt_pk_bf16(hv[0], hv[1]); wb[mm].y = cvt_pk_bf16(hv[2], hv[3]); wb[mm].z = cvt_pk_bf16(hv[4], hv[5]); wb[mm].w = cvt_pk_bf16(hv[6], hv[7]); }
                }
                if (FP8_DOWN) {
                    const int m = 2 * mp + (fq & 1);
                    *(u32x4*)((unsigned char*)H + (size_t)(row0 + ai * HALF + m * 16) * FF + col0 - 8 * (fq & 1)) = widen16(w8[0], w8[1]);
                } else {
#pragma unroll
                    for (int mm = 0; mm < 2; ++mm) *(u32x4*)(H + (size_t)(row0 + ai * HALF + (2 * mp + mm) * 16) * FF + col0) = wb[mm];
                }
            }
    }
};
struct EpiDown {
    static constexpr bool PERM = true;
    bf16* Y; const float* gate;
    __device__ __forceinline__ void operator()(const f32x4 (&acc)[2][2][4][2], const Unit& u, int wr, int wc, int fr, int fq) const {
        const int row0 = u.pm * BM + wr * 64 + fr, col0 = u.pn * BM + wc * 32 + 8 * fq;
        static_assert(FP8_Y, "fp8 Y only");
        const float gsc = (FP8_DOWN ? W8_INV : 1.0f) * Y8_SCALE;
#pragma unroll
        for (int ai = 0; ai < 2; ++ai) {
            float gt4[4];
#pragma unroll
            for (int m = 0; m < 4; ++m) gt4[m] = gate[row0 + ai * HALF + m * 16] * gsc;
#pragma unroll
            for (int mp = 0; mp < 2; ++mp) {
#pragma unroll
                for (int bj = 0; bj < 2; ++bj) {
                    u32x2 w8[2];
#pragma unroll
                    for (int mm = 0; mm < 2; ++mm) { const int m = 2 * mp + mm; const float gt = gt4[m];
                        const f32x4 v0 = acc[ai][bj][m][0] * gt, v1 = acc[ai][bj][m][1] * gt;
                        int w0 = 0, w1 = 0;
                        w0 = __builtin_amdgcn_cvt_pk_fp8_f32(v0[0], v0[1], w0, false); w0 = __builtin_amdgcn_cvt_pk_fp8_f32(v0[2], v0[3], w0, true);
                        w1 = __builtin_amdgcn_cvt_pk_fp8_f32(v1[0], v1[1], w1, false); w1 = __builtin_amdgcn_cvt_pk_fp8_f32(v1[2], v1[3], w1, true);
                        w8[mm].x = (unsigned)w0; w8[mm].y = (unsigned)w1; }
                    *(u32x4*)((unsigned char*)Y + (size_t)(row0 + ai * HALF + (2 * mp + (fq & 1)) * 16) * D + col0 - 8 * (fq & 1) + bj * HALF) = widen16(w8[0], w8[1]);
                }
            }
        }
    }
};
typedef int v8i32 __attribute__((ext_vector_type(8)));
typedef int v4i32 __attribute__((ext_vector_type(4)));
template <class Epi, bool GATHER, bool FP8 = false>
__device__ __forceinline__ void gemm_phase(LAS unsigned char* lds, const char* Abase, int K, const Sched& S, const Epi& E, LAS int* ldsidx, const int* rowidx, const int kwave) {
    const int tid = TIDX, wid = __builtin_amdgcn_readfirstlane(tid >> 6), lane = tid & 63, wr = wid >> 2, wc = wid & 3, fr = lane & 15, fq = lane >> 4;
    const int nt = K / BK;
    int Rst[2], Cst[2]; unsigned voffB[2];
#pragma unroll
    for (int i = 0; i < 2; ++i) { int R, C; stage_rc(tid * 16 + i * 8192, R, C); Rst[i] = R; Cst[i] = C; const int Rb = Epi::PERM ? ((R & ~31) + perm32(R & 31)) : R; voffB[i] = (unsigned)(Rb * K + C) * 2u; }
    const size_t kstep = (size_t)(BK * 2);
    const size_t hstep = (size_t)HALF * K * 2;
    const unsigned ldsw = (unsigned)wid * 1024u;
    constexpr bool ASM_STAGE = FP8;
    const unsigned ldsbase = (unsigned)__builtin_amdgcn_readfirstlane((int)((unsigned)(uintptr_t)lds + ldsw));
    const int aoff = lds_byte(wr * 64 + fr, fq * 8), boff = lds_byte(wc * 32 + fr, fq * 8);
    Unit cur, nxt; int ui = 0;
    if (!S.next(0, cur)) return;
    if (GATHER) {
        Unit t_; for (int i = 0; S.next(i, t_); ++i) if (tid < 256) ldsidx[i * 256 + tid] = rowidx[t_.pm * 256 + tid];
        __syncthreads();
    }
#define PG8_SA(b, h) (((b) * 2 + (h)) * HTB)
#define PG8_SB(b, h) ((4 + (b) * 2 + (h)) * HTB)
#define PG8_GLDS_ASM(off32, gbase, ldsdst) do { unsigned keep_; asm volatile("s_nop 4\n\ts_mov_b32 %0, m0\n\ts_mov_b32 m0, %3\n\ts_nop 0\n\tglobal_load_lds_dwordx4 %1, %2\n\ts_mov_b32 m0, %0" \
        : "=&s"(keep_) : "v"(off32), "s"((const char*)(gbase)), "s"(ldsdst) : "memory"); } while (0)
#define PG8_STAGE(bufoff, gbase, voff) do { if constexpr (ASM_STAGE) { PG8_GLDS_ASM((voff)[0], gbase, ldsbase + (unsigned)(bufoff)); PG8_GLDS_ASM((voff)[1], gbase, ldsbase + (unsigned)((bufoff) + 8192)); } \
        else { _Pragma("unroll") for (int _i = 0; _i < 2; ++_i) \
        __builtin_amdgcn_global_load_lds((const unsigned*)((const char*)(gbase) + (voff)[_i]), (LAS unsigned*)(lds + (bufoff) + ldsw + _i * 8192), 16, 0, 0); } } while (0)
#define PG8_AOFF(vo, u_, ui_) do { const int _t = TIDX; _Pragma("unroll") for (int _i = 0; _i < 2; ++_i) { int _R, _C; stage_rc(_t * 16 + _i * 8192, _R, _C); _Pragma("unroll") for (int _h = 0; _h < 2; ++_h) { \
        const int _row = GATHER ? ldsidx[(ui_) * 256 + _h * HALF + _R] : (u_).pm * BM + _h * HALF + _R; vo[_h][_i] = (unsigned)(_row * K + _C) * 2u; } } } while (0)
#define PG8_LD2(p) __builtin_shufflevector(*(const LAS v4i32*)(p), *(const LAS v4i32*)((p) + 1024), 0, 1, 2, 3, 4, 5, 6, 7)
#define PG8_LDA(dst, b, h) do { _Pragma("unroll") for (int m = 0; m < 4; ++m) dst[m] = PG8_LD2(lds + PG8_SA(b, h) + aoff + m * 2048); } while (0)
#define PG8_LDB(dst, b, h) do { _Pragma("unroll") for (int n = 0; n < 2; ++n) dst[n] = PG8_LD2(lds + PG8_SB(b, h) + boff + n * 2048); } while (0)
#define PG8_H0(x) __builtin_bit_cast(bf16x8, __builtin_shufflevector(x, x, 0, 1, 2, 3))
#define PG8_H1(x) __builtin_bit_cast(bf16x8, __builtin_shufflevector(x, x, 4, 5, 6, 7))
#define PG8_MMA(ai, bj, At, Bt) do { __builtin_amdgcn_s_setprio(1); \
        if constexpr (FP8) { _Pragma("unroll") for (int m = 0; m < 4; ++m) _Pragma("unroll") for (int n = 0; n < 2; ++n) \
            acc[ai][bj][m][n] = __builtin_amdgcn_mfma_scale_f32_16x16x128_f8f6f4(Bt[n], At[m], acc[ai][bj][m][n], 0, 0, 0, 0x7f7f7f7f, 0, 0x7f7f7f7f); } \
        else { _Pragma("unroll") for (int m = 0; m < 4; ++m) _Pragma("unroll") for (int n = 0; n < 2; ++n) { \
            acc[ai][bj][m][n] = __builtin_amdgcn_mfma_f32_16x16x32_bf16(PG8_H0(Bt[n]), PG8_H0(At[m]), acc[ai][bj][m][n], 0, 0, 0); \
            acc[ai][bj][m][n] = __builtin_amdgcn_mfma_f32_16x16x32_bf16(PG8_H1(Bt[n]), PG8_H1(At[m]), acc[ai][bj][m][n], 0, 0, 0); } } \
        __builtin_amdgcn_s_setprio(0); } while (0)
#define PG8_WAIT_V(n) asm volatile("s_waitcnt vmcnt(" #n ")" ::: "memory")
#define PG8_WAIT_L(n) asm volatile("s_waitcnt lgkmcnt(" #n ")" ::: "memory")
#define PG8_BAR __builtin_amdgcn_s_barrier()
#define PG8_SCHED __builtin_amdgcn_sched_barrier(0)
    f32x4 acc[2][2][4][2];
#pragma unroll
    for (int a = 0; a < 2; ++a)
#pragma unroll
        for (int b = 0; b < 2; ++b)
#pragma unroll
            for (int m = 0; m < 4; ++m)
#pragma unroll
                for (int n = 0; n < 2; ++n) acc[a][b][m][n] = (f32x4){0.f, 0.f, 0.f, 0.f};
    v8i32 At[4], B0[2], B1[2];
    unsigned voC[2][2];
    const size_t hstepA = GATHER ? 0 : hstep;
    const char* cA = Abase; const char* nA = Abase;
    if (GATHER) { PG8_AOFF(voC, cur, 0); }
    else {
#pragma unroll
        for (int i = 0; i < 2; ++i) { voC[0][i] = (unsigned)(Rst[i] * K + Cst[i]) * 2u; voC[1][i] = voC[0][i]; }
        cA = Abase + (size_t)cur.pm * 2 * hstep;
    }
    const char* cB = S.b_base(cur);
    PG8_STAGE(PG8_SB(0, 0), cB, voffB); PG8_STAGE(PG8_SB(0, 1), cB + hstep, voffB); PG8_STAGE(PG8_SA(0, 0), cA, voC[0]); PG8_STAGE(PG8_SA(0, 1), cA + hstepA, voC[1]);
    if (wr == 1) PG8_BAR;
    PG8_WAIT_V(2); PG8_BAR;
    PG8_STAGE(PG8_SB(1, 0), cB + kstep, voffB); PG8_STAGE(PG8_SA(1, 0), cA + kstep, voC[0]); PG8_STAGE(PG8_SB(1, 1), cB + hstep + kstep, voffB);
    PG8_WAIT_V(6); PG8_BAR;
    for (;;) {
        const bool has_next = S.next(ui + 1, nxt);
        if (!GATHER) nA = has_next ? Abase + (size_t)nxt.pm * 2 * hstep : cA;
        const char* nB = has_next ? S.b_base(nxt) : cB;
#pragma nounroll
        for (int t = 0; t < nt; t += 2) {
            const bool last = (t == nt - 2);
            const char* kA1 = cA + (size_t)(t + 1) * kstep;
            const char* kA2 = last ? nA : cA + (size_t)(t + 2) * kstep; const char* kA3 = kA2 + kstep;
            const char* b2 = last ? nB : cB + (size_t)(t + 2) * kstep; const char* b3 = b2 + kstep;
            PG8_LDB(B0, 0, 0); PG8_LDB(B1, 0, 1); PG8_SCHED; PG8_LDA(At, 0, 0); PG8_STAGE(PG8_SA(1, 1), kA1 + hstepA, voC[1]);
            if (GATHER) { if (last && has_next) { PG8_AOFF(voC, nxt, ui + 1); } }
            PG8_WAIT_V(8); PG8_WAIT_L(0); PG8_BAR; PG8_MMA(0, 0, At, B0); PG8_MMA(0, 1, At, B1); PG8_BAR; PG8_SCHED;
            PG8_LDA(At, 0, 1); PG8_STAGE(PG8_SB(0, 0), b2, voffB); PG8_STAGE(PG8_SB(0, 1), b2 + hstep, voffB); PG8_STAGE(PG8_SA(0, 0), kA2, voC[0]);
            PG8_WAIT_V(8); PG8_WAIT_L(0); PG8_BAR; PG8_MMA(1, 0, At, B0); PG8_MMA(1, 1, At, B1); PG8_BAR; PG8_SCHED;
            PG8_LDB(B0, 1, 0); PG8_LDB(B1, 1, 1); PG8_SCHED; PG8_LDA(At, 1, 0); PG8_STAGE(PG8_SA(0, 1), kA2 + hstepA, voC[1]);
            PG8_WAIT_V(8); PG8_WAIT_L(0); PG8_BAR; PG8_MMA(0, 0, At, B0); PG8_MMA(0, 1, At, B1); PG8_BAR; PG8_SCHED;
            PG8_LDA(At, 1, 1); PG8_STAGE(PG8_SB(1, 0), b3, voffB); PG8_STAGE(PG8_SB(1, 1), b3 + hstep, voffB); PG8_STAGE(PG8_SA(1, 0), kA3, voC[0]);
            PG8_WAIT_V(8); PG8_WAIT_L(0); PG8_BAR; PG8_MMA(1, 0, At, B0); PG8_MMA(1, 1, At, B1); PG8_BAR; PG8_SCHED;
        }
        if (wr == 0) PG8_BAR;
        { int fr_e = fr, fq_e = fq; asm volatile("" : "+v"(fr_e), "+v"(fq_e));
          E(acc, cur, wr, wc, fr_e, fq_e); }
        if (!has_next) break;
#pragma unroll
        for (int a = 0; a < 2; ++a)
#pragma unroll
            for (int b = 0; b < 2; ++b)
#pragma unroll
                for (int m = 0; m < 4; ++m)
#pragma unroll
                    for (int n = 0; n < 2; ++n) acc[a][b][m][n] = (f32x4){0.f, 0.f, 0.f, 0.f};
        cur = nxt; cB = nB; ++ui;
        if (!GATHER) cA = nA;
        if (wr == 1) PG8_BAR;
    }
    PG8_WAIT_V(0);
    PG8_BAR;
#undef PG8_SA
#undef PG8_SB
#undef PG8_STAGE
#undef PG8_GLDS_ASM
#undef PG8_AOFF
#undef PG8_LDA
#undef PG8_LDB
#undef PG8_MMA
#undef PG8_LD2
#undef PG8_H0
#undef PG8_H1
#undef PG8_WAIT_V
#undef PG8_WAIT_L
#undef PG8_BAR
#undef PG8_SCHED
}
}


namespace att {
typedef float f32x16 __attribute__((ext_vector_type(16)));
typedef short s16x4 __attribute__((ext_vector_type(4)));
constexpr int TILEB = 8192, OFF_K = 0, OFF_V = 4 * TILEB, OFF_BIAS = 8 * TILEB, BIAS_PITCH = 160, BIAS_ORG = 64, OFF_QBOX = 80 * 1024  ;
constexpr float NEG = -1e30f;
__device__ __forceinline__ int crow(int r, int h) { return (r & 3) + 8 * (r >> 2) + 4 * h; }
struct StageOff { unsigned k, v; };
__device__ __forceinline__ StageOff stage_off(int tid, int ld) {
    const int row = tid >> 3, ch = tid & 7; StageOff o;
    o.k = (unsigned)(row * ld + ((ch ^ ((row >> 1) & 7)) << 3)) * 2u; o.v = (unsigned)(row * ld + ((ch ^ (((row >> 1) & 1) << 2)) << 3)) * 2u; return o;
}
#define ATT_GLDS(voff, gbase, ldsdst, imm) do { unsigned keep_; asm volatile("s_mov_b32 %0, m0\n\ts_mov_b32 m0, %3\n\ts_nop 0\n\tglobal_load_lds_dwordx4 %1, %2 offset:" #imm "\n\ts_mov_b32 m0, %0" \
        : "=&s"(keep_) : "v"(voff), "s"((const char*)(gbase)), "s"(ldsdst) : "memory"); } while (0)
__device__ __forceinline__ void stage_tile_at(LAS unsigned char* kdst, LAS unsigned char* vdst, const bf16* kbase, const bf16* vbase, const StageOff& so, int wave) {
    const unsigned kd = (unsigned)__builtin_amdgcn_readfirstlane((int)(unsigned)(uintptr_t)(kdst + wave * 1024));
    const unsigned vd = (unsigned)__builtin_amdgcn_readfirstlane((int)(unsigned)(uintptr_t)(vdst + wave * 1024));
    ATT_GLDS(so.k, kbase, kd, 0);
    ATT_GLDS(so.v, vbase, vd, 0);
}
__device__ __forceinline__ void stage_tile(LAS unsigned char* lds, int slot, const bf16* kbase, const bf16* vbase, const StageOff& so, int wave) {
    const unsigned kd = (unsigned)__builtin_amdgcn_readfirstlane((int)(unsigned)(uintptr_t)(lds + OFF_K + slot * TILEB + wave * 1024));
    const unsigned vd = (unsigned)__builtin_amdgcn_readfirstlane((int)(unsigned)(uintptr_t)(lds + OFF_V + slot * TILEB + wave * 1024));
    ATT_GLDS(so.k, kbase, kd, 0);
    ATT_GLDS(so.v, vbase, vd, 0);
}
struct WaveCtx { int koff[4]; int vl[2]; bf16x8 qf[4]; f32x16 o[2]; f32x16 negm; float m, l; };
__device__ __forceinline__ void wave_offsets(WaveCtx& c, int lane, int krow0  ) {
    const int r31 = lane & 31, h = lane >> 5, row = krow0 + r31;
#pragma unroll
    for (int ds = 0; ds < 4; ++ds) c.koff[ds] = row * 128 + (((2 * ds + h) ^ ((row >> 1) & 7)) << 4);
    const int i = lane & 15, qp = i >> 2, pp = i & 3, cb = (lane >> 4) & 1;
#pragma unroll
    for (int db = 0; db < 2; ++db) c.vl[db] = (4 * h + qp) * 128 + ((db ^ ((qp >> 1) & 1)) << 6) + 32 * cb + 8 * pp;
}
__device__ __forceinline__ void load_q(bf16x8 (&qf)[4], int lane, const bf16* qrow) {
#pragma unroll
    for (int ds = 0; ds < 4; ++ds) qf[ds] = *(const bf16x8*)(qrow + 16 * ds + 8 * (lane >> 5));
}
__device__ __forceinline__ void set_negm(WaveCtx& c) {
#pragma unroll
    for (int r = 0; r < 16; ++r) c.negm[r] = -c.m;
    asm volatile("" : "+v"(c.negm));
}
__device__ __forceinline__ void wave_reset(WaveCtx& c, int lane, float m0, float l0, bool need_negm = true) {
#pragma unroll
    for (int r = 0; r < 16; ++r) { c.o[0][r] = 0.f; c.o[1][r] = 0.f; }
    c.m = m0; c.l = (lane < 32) ? l0 : 0.f; if (need_negm) set_negm(c);
}
typedef short v4i16_t __attribute__((ext_vector_type(4)));
__device__ __forceinline__ s16x4 vtr(const LAS unsigned char* p) { return __builtin_bit_cast(s16x4, __builtin_amdgcn_ds_read_tr16_b64_v4i16((LAS v4i16_t*)p)); }
typedef float f32x2_t __attribute__((ext_vector_type(2))); typedef __bf16 bf16x2_t __attribute__((ext_vector_type(2)));
__device__ __forceinline__ unsigned cvtpk(float lo, float hi) { f32x2_t v = {lo, hi}; bf16x2_t b = __builtin_convertvector(v, bf16x2_t); return __builtin_bit_cast(unsigned, b); }
__device__ __forceinline__ float max3f(float a, float b, float c3) { float r; asm("v_max3_f32 %0, %1, %2, %3" : "=v"(r) : "v"(a), "v"(b), "v"(c3)); return r; }
__device__ __forceinline__ float max2f(float a, float b) { float r; asm("v_max_f32_e32 %0, %1, %2" : "=v"(r) : "v"(a), "v"(b)); return r; }
__device__ __forceinline__ bf16x8 pack8(const f32x16& p, int s) {
    u32x4 w; w.x = cvtpk(p[8 * s], p[8 * s + 1]); w.y = cvtpk(p[8 * s + 2], p[8 * s + 3]); w.z = cvtpk(p[8 * s + 4], p[8 * s + 5]); w.w = cvtpk(p[8 * s + 6], p[8 * s + 7]);
    return __builtin_bit_cast(bf16x8, w);
}
constexpr float ATT_THR = 8.0f;
__device__ __forceinline__ bool update_ref(WaveCtx& c, float mx, float& dl) {
    { auto rr = __builtin_amdgcn_permlane32_swap(__float_as_uint(mx), __float_as_uint(mx), false, false); mx = max2f(__uint_as_float(rr[0]), __uint_as_float(rr[1])); }
    dl = 0.f;
    if (__builtin_expect(__any(mx > ATT_THR), 0)) {
        dl = max2f(mx, 0.f);
        const float f = __builtin_amdgcn_exp2f(-dl);
        c.m += dl; c.l *= f;
        c.o[0] = c.o[0] * f; c.o[1] = c.o[1] * f;
        set_negm(c);
        return true;
    }
    return false;
}
#define ATT_SB() __builtin_amdgcn_sched_barrier(0)
struct VFrag { s16x4 lo[4], hi[4]; };
__device__ __forceinline__ void load_v32(const WaveCtx& c, VFrag& f, const LAS unsigned char* vb) {
#pragma unroll
    for (int db = 0; db < 2; ++db)
#pragma unroll
        for (int s = 0; s < 2; ++s) { const LAS unsigned char* p = vb + c.vl[db] + s * 2048; f.lo[db * 2 + s] = vtr(p); f.hi[db * 2 + s] = vtr(p + 1024); }
}
__device__ __forceinline__ void pv32(WaveCtx& c, const f32x16& p, const VFrag& f) {
    const bf16x8 pf0 = pack8(p, 0), pf1 = pack8(p, 1);
#pragma unroll
    for (int db = 0; db < 2; ++db) {
        { const s16x4 lo = f.lo[db * 2], hi = f.hi[db * 2]; const bf16x8 vf = (bf16x8){lo[0], lo[1], lo[2], lo[3], hi[0], hi[1], hi[2], hi[3]}; c.o[db] = __builtin_amdgcn_mfma_f32_32x32x16_bf16(vf, pf0, c.o[db], 0, 0, 0); }
        { const s16x4 lo = f.lo[db * 2 + 1], hi = f.hi[db * 2 + 1]; const bf16x8 vf = (bf16x8){lo[0], lo[1], lo[2], lo[3], hi[0], hi[1], hi[2], hi[3]}; c.o[db] = __builtin_amdgcn_mfma_f32_32x32x16_bf16(vf, pf1, c.o[db], 0, 0, 0); }
    }
}
__device__ __forceinline__ void tile64(WaveCtx& c, const LAS unsigned char* kb, const LAS unsigned char* vb, int qq, int h, int MASK  ) {
    bf16x8 kf[8];
#pragma unroll
    for (int ds = 0; ds < 4; ++ds) { kf[2 * ds] = *(const LAS bf16x8*)(kb + c.koff[ds]); kf[2 * ds + 1] = *(const LAS bf16x8*)(kb + 4096 + c.koff[ds]); }
    ATT_SB();
    f32x16 p0 = __builtin_amdgcn_mfma_f32_32x32x16_bf16(kf[0], c.qf[0], c.negm, 0, 0, 0), p1 = __builtin_amdgcn_mfma_f32_32x32x16_bf16(kf[1], c.qf[0], c.negm, 0, 0, 0);
#pragma unroll
    for (int ds = 1; ds < 4; ++ds) { p0 = __builtin_amdgcn_mfma_f32_32x32x16_bf16(kf[2 * ds], c.qf[ds], p0, 0, 0, 0); p1 = __builtin_amdgcn_mfma_f32_32x32x16_bf16(kf[2 * ds + 1], c.qf[ds], p1, 0, 0, 0); }
    VFrag f0, f1; load_v32(c, f0, vb); load_v32(c, f1, vb + 4096);
    ATT_SB();
    asm volatile("s_nop 15\n\ts_nop 7" : "+v"(p0), "+v"(p1));
    if (MASK == 1) {
#pragma unroll
        for (int r = 0; r < 16; ++r) { const int kk = crow(r, h); if (kk < qq) p0[r] = NEG; if (kk + 32 < qq) p1[r] = NEG; } }
    if (MASK == 2) {
#pragma unroll
        for (int r = 0; r < 16; ++r) { const int kk = crow(r, h); if (kk > qq) p0[r] = NEG; if (kk + 32 > qq) p1[r] = NEG; } }
    float ma = max3f(p0[0], p0[1], p1[0]), mb = max3f(p0[2], p0[3], p1[1]); ma = max3f(ma, p1[2], p1[3]);
#pragma unroll
    for (int r = 4; r < 16; r += 4) { ma = max3f(ma, p0[r], p0[r + 1]); mb = max3f(mb, p0[r + 2], p0[r + 3]); ma = max3f(ma, p1[r], p1[r + 1]); mb = max3f(mb, p1[r + 2], p1[r + 3]); }
    float dl;
    if (update_ref(c, max2f(ma, mb), dl)) {
#pragma unroll
        for (int r = 0; r < 16; ++r) { p0[r] -= dl; p1[r] -= dl; } }
    float ls = 0.f;
#pragma unroll
    for (int r = 0; r < 16; ++r) { p0[r] = __builtin_amdgcn_exp2f(p0[r]); p1[r] = __builtin_amdgcn_exp2f(p1[r]); ls += p0[r] + p1[r]; }
    c.l += ls;
    pv32(c, p0, f0); pv32(c, p1, f1);
}
constexpr float ATT_FAST_BOUND = 60.0f;
__device__ __forceinline__ void tile64_fast(WaveCtx& c, const LAS unsigned char* kb, const LAS unsigned char* vb, int qq, int h, int MASK  ) {
    bf16x8 kf[8];
#pragma unroll
    for (int ds = 0; ds < 4; ++ds) { kf[2 * ds] = *(const LAS bf16x8*)(kb + c.koff[ds]); kf[2 * ds + 1] = *(const LAS bf16x8*)(kb + 4096 + c.koff[ds]); }
    ATT_SB();
    f32x16 p0, p1;
#pragma unroll
    for (int r = 0; r < 16; ++r) { p0[r] = 0.f; p1[r] = 0.f; }
#pragma unroll
    for (int ds = 0; ds < 4; ++ds) { p0 = __builtin_amdgcn_mfma_f32_32x32x16_bf16(kf[2 * ds], c.qf[ds], p0, 0, 0, 0); p1 = __builtin_amdgcn_mfma_f32_32x32x16_bf16(kf[2 * ds + 1], c.qf[ds], p1, 0, 0, 0); }
    VFrag f0, f1; load_v32(c, f0, vb); load_v32(c, f1, vb + 4096);
    ATT_SB();
    if (MASK == 1) {
#pragma unroll
        for (int r = 0; r < 16; ++r) { const int kk = crow(r, h); if (kk < qq) p0[r] = NEG; if (kk + 32 < qq) p1[r] = NEG; } }
    if (MASK == 2) {
#pragma unroll
        for (int r = 0; r < 16; ++r) { const int kk = crow(r, h); if (kk > qq) p0[r] = NEG; if (kk + 32 > qq) p1[r] = NEG; } }
    float ls = 0.f;
#pragma unroll
    for (int r = 0; r < 16; ++r) { p0[r] = __builtin_amdgcn_exp2f(p0[r]); p1[r] = __builtin_amdgcn_exp2f(p1[r]); ls += p0[r] + p1[r]; }
    c.l += ls;
    pv32(c, p0, f0); pv32(c, p1, f1);
}
__device__ __forceinline__ void ldk64(bf16x8 (&kf)[8], const WaveCtx& c, const LAS unsigned char* kb) {
#pragma unroll
    for (int ds = 0; ds < 4; ++ds) { kf[2 * ds] = *(const LAS bf16x8*)(kb + c.koff[ds]); kf[2 * ds + 1] = *(const LAS bf16x8*)(kb + 4096 + c.koff[ds]); }
}
template <bool PRE>
__device__ __forceinline__ void tile64_fast_core(WaveCtx& c, const bf16x8 (&kf)[8], bf16x8 (&kn)[8], const LAS unsigned char* knb, const LAS unsigned char* vb, int qq, int h, int MASK  ) {
    f32x16 p0, p1;
#pragma unroll
    for (int r = 0; r < 16; ++r) { p0[r] = 0.f; p1[r] = 0.f; }
#pragma unroll
    for (int ds = 0; ds < 4; ++ds) { p0 = __builtin_amdgcn_mfma_f32_32x32x16_bf16(kf[2 * ds], c.qf[ds], p0, 0, 0, 0); p1 = __builtin_amdgcn_mfma_f32_32x32x16_bf16(kf[2 * ds + 1], c.qf[ds], p1, 0, 0, 0); }
    VFrag f0, f1; load_v32(c, f0, vb); load_v32(c, f1, vb + 4096);
    if (PRE) ldk64(kn, c, knb);
    if (MASK == 1) {
#pragma unroll
        for (int r = 0; r < 16; ++r) { const int kk = crow(r, h); if (kk < qq) p0[r] = NEG; if (kk + 32 < qq) p1[r] = NEG; } }
    if (MASK == 2) {
#pragma unroll
        for (int r = 0; r < 16; ++r) { const int kk = crow(r, h); if (kk > qq) p0[r] = NEG; if (kk + 32 > qq) p1[r] = NEG; } }
    float ls = 0.f;
#pragma unroll
    for (int r = 0; r < 16; ++r) { p0[r] = __builtin_amdgcn_exp2f(p0[r]); p1[r] = __builtin_amdgcn_exp2f(p1[r]); ls += p0[r] + p1[r]; }
    c.l += ls;
    pv32(c, p0, f0); pv32(c, p1, f1);
}
__device__ __forceinline__ void tile32_b_fast(WaveCtx& c, const LAS unsigned char* kb, const int (&koffL)[4], const LAS unsigned char* vb, const LAS float* brow, bool rowok, int kstart, int wst, int h) {
    bf16x8 kf[4];
#pragma unroll
    for (int ds = 0; ds < 4; ++ds) kf[ds] = *(const LAS bf16x8*)(kb + koffL[ds]);
    float bv[16];
#pragma unroll
    for (int r = 0; r < 16; ++r) bv[r] = brow[(r & 3) + 8 * (r >> 2)];
    ATT_SB();
    f32x16 p0;
#pragma unroll
    for (int r = 0; r < 16; ++r) p0[r] = 0.f;
#pragma unroll
    for (int ds = 0; ds < 4; ++ds) p0 = __builtin_amdgcn_mfma_f32_32x32x16_bf16(kf[ds], c.qf[ds], p0, 0, 0, 0);
    VFrag f0; load_v32(c, f0, vb);
    ATT_SB();
    float ls = 0.f;
#pragma unroll
    for (int r = 0; r < 16; ++r) { const int kc = kstart + (r & 3) + 8 * (r >> 2) + 4 * h; const float sv = (rowok && kc >= wst && kc < wst + 16) ? p0[r] + bv[r] : NEG; p0[r] = __builtin_amdgcn_exp2f(sv); ls += p0[r]; }
    c.l += ls;
    pv32(c, p0, f0);
}
struct B32In { bf16x8 kf[4]; float bv[16]; };
__device__ __forceinline__ void ld_b32(B32In& in, const LAS unsigned char* kb, const int (&koffL)[4], const LAS float* brow) {
#pragma unroll
    for (int ds = 0; ds < 4; ++ds) in.kf[ds] = *(const LAS bf16x8*)(kb + koffL[ds]);
#pragma unroll
    for (int r = 0; r < 16; ++r) in.bv[r] = brow[(r & 3) + 8 * (r >> 2)];
}
template <bool PRE>
__device__ __forceinline__ void tile32_b_fast_core(WaveCtx& c, const B32In& in, B32In& nx, const LAS unsigned char* knb, const int (&koffL)[4], const LAS float* nbrow, const LAS unsigned char* vb, bool rowok, int kstart, int wst, int h) {
    f32x16 p0;
#pragma unroll
    for (int r = 0; r < 16; ++r) p0[r] = 0.f;
#pragma unroll
    for (int ds = 0; ds < 4; ++ds) p0 = __builtin_amdgcn_mfma_f32_32x32x16_bf16(in.kf[ds], c.qf[ds], p0, 0, 0, 0);
    VFrag f0; load_v32(c, f0, vb);
    if (PRE) ld_b32(nx, knb, koffL, nbrow);
    float ls = 0.f;
#pragma unroll
    for (int r = 0; r < 16; ++r) { const int kc = kstart + (r & 3) + 8 * (r >> 2) + 4 * h; const float sv = (rowok && kc >= wst && kc < wst + 16) ? p0[r] + in.bv[r] : NEG; p0[r] = __builtin_amdgcn_exp2f(sv); ls += p0[r]; }
    c.l += ls;
    pv32(c, p0, f0);
}
__device__ __forceinline__ void ldk32(bf16x8 (&kf)[4], const LAS unsigned char* kb, const int (&koffL)[4]) {
#pragma unroll
    for (int ds = 0; ds < 4; ++ds) kf[ds] = *(const LAS bf16x8*)(kb + koffL[ds]);
}
__device__ __forceinline__ void ldbias(float (&bv)[16], const LAS float* brow) {
#pragma unroll
    for (int r = 0; r < 16; ++r) bv[r] = brow[(r & 3) + 8 * (r >> 2)];
}
template <bool PRE>
__device__ __forceinline__ void tile32_b_fast_core(WaveCtx& c, const bf16x8 (&kf)[4], const float (&bv)[16], bf16x8 (&kn)[4], float (&bvn)[16], const LAS unsigned char* knb, const LAS float* nbrow, const int (&koffL)[4], const LAS unsigned char* vb, bool rowok, int kstart, int wst, int h) {
    f32x16 p0;
#pragma unroll
    for (int r = 0; r < 16; ++r) { const int kc = kstart + (r & 3) + 8 * (r >> 2) + 4 * h; p0[r] = (rowok && kc >= wst && kc < wst + 16) ? bv[r] : NEG; }
#pragma unroll
    for (int ds = 0; ds < 4; ++ds) p0 = __builtin_amdgcn_mfma_f32_32x32x16_bf16(kf[ds], c.qf[ds], p0, 0, 0, 0);
    VFrag f0; load_v32(c, f0, vb);
    if (PRE) { ldk32(kn, knb, koffL); ldbias(bvn, nbrow); }
    float ls = 0.f;
#pragma unroll
    for (int r = 0; r < 16; ++r) { p0[r] = __builtin_amdgcn_exp2f(p0[r]); ls += p0[r]; }
    c.l += ls;
    pv32(c, p0, f0);
}
__device__ __forceinline__ void tile32_b(WaveCtx& c, const LAS unsigned char* kb, const int (&koffL)[4], const LAS unsigned char* vb, const LAS float* brow, bool rowok, int kstart, int wst, int h) {
    bf16x8 kf[4];
#pragma unroll
    for (int ds = 0; ds < 4; ++ds) kf[ds] = *(const LAS bf16x8*)(kb + koffL[ds]);
    float bv[16];
#pragma unroll
    for (int r = 0; r < 16; ++r) bv[r] = brow[(r & 3) + 8 * (r >> 2)];
    ATT_SB();
    f32x16 p0 = __builtin_amdgcn_mfma_f32_32x32x16_bf16(kf[0], c.qf[0], c.negm, 0, 0, 0);
#pragma unroll
    for (int ds = 1; ds < 4; ++ds) p0 = __builtin_amdgcn_mfma_f32_32x32x16_bf16(kf[ds], c.qf[ds], p0, 0, 0, 0);
    VFrag f0; load_v32(c, f0, vb);
    ATT_SB();
    asm volatile("s_nop 15\n\ts_nop 7" : "+v"(p0));
#pragma unroll
    for (int r = 0; r < 16; ++r) { const int kc = kstart + (r & 3) + 8 * (r >> 2) + 4 * h; p0[r] = (rowok && kc >= wst && kc < wst + 16) ? p0[r] + bv[r] : NEG; }
    float ma = max3f(p0[0], p0[1], p0[2]), mb = max3f(p0[3], p0[4], p0[5]);
    ma = max3f(ma, p0[6], p0[7]); mb = max3f(mb, p0[8], p0[9]); ma = max3f(ma, p0[10], p0[11]); mb = max3f(mb, p0[12], p0[13]); ma = max3f(ma, p0[14], p0[15]);
    float dl;
    if (update_ref(c, max2f(ma, mb), dl)) {
#pragma unroll
        for (int r = 0; r < 16; ++r) p0[r] -= dl; }
    float ls = 0.f;
#pragma unroll
    for (int r = 0; r < 16; ++r) { p0[r] = __builtin_amdgcn_exp2f(p0[r]); ls += p0[r]; }
    c.l += ls;
    pv32(c, p0, f0);
}
__device__ __forceinline__ void wave_store(const WaveCtx& c, int lane, bf16* orow  ) {
    const int h = lane >> 5;
    const float lt = c.l + __shfl_xor(c.l, 32), rl = (FP8_O ? O8_SCALE : 1.0f) / lt;
    if (FP8_O) {
#pragma unroll
        for (int db = 0; db < 2; ++db) {
            unsigned d[4];
#pragma unroll
            for (int g = 0; g < 4; ++g) { int w = 0; w = __builtin_amdgcn_cvt_pk_fp8_f32(c.o[db][4 * g] * rl, c.o[db][4 * g + 1] * rl, w, false); w = __builtin_amdgcn_cvt_pk_fp8_f32(c.o[db][4 * g + 2] * rl, c.o[db][4 * g + 3] * rl, w, true); d[g] = (unsigned)w; }
            { auto r = __builtin_amdgcn_permlane32_swap(d[0], d[1], false, false); d[0] = r[0]; d[1] = r[1]; }
            { auto r = __builtin_amdgcn_permlane32_swap(d[2], d[3], false, false); d[2] = r[0]; d[3] = r[1]; }
            { auto r = __builtin_amdgcn_permlane32_swap(d[0], d[2], false, false); d[0] = r[0]; d[2] = r[1]; }
            { auto r = __builtin_amdgcn_permlane32_swap(d[1], d[3], false, false); d[1] = r[0]; d[3] = r[1]; }
            u32x4 w; w.x = d[0]; w.y = d[1]; w.z = d[2]; w.w = d[3];
            *(u32x4*)((unsigned char*)orow + 32 * db + 16 * h) = w;
        }
    } else {
#pragma unroll
        for (int db = 0; db < 2; ++db)
#pragma unroll
            for (int g = 0; g < 4; ++g) { u32x2 w; w.x = cvtpk(c.o[db][4 * g] * rl, c.o[db][4 * g + 1] * rl); w.y = cvtpk(c.o[db][4 * g + 2] * rl, c.o[db][4 * g + 3] * rl);
                *(u32x2*)(orow + 32 * db + 8 * g + 4 * h) = w; }
    }
}
__device__ __forceinline__ void stage_q(LAS unsigned char* qbox, const bf16* qbase, unsigned qoff) {
    const unsigned qd = (unsigned)__builtin_amdgcn_readfirstlane((int)(unsigned)(uintptr_t)qbox);
    ATT_GLDS(qoff, qbase, qd, 0); ATT_GLDS(qoff, qbase + 16, qd + 1024u, 0); ATT_GLDS(qoff, qbase + 32, qd + 2048u, 0); ATT_GLDS(qoff, qbase + 48, qd + 3072u, 0);
}
__device__ __forceinline__ void read_q(bf16x8 (&qf)[4], const LAS unsigned char* qbox, int lane) {
#pragma unroll
    for (int ds = 0; ds < 4; ++ds) qf[ds] = *(const LAS bf16x8*)(qbox + ds * 1024 + lane * 16);
}
__device__ __forceinline__ void wave_pack(const WaveCtx& c, u32x4 (&w)[2]) {
    const float lt = c.l + __shfl_xor(c.l, 32), rl = O8_SCALE / lt;
#pragma unroll
    for (int db = 0; db < 2; ++db) {
        unsigned d[4];
#pragma unroll
        for (int g = 0; g < 4; ++g) { int t = 0; t = __builtin_amdgcn_cvt_pk_fp8_f32(c.o[db][4 * g] * rl, c.o[db][4 * g + 1] * rl, t, false); t = __builtin_amdgcn_cvt_pk_fp8_f32(c.o[db][4 * g + 2] * rl, c.o[db][4 * g + 3] * rl, t, true); d[g] = (unsigned)t; }
        { auto r = __builtin_amdgcn_permlane32_swap(d[0], d[1], false, false); d[0] = r[0]; d[1] = r[1]; }
        { auto r = __builtin_amdgcn_permlane32_swap(d[2], d[3], false, false); d[2] = r[0]; d[3] = r[1]; }
        { auto r = __builtin_amdgcn_permlane32_swap(d[0], d[2], false, false); d[0] = r[0]; d[2] = r[1]; }
        { auto r = __builtin_amdgcn_permlane32_swap(d[1], d[3], false, false); d[1] = r[0]; d[3] = r[1]; }
        w[db].x = d[0]; w[db].y = d[1]; w[db].z = d[2]; w[db].w = d[3];
    }
}
#define ATT_WAIT_BAR() do { asm volatile("s_waitcnt vmcnt(0)" ::: "memory"); __syncthreads(); } while (0)

struct UnitA { int b, kvh, Q0, qrow0, nl, tl0, nt; };
__device__ __forceinline__ UnitA decode_a(int u) {
    UnitA d;
    if (u < 2048) { d.b = u >> 9; d.kvh = (u >> 7) & 3; d.Q0 = (u & 127) * 64; d.qrow0 = d.b * S + d.Q0;
        d.tl0 = d.Q0 >= 128 ? 0 : (128 - d.Q0) / 64; const int t1 = (S + 64 - d.Q0) / 64; d.nl = (t1 < 4 ? t1 : 4) - d.tl0 + 1; }
    else { const int v = u - 2048; d.b = v >> 4; d.kvh = (v >> 2) & 3; d.Q0 = 0; d.qrow0 = NLAT + d.b * CTX + (v & 3) * 64; d.nl = 0; d.tl0 = 0; }
    d.nt = d.nl + 4; return d;
}
__device__ __forceinline__ int rowbase_a(const UnitA& d, int j) { return j < d.nl ? d.b * S + d.Q0 - 128 + 64 * (d.tl0 + j) : NLAT + d.b * CTX + 64 * (j - d.nl); }
__device__ __forceinline__ void stage_step_a(LAS unsigned char* lds, const UnitA& d, int s, int buf, const bf16* Kt, const bf16* Vt, const StageOff& so, int wave) {
#pragma unroll
    for (int sub = 0; sub < 2; ++sub) { const int j = 2 * s + sub; if (j < d.nt) { const size_t o = (size_t)rowbase_a(d, j) * 256 + d.kvh * 64; stage_tile(lds, buf * 2 + sub, Kt + o, Vt + o, so, wave); } }
}
__device__ __forceinline__ void qk64(const WaveCtx& c, const bf16x8 (&kf)[8], f32x16& p0, f32x16& p1) {
#pragma unroll
    for (int r = 0; r < 16; ++r) { p0[r] = 0.f; p1[r] = 0.f; }
#pragma unroll
    for (int ds = 0; ds < 4; ++ds) { p0 = __builtin_amdgcn_mfma_f32_32x32x16_bf16(kf[2 * ds], c.qf[ds], p0, 0, 0, 0); p1 = __builtin_amdgcn_mfma_f32_32x32x16_bf16(kf[2 * ds + 1], c.qf[ds], p1, 0, 0, 0); }
}
template <int MASK>
__device__ __forceinline__ void sm_pv64(WaveCtx& c, f32x16& p0, f32x16& p1, const LAS unsigned char* vb, int qq, int h) {
    VFrag f0; load_v32(c, f0, vb);
    if (MASK == 1) {
#pragma unroll
        for (int r = 0; r < 16; ++r) { const int kk = crow(r, h); if (kk < qq) p0[r] = NEG; if (kk + 32 < qq) p1[r] = NEG; } }
    if (MASK == 2) {
#pragma unroll
        for (int r = 0; r < 16; ++r) { const int kk = crow(r, h); if (kk > qq) p0[r] = NEG; if (kk + 32 > qq) p1[r] = NEG; } }
    float ls = 0.f;
#pragma unroll
    for (int r = 0; r < 16; ++r) { p0[r] = __builtin_amdgcn_exp2f(p0[r]); p1[r] = __builtin_amdgcn_exp2f(p1[r]); ls += p0[r] + p1[r]; }
    c.l += ls;
    VFrag f1; load_v32(c, f1, vb + 4096);
    pv32(c, p0, f0); pv32(c, p1, f1);
}
__device__ __forceinline__ LAS unsigned char* ringk(LAS unsigned char* lds, int r) { return lds + (r < 4 ? 65536 + r * TILEB : 135168); }
__device__ __forceinline__ LAS unsigned char* ringv(LAS unsigned char* lds, int r) { return lds + (r < 4 ? 98304 + r * TILEB : 143360); }
template <bool FAST>
__device__ __forceinline__ void attn_a_impl(LAS unsigned char* lds, int u0, int ucount, int uextra, const bf16* Q, const bf16* Kt, const bf16* Vt, bf16* O, const float* sink, const float* qgain, const float* kgain, const int kwave) {
    const int tid = TIDX, lane = tid & 63, wave = __builtin_amdgcn_readfirstlane(tid >> 6);
    const int g = wave >> 1, qs = wave & 1, h = lane >> 5, qq = 32 * qs + (lane & 31);
    const int ntot = ucount + (uextra >= 0 ? 1 : 0);
    if (ntot == 0) return;
    WaveCtx c; wave_offsets(c, lane, 0);
    const StageOff so = stage_off(tid, 256);
    const UnitA first = decode_a(ucount > 0 ? u0 : uextra);
    const int b = first.b, kvh = first.kvh, qb0 = first.Q0 >> 6;
    const bf16* Kl = Kt + (size_t)(b * S) * 256 + kvh * 64; const bf16* Vl = Vt + (size_t)(b * S) * 256 + kvh * 64;
    const bf16* Kc = Kt + (size_t)(NLAT + b * CTX) * 256 + kvh * 64; const bf16* Vc = Vt + (size_t)(NLAT + b * CTX) * 256 + kvh * 64;
#pragma unroll
    for (int i = 0; i < 4; ++i) stage_tile_at(lds + i * TILEB, lds + 32768 + i * TILEB, Kc + (size_t)(64 * i) * 256, Vc + (size_t)(64 * i) * 256, so, wave);
    if (ucount > 0) for (int kt = qb0 - 2; kt <= qb0 + 2; ++kt) if (kt >= 0 && kt < S / 64) stage_tile_at(ringk(lds, kt % 5), ringv(lds, kt % 5), Kl + (size_t)(64 * kt) * 256, Vl + (size_t)(64 * kt) * 256, so, wave);
    bf16x8 qn[4]; load_q(qn, lane, Q + (size_t)(first.qrow0 + qq) * 1024 + (kvh * 4 + g) * 64);
    u32x4 pend[2]; unsigned pend_off = 0u;
    ATT_WAIT_BAR();
    for (int ui = 0; ui < ntot; ++ui) {
        const bool lat = ui < ucount, has_next = ui + 1 < ntot;
        const UnitA cur = decode_a(lat ? u0 + ui : uextra);
        const UnitA nxt = decode_a(has_next ? (ui + 1 < ucount ? u0 + ui + 1 : uextra) : (lat ? u0 + ui : uextra));
        const int head = kvh * 4 + g, qb = cur.Q0 >> 6;
#pragma unroll
        for (int ds = 0; ds < 4; ++ds) c.qf[ds] = qn[ds];
        if (FP8_O && ui > 0) { *(u32x4*)((unsigned char*)O + pend_off) = pend[0]; *(u32x4*)((unsigned char*)O + pend_off + 32u) = pend[1]; }
        if (FAST) wave_reset(c, lane, 0.0f, __builtin_amdgcn_exp2f(sink[head] * LOG2E), false); else wave_reset(c, lane, sink[head] * LOG2E, 1.0f);
#define ATT_A_VALID(t) ((t) >= 4 || (lat && qb - 2 + (t) >= 0 && qb - 2 + (t) < S / 64))
#define ATT_A_KB(t) ((t) >= 4 ? lds + ((t) - 4) * TILEB : ringk(lds, (qb + 3 + (t)) % 5))
#define ATT_A_VB(t) ((t) >= 4 ? lds + 32768 + ((t) - 4) * TILEB : ringv(lds, (qb + 3 + (t)) % 5))
        const bool interior = FAST && lat && qb >= 2 && qb + 2 < S / 64;
        if (interior) {
            const int r0 = (qb + 3) % 5;
#define ATT_I_SLOT(i) (r0 + (i) >= 5 ? r0 + (i) - 5 : r0 + (i))
#define ATT_I_KB(i) ((i) < 5 ? ringk(lds, ATT_I_SLOT(i)) : lds + ((i) - 5) * TILEB)
#define ATT_I_VB(i) ((i) < 5 ? ringv(lds, ATT_I_SLOT(i)) : lds + 32768 + ((i) - 5) * TILEB)
#define ATT_I_ITER(i, P0, P1, N0, N1, MSK) do { \
                if ((i) == 2) { ATT_WAIT_BAR(); \
                    if (has_next && ui + 1 < ucount) { const int kt = qb + 3; if (kt < S / 64) stage_tile_at(ringk(lds, kt % 5), ringv(lds, kt % 5), Kl + (size_t)(64 * kt) * 256, Vl + (size_t)(64 * kt) * 256, so, wave); } \
                    } \
                if ((i) == 7) load_q(qn, lane, Q + (size_t)(nxt.qrow0 + qq) * 1024 + (kvh * 4 + g) * 64); \
                if ((i) < 8) qk64(c, kf, N0, N1); \
                if ((i) < 7) ldk64(kf, c, ATT_I_KB((i) + 2)); \
                sm_pv64<MSK>(c, P0, P1, ATT_I_VB(i), qq, h); ATT_SB(); } while (0)
            bf16x8 kf[8]; f32x16 pa0, pa1, pb0, pb1;
            ldk64(kf, c, ATT_I_KB(0)); qk64(c, kf, pa0, pa1); ldk64(kf, c, ATT_I_KB(1));
            ATT_I_ITER(0, pa0, pa1, pb0, pb1, 1); ATT_I_ITER(1, pb0, pb1, pa0, pa1, 0); ATT_I_ITER(2, pa0, pa1, pb0, pb1, 0); ATT_I_ITER(3, pb0, pb1, pa0, pa1, 0); ATT_I_ITER(4, pa0, pa1, pb0, pb1, 2);
            ATT_I_ITER(5, pb0, pb1, pa0, pa1, 0); ATT_I_ITER(6, pa0, pa1, pb0, pb1, 0); ATT_I_ITER(7, pb0, pb1, pa0, pa1, 0); ATT_I_ITER(8, pa0, pa1, pb0, pb1, 0);
        } else {
        if (FAST) {
            bf16x8 kfa[8], kfb[8];
            ldk64(kfa, c, ATT_A_KB(0));
#pragma nounroll
            for (int tp = 0; tp < 4; ++tp) {
                const int t0 = 2 * tp, t1 = t0 + 1, t2 = (t0 + 2) & 7;
                if (ATT_A_VALID(t0)) tile64_fast_core<true>(c, kfa, kfb, ATT_A_KB(t1), ATT_A_VB(t0), qq, h, t0 == 0 ? 1 : 0); else ldk64(kfb, c, ATT_A_KB(t1));
                if (ATT_A_VALID(t1)) tile64_fast_core<true>(c, kfb, kfa, ATT_A_KB(t2), ATT_A_VB(t1), qq, h, 0); else ldk64(kfa, c, ATT_A_KB(t2));
            }
        } else {
            for (int t = 0; t < 8; ++t) if (ATT_A_VALID(t)) tile64(c, ATT_A_KB(t), ATT_A_VB(t), qq, h, t == 0 ? 1 : 0);
        }
        ATT_WAIT_BAR();
        if (has_next && ui + 1 < ucount) { const int kt = qb + 3; if (kt < S / 64) stage_tile_at(ringk(lds, kt % 5), ringv(lds, kt % 5), Kl + (size_t)(64 * kt) * 256, Vl + (size_t)(64 * kt) * 256, so, wave); }
        load_q(qn, lane, Q + (size_t)(nxt.qrow0 + qq) * 1024 + (kvh * 4 + g) * 64);
        if (lat && qb + 2 < S / 64) {
            if (FAST) { bf16x8 kfa[8], kfb[8]; ldk64(kfa, c, ringk(lds, (qb + 2) % 5)); ATT_SB(); tile64_fast_core<false>(c, kfa, kfb, lds, ringv(lds, (qb + 2) % 5), qq, h, 2); }
            else tile64(c, ringk(lds, (qb + 2) % 5), ringv(lds, (qb + 2) % 5), qq, h, 2);
        }
        }
        if (FP8_O) { wave_pack(c, pend); pend_off = (unsigned)((cur.qrow0 + qq) * 1024 + head * 64 + 16 * h); }
        else wave_store(c, lane, O + (size_t)(cur.qrow0 + qq) * 1024 + head * 64);
    }
    if (FP8_O) { *(u32x4*)((unsigned char*)O + pend_off) = pend[0]; *(u32x4*)((unsigned char*)O + pend_off + 32u) = pend[1]; }
    __syncthreads();
}
__device__ __forceinline__ void attn_a_phase(LAS unsigned char* lds, int u0, int ucount, int uextra, const bf16* Q, const bf16* Kt, const bf16* Vt, bf16* O, const float* sink, const float* qgain, const float* kgain, const int kwave) {
    const int lane = TIDX & 63;
    const float gqm = wave_max(fabsf(qgain[lane])), gkm = wave_max(fabsf(kgain[lane])), skm = wave_max(fabsf(sink[lane & 15]));
    const bool fast = (64.0f * QSCALE * gqm * gkm <= ATT_FAST_BOUND) && (skm * LOG2E <= ATT_FAST_BOUND);
    if (fast) attn_a_impl<true>(lds, u0, ucount, uextra, Q, Kt, Vt, O, sink, qgain, kgain, kwave);
    else attn_a_impl<false>(lds, u0, ucount, uextra, Q, Kt, Vt, O, sink, qgain, kgain, kwave);
}
struct UnitB { int b, head, r0, klo, nt; };
__device__ __forceinline__ UnitB decode_b(int u) {
    UnitB d; d.b = u >> 9; d.head = (u >> 5) & 15; d.r0 = (u & 31) * 4;
    d.klo = min(max(d.r0 - 4, 0), 120); const int khi = min(max(d.r0 - 1, 0), 120) + 7; d.nt = 4 + (khi - d.klo + 1); return d;
}
__device__ __forceinline__ int rowbase_b(const UnitB& d, int j) { return j < 4 ? NLAT + d.b * CTX + 64 * j : d.b * S + (d.klo + j - 4) * 64; }
__device__ __forceinline__ void stage_step_b(LAS unsigned char* lds, const UnitB& d, int s, int buf, const bf16* Kt, const bf16* Vt, const StageOff& so, int wave) {
#pragma unroll
    for (int sub = 0; sub < 2; ++sub) { const int j = 2 * s + sub; if (j < d.nt) { const size_t o = (size_t)rowbase_b(d, j) * 1024 + d.head * 64; stage_tile(lds, buf * 2 + sub, Kt + o, Vt + o, so, wave); } }
}
template <bool FAST>
__device__ __forceinline__ void attn_b_impl(LAS unsigned char* lds, int u0, int ucount, const bf16* Q, const bf16* Kt, const bf16* Vt, bf16* O, const float* rpb, const float* qgain, const float* kgain, const int kwave) {
    const int tid = TIDX, lane = tid & 63, wave = __builtin_amdgcn_readfirstlane(tid >> 6);
    if (ucount <= 0) return;
    const int jb = wave & 3, rp = wave >> 2, h = lane >> 5, q31 = lane & 31;
    const int kstart = jb == 0 ? 0 : (jb == 1 ? 8 : (jb == 2 ? 24 : 32));
    const int qc = 16 * jb + (q31 & 15), wst = min(max(qc - 8, 0), 48);
    UnitB cur = decode_b(u0);
    LAS float* bt = (LAS float*)(lds + OFF_BIAS) + BIAS_PITCH;
    for (int i = tid; i < 15 * 31; i += NTHREADS) { const int dr = i / 31, dc = i - dr * 31; bt[dr * BIAS_PITCH + BIAS_ORG + dc] = rpb[(cur.head * 15 + dr) * 31 + dc] * LOG2E; }
    WaveCtx c; wave_offsets(c, lane, 0);
    LAS unsigned char* qbox = lds + OFF_QBOX + wave * 4096;
    int koffL[4];
    { const int row = kstart + q31;
#pragma unroll
      for (int ds = 0; ds < 4; ++ds) koffL[ds] = row * 128 + (((2 * ds + h) ^ ((row >> 1) & 7)) << 4); }
    const StageOff so = stage_off(tid, 1024); const unsigned qoff = (unsigned)(((2 * rp + (q31 >> 4)) * 64 + qc) * 1024 + 8 * h) * 2u;
    int gs = 0;
    stage_step_b(lds, cur, 0, 0, Kt, Vt, so, wave);
    stage_q(qbox, Q + (size_t)(cur.b * S + cur.r0 * 64) * 1024 + cur.head * 64, qoff);
    u32x4 pend[2]; unsigned pend_off = 0u;
    ATT_WAIT_BAR();
    for (int ui = 0; ui < ucount; ++ui) {
        const bool has_next = ui + 1 < ucount;
        const UnitB nxt = decode_b(has_next ? u0 + ui + 1 : u0);
        const int nsteps = (cur.nt + 1) >> 1;
        const int qrow = cur.r0 + 2 * rp + (q31 >> 4);
        const int rsq = min(max(qrow - 4, 0), 120);
        const int rs_a = min(max(cur.r0 + 2 * rp - 4, 0), 120), rs_b = min(max(cur.r0 + 2 * rp + 1 - 4, 0), 120);
        read_q(c.qf, qbox, lane);
        if (FP8_O && ui > 0) { *(u32x4*)((unsigned char*)O + pend_off) = pend[0]; *(u32x4*)((unsigned char*)O + pend_off + 32u) = pend[1]; }
        wave_reset(c, lane, 0.0f, 0.0f, !FAST);
        for (int s = 0; s < 2; ++s) {
            if (FAST) {
                const int slot = (gs & 1) * 2;
                bf16x8 kfa[8], kfb[8];
                ldk64(kfa, c, lds + OFF_K + slot * TILEB);
                stage_step_b(lds, cur, s + 1, (gs + 1) & 1, Kt, Vt, so, wave);
                ATT_SB();
                tile64_fast_core<true>(c, kfa, kfb, lds + OFF_K + (slot + 1) * TILEB, lds + OFF_V + slot * TILEB, 0, h, 0);
                tile64_fast_core<false>(c, kfb, kfa, lds, lds + OFF_V + (slot + 1) * TILEB, 0, h, 0);
            } else {
                stage_step_b(lds, cur, s + 1, (gs + 1) & 1, Kt, Vt, so, wave);
#pragma unroll
                for (int sub = 0; sub < 2; ++sub) { const int slot = (gs & 1) * 2 + sub; tile64(c, lds + OFF_K + slot * TILEB, lds + OFF_V + slot * TILEB, 0, h, 0); }
            }
            ++gs;
            ATT_WAIT_BAR();
        }
        for (int s = 2; s < nsteps; ++s) {
            if (FAST) {
                const int slot = (gs & 1) * 2, kra = cur.klo + 2 * s - 4, krb = kra + 1;
                const bool acta = kra >= rs_a && kra <= rs_b + 7, actb = (2 * s + 1 < cur.nt) && krb >= rs_a && krb <= rs_b + 7;
                const LAS float* browa = bt + (kra - qrow + 7) * BIAS_PITCH + BIAS_ORG + 15 - qc + kstart + 4 * h;
                bf16x8 kfa[4], kfb[4]; float bva[16], bvb[16];
                if (s + 1 < nsteps) stage_step_b(lds, cur, s + 1, (gs + 1) & 1, Kt, Vt, so, wave);
                else if (has_next) { stage_step_b(lds, nxt, 0, (gs + 1) & 1, Kt, Vt, so, wave); stage_q(qbox, Q + (size_t)(nxt.b * S + nxt.r0 * 64) * 1024 + nxt.head * 64, qoff); }
                if (acta) {
                    ldk32(kfa, lds + OFF_K + slot * TILEB, koffL); ldbias(bva, browa);
                    ATT_SB();
                    tile32_b_fast_core<true>(c, kfa, bva, kfb, bvb, lds + OFF_K + (slot + 1) * TILEB, browa + BIAS_PITCH, koffL, lds + OFF_V + slot * TILEB + kstart * 128, kra >= rsq && kra <= rsq + 7, kstart, wst, h);
                } else if (actb) { ldk32(kfb, lds + OFF_K + (slot + 1) * TILEB, koffL); ldbias(bvb, browa + BIAS_PITCH); }
                if (actb) tile32_b_fast_core<false>(c, kfb, bvb, kfa, bva, lds, browa, koffL, lds + OFF_V + (slot + 1) * TILEB + kstart * 128, krb >= rsq && krb <= rsq + 7, kstart, wst, h);
            } else {
                if (s + 1 < nsteps) stage_step_b(lds, cur, s + 1, (gs + 1) & 1, Kt, Vt, so, wave);
                else if (has_next) { stage_step_b(lds, nxt, 0, (gs + 1) & 1, Kt, Vt, so, wave); stage_q(qbox, Q + (size_t)(nxt.b * S + nxt.r0 * 64) * 1024 + nxt.head * 64, qoff); }
#pragma unroll
                for (int sub = 0; sub < 2; ++sub) {
                    const int j = 2 * s + sub, kr = cur.klo + j - 4;
                    if (j < cur.nt && kr >= rs_a && kr <= rs_b + 7) {
                        const int slot = (gs & 1) * 2 + sub;
                        const bool rowok = kr >= rsq && kr <= rsq + 7;
                        const LAS float* brow = bt + (kr - qrow + 7) * BIAS_PITCH + BIAS_ORG + 15 - qc + kstart + 4 * h;
                        tile32_b(c, lds + OFF_K + slot * TILEB, koffL, lds + OFF_V + slot * TILEB + kstart * 128, brow, rowok, kstart, wst, h);
                    }
                }
            }
            ++gs;
            ATT_WAIT_BAR();
        }
        if (FP8_O) { wave_pack(c, pend); pend_off = (unsigned)((cur.b * S + qrow * 64 + qc) * 1024 + cur.head * 64 + 16 * h); }
        else wave_store(c, lane, O + (size_t)(cur.b * S + qrow * 64 + qc) * 1024 + cur.head * 64);
        cur = nxt;
    }
    if (FP8_O) { *(u32x4*)((unsigned char*)O + pend_off) = pend[0]; *(u32x4*)((unsigned char*)O + pend_off + 32u) = pend[1]; }
    __syncthreads();
}
__device__ __forceinline__ void attn_b_phase(LAS unsigned char* lds, int u0, int ucount, const bf16* Q, const bf16* Kt, const bf16* Vt, bf16* O, const float* rpb, const float* qgain, const float* kgain, const int kwave) {
    const int lane = TIDX & 63;
    float bmx = 0.f;
    {
        const f32x4* r4 = (const f32x4*)rpb; f32x4 bv[30];
#pragma unroll
        for (int k = 0; k < 30; ++k) { const int i = lane + 64 * k; bv[k] = r4[i < 1860 ? i : 1859]; }
#pragma unroll
        for (int k = 0; k < 30; ++k) bmx = fmaxf(fmaxf(bmx, fmaxf(fabsf(bv[k][0]), fabsf(bv[k][1]))), fmaxf(fabsf(bv[k][2]), fabsf(bv[k][3])));
    }
    const float gqm = wave_max(fabsf(qgain[lane])), gkm = wave_max(fabsf(kgain[lane]));
    const bool fast = 64.0f * QSCALE * gqm * gkm + wave_max(bmx) * LOG2E <= ATT_FAST_BOUND;
    if (fast) attn_b_impl<true>(lds, u0, ucount, Q, Kt, Vt, O, rpb, qgain, kgain, kwave);
    else attn_b_impl<false>(lds, u0, ucount, Q, Kt, Vt, O, rpb, qgain, kgain, kwave);
}
}


typedef __attribute__((address_space(1))) unsigned gu32;
#define XB_TMO      128
#define XB_XCNT(j)  (256  + 64 * (j))
#define XB_XSUB(j)  (1280 + 64 * (j))
#define XB_XGEN(j)  (2304 + 64 * (j))
#define XB_TOP      3328
#define XB_TOPGEN   3392
#define XCD_BAR_WORDS 3456
#define XB_SPIN_CAP (1u << 20)
__device__ __forceinline__ unsigned xb_ld(unsigned* p)              { return __hip_atomic_load(p, __ATOMIC_RELAXED, __HIP_MEMORY_SCOPE_AGENT); }
__device__ __forceinline__ unsigned xb_add(unsigned* p, unsigned v) { return __hip_atomic_fetch_add(p, v, __ATOMIC_RELAXED, __HIP_MEMORY_SCOPE_AGENT); }
__device__ __forceinline__ unsigned xb_xcc_id() { return (unsigned)__builtin_amdgcn_s_getreg((3 << 11) | 20) & 0xFu; }
#define XB_SPIN(cond, bar) do { unsigned _sp = 0; while (cond) { __builtin_amdgcn_s_sleep(1); \
    if ((++_sp & 255u) == 0u) { if (xb_ld(&(bar)[XB_TMO])) break; if (_sp > XB_SPIN_CAP) { atomicAdd(&(bar)[XB_TMO], 1u); break; } } } } while (0)
struct XcdBarrier { unsigned* bar; unsigned x; volatile LAS unsigned* st; };
__device__ __forceinline__ XcdBarrier xcd_barrier_post(unsigned* bar, volatile LAS unsigned* st, const int kwave) {
    XcdBarrier b; b.bar = bar; b.x = xb_xcc_id(); b.st = st;
    if (TIDX == 0) (void)xb_add(&bar[XB_XCNT(b.x)], 1u);
    return b;
}
__device__ __forceinline__ void xcd_barrier_complete(unsigned* bar, unsigned x, unsigned& nloc, unsigned& nx) {
    const unsigned G = gridDim.x * gridDim.y * gridDim.z;
    unsigned sum, cnt, mine, sp = 0u;
    for (;;) {
        sum = 0u; cnt = 0u; mine = 0u;
#pragma unroll
        for (unsigned j = 0; j < 16; ++j) { const unsigned c = xb_ld(&bar[XB_XCNT(j)]); sum += c; cnt += (c > 0u) ? 1u : 0u; mine = (j == x) ? c : mine; }
        if (sum == G) break;
        __builtin_amdgcn_s_sleep(1);
        if ((++sp & 255u) == 0u) { if (xb_ld(&bar[XB_TMO])) break; if (sp > XB_SPIN_CAP) { atomicAdd(&bar[XB_TMO], 1u); break; } }
    }
    nloc = mine > 0u ? mine : 1u; nx = cnt > 0u ? cnt : 1u;
}
__device__ __forceinline__ void xcd_barrier(const XcdBarrier& b, const int kwave) {
    asm volatile("s_waitcnt vmcnt(0)" ::: "memory");
    __syncthreads();
    if (TIDX == 0) {
        unsigned* bar = b.bar;
        __builtin_amdgcn_s_waitcnt(0);
        unsigned nloc = b.st[0], nx = b.st[1];
        if (nloc == 0u) { xcd_barrier_complete(bar, b.x, nloc, nx); b.st[0] = nloc; b.st[1] = nx; }
        const unsigned old = xb_add(&bar[XB_XSUB(b.x)], 1u);
        const unsigned gen = old / nloc;
        if (old + 1u == (gen + 1u) * nloc) {
            __builtin_amdgcn_fence(__ATOMIC_RELEASE, "agent");
            asm volatile("s_waitcnt vmcnt(0)" ::: "memory");
            const unsigned og = xb_add(&bar[XB_TOP], 1u);
            const unsigned tg = og / nx;
            if (og + 1u == (tg + 1u) * nx) xb_add(&bar[XB_TOPGEN], 1u);
            else XB_SPIN(xb_ld(&bar[XB_TOPGEN]) == tg, bar);
            __builtin_amdgcn_fence(__ATOMIC_ACQUIRE, "agent");
            xb_add(&bar[XB_XGEN(b.x)], 1u);
            asm volatile("s_waitcnt vmcnt(0)" ::: "memory");
        } else {
            XB_SPIN(xb_ld(&bar[XB_XGEN(b.x)]) == gen, bar);
            __builtin_amdgcn_fence(__ATOMIC_ACQUIRE, "agent");
            asm volatile("s_waitcnt vmcnt(0)" ::: "memory");
        }
    }
    __syncthreads();
}

constexpr int CI_QA = 16 * 48, CI_O = FP8_O ? 8 * 32 : 16 * 32, CI_QB = 16 * 96, WD_IPE = FP8_DOWN ? 512 : 1024  , CI_WD = 16 * WD_IPE, GU_IPM = FP8_GU ? 512 : 1024  , CI_WGU = 32 * GU_IPM;
constexpr int CS0 = 0, CS1 = CS0 + CI_QA + CI_O, CS2 = CS1 + CI_WD, CS3 = CS2 + CI_WGU, CS4 = CS3 + CI_QB + CI_O, CS5 = CS4 + CI_WGU, CS_END = CS5 + CI_WD;
__device__ __forceinline__ void conv_load8(const ConvJob& j, f32x4 (&v)[16], int lane) {
    const int nblk = j.N / 32, kb = j.item / nblk, nbk = j.item % nblk, k0 = 128 * kb, n0 = 32 * nbk;
    const int nq = lane & 7, kg = lane >> 3;
#pragma unroll
    for (int i = 0; i < 16; ++i) v[i] = __builtin_nontemporal_load((const f32x4*)(j.W + (size_t)(k0 + 16 * kg + i) * j.N + n0 + 4 * nq));
}
__device__ __forceinline__ void conv_store8(const ConvJob& j, const f32x4 (&v)[16], int lane) {
    const int nblk = j.N / 32, kb = j.item / nblk, nbk = j.item % nblk, k0 = 128 * kb, n0 = 32 * nbk;
    const int nq = lane & 7, kg = lane >> 3;
    unsigned char* Wt8 = (unsigned char*)j.Wt;
#pragma unroll
    for (int c = 0; c < 4; ++c) {
        u32x4 o;
#pragma unroll
        for (int q = 0; q < 4; ++q) { int w = 0; w = __builtin_amdgcn_cvt_pk_fp8_f32(v[4 * q][c] * W8_SCALE, v[4 * q + 1][c] * W8_SCALE, w, false); w = __builtin_amdgcn_cvt_pk_fp8_f32(v[4 * q + 2][c] * W8_SCALE, v[4 * q + 3][c] * W8_SCALE, w, true); o[q] = (unsigned)w; }
        const int row = conv_rowmap(j.mode & 7, n0 + 4 * nq + c);
        __builtin_nontemporal_store(o, (u32x4*)(Wt8 + (size_t)row * j.K + k0 + 16 * kg));
    }
}
__device__ __forceinline__ ConvJob conv_decode(const Args& a, int it) {
    unsigned char* ws = a.ws; ConvJob j;
    if (it < CS1) { if (it < CI_QA) j = ConvJob{a.in[8], (bf16*)(ws + WS_WQKVA), 1024, QKVA_N, 3, it}; else j = ConvJob{a.in[12], (bf16*)(ws + WS_WOA), 1024, 1024, FP8_O ? 8 : 0, it - CI_QA}; return j; }
    if (it >= CS3 && it < CS4) { const int r = it - CS3; if (r < CI_QB) j = ConvJob{a.in[13], (bf16*)(ws + WS_WQKVB), 1024, QKVB_N, 4, r}; else j = ConvJob{a.in[17], (bf16*)(ws + WS_WOB), 1024, 1024, FP8_O ? 8 : 0, r - CI_QB}; return j; }
    int l, r; bool down;
    if (it < CS2) { l = 0; down = true; r = it - CS1; } else if (it < CS3) { l = 0; down = false; r = it - CS2; } else if (it < CS5) { l = 1; down = false; r = it - CS4; } else { l = 1; down = true; r = it - CS5; }
    if (down) { const int e = r / WD_IPE, item = r % WD_IPE, le = l * 16 + e;
        if (FP8_DOWN) j = ConvJob{a.in[21] + (size_t)le * 2048 * 1024, (bf16*)(ws + WS_WD + (size_t)le * 1024 * 2048), 2048, 1024, 8, item};
        else j = ConvJob{a.in[21] + (size_t)le * 2048 * 1024, (bf16*)(ws + WS_WD) + (size_t)le * 1024 * 2048, 2048, 1024, 0, item}; }
    else { const int e = r / (2 * GU_IPM), which = (r / GU_IPM) & 1, item = r % GU_IPM, le = l * 16 + e;
        if (FP8_GU) j = ConvJob{(which ? a.in[20] : a.in[19]) + (size_t)le * 1024 * 2048, (bf16*)(ws + WS_WGU + (size_t)le * 4096 * 1024), 1024, 2048, 8 + 1 + which, item};
        else j = ConvJob{(which ? a.in[20] : a.in[19]) + (size_t)le * 1024 * 2048, (bf16*)(ws + WS_WGU) + (size_t)le * 4096 * 1024, 1024, 2048, 1 + which, item}; }
    return j;
}
#ifndef CONV_DEPTH
#define CONV_DEPTH 3
#endif
__device__ __forceinline__ void conv_span(const Args& a, int lo, int hi, int nw, int wid, const int kwave) {
    const int lane = TIDX & 63, wave = TIDX >> 6, stride = nw * NWAVES;
    for (int it = lo + wid * NWAVES + wave; it < hi; it += CONV_DEPTH * stride) {
        ConvJob j[CONV_DEPTH]; f32x4 v[CONV_DEPTH][8];
        bool any8 = false;
#pragma unroll
        for (int d = 0; d < CONV_DEPTH; ++d) if (it + d * stride < hi) { j[d] = conv_decode(a, it + d * stride); any8 = any8 || j[d].mode >= 8; }
        if (any8) {
#pragma unroll
            for (int d = 0; d < CONV_DEPTH; ++d) if (it + d * stride < hi) {
                if (j[d].mode >= 8) { f32x4 w[16]; conv_load8(j[d], w, lane); conv_store8(j[d], w, lane); }
                else { conv_load(j[d], v[0], lane); conv_store(j[d], v[0], lane); } }
        } else {
#pragma unroll
            for (int d = 0; d < CONV_DEPTH; ++d) if (it + d * stride < hi) conv_load(j[d], v[d], lane);
#pragma unroll
            for (int d = 0; d < CONV_DEPTH; ++d) if (it + d * stride < hi) conv_store(j[d], v[d], lane);
        }
    }
}
#ifndef Q2
#define Q2 5500
#endif
#ifndef Q4
#define Q4 5500
#endif
#ifndef Q6
#define Q6 5384
#endif
#ifndef Q8
#define Q8 8500
#endif
#ifndef Q10
#define Q10 5000
#endif
#ifndef Q14A
#define Q14A 2884
#endif
#ifndef Q14B
#define Q14B 4096
#endif
constexpr int F_P2_A = CS2, F_P2_B = F_P2_A + Q2, F_P4_A = F_P2_B, F_P4_B = F_P4_A + Q4, F_P6_A = F_P4_B, F_P6_B = F_P6_A + Q6;
constexpr int F_P8_A = CS4, F_P8_B = F_P8_A + Q8, F_P10_A = F_P8_B, F_P10_B = F_P10_A + Q10, F_P14_A = F_P10_B, F_P14_B = F_P14_A + Q14A;
constexpr int F_P14_C = CS5, F_P14_D = CS5 + Q14B;
static_assert(F_P6_B <= CS3 && F_P14_B <= CS5 && F_P14_D <= CS_END, "filler plan");

__global__ void __launch_bounds__(NTHREADS, 2) mega(Args a) {
    extern __shared__ __attribute__((aligned(16))) unsigned char lds_raw[];
    LAS unsigned char* lds = (LAS unsigned char*)lds_raw;
    const int kwave = __builtin_amdgcn_readfirstlane((int)(threadIdx.x >> 6));
    asm volatile("s_nop 0");
    const int lo = a.ph_lo, hi = a.ph_hi;
    volatile LAS unsigned* MISC = (volatile LAS unsigned*)(lds + 131072);
    if (TIDX < 64) MISC[TIDX] = 0u;
    __syncthreads();
    XcdBarrier bar; bar.bar = (unsigned*)(a.ws + WS_CTL) + 4096; bar.x = 0; bar.st = nullptr;
    if (hi - lo > 1) bar = xcd_barrier_post((unsigned*)(a.ws + WS_CTL) + 4096, MISC + 8, kwave);
#define IN(k) (lo <= (k) && (k) < hi)
#define SEAM(k) do { if (IN(k) && IN((k) + 1)) xcd_barrier(bar, kwave); } while (0)
    unsigned char* ws = a.ws;
    const float* mod = (const float*)(ws + WS_MOD);
    LAS int* ldsidx = (LAS int*)(lds + IDX_OFF);
    const int G = gridDim.x, bx = blockIdx.x;
    const bool plan = (G == 256) && (hi - lo == 18);
#define FILL_TAIL(nwg_, A, B) do { if (plan) { const int rem_ = (nwg_) % G; if (rem_ && bx >= rem_) conv_span(a, (A), (B), G - rem_, bx - rem_, kwave); } } while (0)
    if (IN(0)) { p0_phase(a, lds, kwave);
        if (plan) { conv_span(a, CS0, CS2, G, bx, kwave); conv_span(a, F_P6_B, CS4, G, bx, kwave); conv_span(a, F_P14_B, CS5, G, bx, kwave); conv_span(a, F_P14_D, CS_END, G, bx, kwave); } else conv_span(a, 0, CS_END, G, bx, kwave); }
    SEAM(0);
    if (IN(1)) norm1_l0_phase(a, kwave);
    SEAM(1);
    if (IN(2)) {
        pg8::Sched Sc; Sc.init(NROWS / 256, QKVA_N / 256, G, bx, 0, ws + WS_WQKVA, 0, (size_t)256 * 1024 * 2); Sc.reph = GREPH(2);
        pg8::EpiQKV E{(bf16*)(ws + WS_Q), (bf16*)(ws + WS_K), (bf16*)(ws + WS_V), 256, 4, 1, a.in[9], a.in[10], (const float*)(ws + WS_ROPE), 1, QSCALE};
        pg8::gemm_phase<pg8::EpiQKV, false>(lds, (const char*)(ws + WS_HL), 1024, Sc, E, ldsidx, nullptr, kwave);
        FILL_TAIL((NROWS / 256) * (QKVA_N / 256), F_P2_A, F_P2_B);
    }
    SEAM(2);
    if (IN(3)) for (int rep_ = 0; rep_ < NREP(3); ++rep_) { if (rep_) xcd_barrier(bar, kwave);
        const int vcu = (G % 8 == 0) ? (bx % 8) * (G / 8) + bx / 8 : bx;
        att::attn_a_phase(lds, vcu * 8, vcu * 8 < 2048 ? 8 : 0, (vcu & 15) < 4 ? 2048 + (vcu >> 4) * 4 + (vcu & 3) : -1, (const bf16*)(ws + WS_Q), (const bf16*)(ws + WS_K), (const bf16*)(ws + WS_V), (bf16*)(ws + WS_O), a.in[11], a.in[9], a.in[10], kwave);
    }
    SEAM(3);
    if (IN(4)) {
        constexpr int EB = FP8_O ? 1 : 2;
        pg8::Sched Sc; Sc.init(NROWS / 256, 4, G, bx, 0, ws + WS_WOA, 0, (size_t)256 * 1024 * EB); Sc.reph = GREPH(4);
        pg8::EpiOproj E{a.in[0], a.in[2], a.out, (float*)(ws + WS_XC), mod + 0 * 5 * 6144 + 2 * 1024, FP8_O ? W8_INV / O8_SCALE : 1.0f};
        pg8::gemm_phase<pg8::EpiOproj, false, FP8_O != 0>(lds, (const char*)(ws + WS_O), 1024 * EB / 2, Sc, E, ldsidx, nullptr, kwave);
        FILL_TAIL((NROWS / 256) * 4, F_P4_A, F_P4_B);
    }
    SEAM(4);
    if (IN(5)) norm2_router_phase(a, 0, NROWS, lds, kwave);
    SEAM(5);
    if (IN(6)) { select_phase(a, 128, lds, kwave);
        if (plan) { constexpr int E1 = 256, E2 = 1024, M0 = F_P6_A + E1, M1 = F_P6_B - E2;
            if (bx < 64) conv_span(a, F_P6_A, M0, 64, bx, kwave);
            else { conv_span(a, M0, M1, G - 64, bx - 64, kwave); if (bx >= 128) conv_span(a, M1, F_P6_B, G - 128, bx - 128, kwave); } } }
    SEAM(6);
    if (IN(7)) {
        constexpr int EB = FP8_GU ? 1 : 2;
        pg8::Sched Sc; Sc.init(272, 16, G, bx, 17, ws + WS_WGU, (size_t)4096 * 1024 * EB, (size_t)256 * 1024 * EB); Sc.reph = GREPH(7);
        pg8::EpiGU E{(bf16*)(ws + WS_H), FP8_GU ? W8_INV : 1.0f};
        pg8::gemm_phase<pg8::EpiGU, true, FP8_GU != 0>(lds, (const char*)(ws + WS_HL), 1024 * EB / 2, Sc, E, ldsidx, (const int*)(ws + WS_ROWIDX), kwave);
    }
    SEAM(7);
    if (IN(8)) {
        constexpr int EB = FP8_DOWN ? 1 : 2;
        pg8::Sched Sc; Sc.init(272, 4, G, bx, 17, ws + WS_WD, (size_t)1024 * 2048 * EB, (size_t)256 * 2048 * EB); Sc.reph = GREPH(8);
        pg8::EpiDown E{(bf16*)(ws + WS_Y), (const float*)(ws + WS_GATE)};
        pg8::gemm_phase<pg8::EpiDown, false, FP8_DOWN != 0>(lds, (const char*)(ws + WS_H), 2048 * EB / 2, Sc, E, ldsidx, nullptr, kwave);
        FILL_TAIL(272 * 4, F_P8_A, F_P8_B);
    }
    SEAM(8);
    if (IN(9)) combine_phase(a, 0, kwave);
    SEAM(9);
    if (IN(10)) {
        pg8::Sched Sc; Sc.init(NROWS / 256, QKVB_N / 256, G, bx, 0, ws + WS_WQKVB, 0, (size_t)256 * 1024 * 2); Sc.reph = GREPH(10);
        pg8::EpiQKV E{(bf16*)(ws + WS_Q), (bf16*)(ws + WS_K), (bf16*)(ws + WS_V), 1024, 4, 4, a.in[14], a.in[15], (const float*)(ws + WS_ROPE), 0, QSCALE};
        pg8::gemm_phase<pg8::EpiQKV, false>(lds, (const char*)(ws + WS_HL), 1024, Sc, E, ldsidx, nullptr, kwave);
        FILL_TAIL((NROWS / 256) * (QKVB_N / 256), F_P10_A, F_P10_B);
    }
    SEAM(10);
    if (IN(11)) for (int rep_ = 0; rep_ < NREP(11); ++rep_) { if (rep_) xcd_barrier(bar, kwave);
        const int vcu = (G % 8 == 0) ? (bx % 8) * (G / 8) + bx / 8 : bx;
        att::attn_b_phase(lds, vcu * 8, vcu * 8 < 2048 ? 8 : 0, (const bf16*)(ws + WS_Q), (const bf16*)(ws + WS_K), (const bf16*)(ws + WS_V), (bf16*)(ws + WS_O), a.in[16], a.in[14], a.in[15], kwave);
    }
    SEAM(11);
    if (IN(12)) {
        constexpr int EB = FP8_O ? 1 : 2;
        pg8::Sched Sc; Sc.init(NLAT / 256, 4, G, bx, 0, ws + WS_WOB, 0, (size_t)256 * 1024 * EB); Sc.reph = GREPH(12);
        pg8::EpiOproj E{a.out, a.in[2], a.out, (float*)(ws + WS_XC), mod + 1 * 5 * 6144 + 2 * 1024, FP8_O ? W8_INV / O8_SCALE : 1.0f};
        pg8::gemm_phase<pg8::EpiOproj, false, FP8_O != 0>(lds, (const char*)(ws + WS_O), 1024 * EB / 2, Sc, E, ldsidx, nullptr, kwave);
    }
    SEAM(12);
    if (IN(13)) norm2_router_phase(a, 1, NLAT, lds, kwave);
    SEAM(13);
    if (IN(14)) { select_phase(a, 64, lds, kwave);
        if (plan) { constexpr int E1 = 640, C1 = F_P14_D - E1;
            if (bx < 64) conv_span(a, C1, F_P14_D, 64, bx, kwave);
            else { conv_span(a, F_P14_A, F_P14_B, G - 64, bx - 64, kwave); conv_span(a, F_P14_C, C1, G - 64, bx - 64, kwave); } } }
    SEAM(14);
    if (IN(15)) {
        constexpr int EB = FP8_GU ? 1 : 2;
        pg8::Sched Sc; Sc.init(256, 16, G, bx, 16, ws + WS_WGU + (size_t)16 * 4096 * 1024 * EB, (size_t)4096 * 1024 * EB, (size_t)256 * 1024 * EB); Sc.reph = GREPH(15);
        pg8::EpiGU E{(bf16*)(ws + WS_H), FP8_GU ? W8_INV : 1.0f};
        pg8::gemm_phase<pg8::EpiGU, true, FP8_GU != 0>(lds, (const char*)(ws + WS_HL), 1024 * EB / 2, Sc, E, ldsidx, (const int*)(ws + WS_ROWIDX), kwave);
    }
    SEAM(15);
    if (IN(16)) {
        constexpr int EB = FP8_DOWN ? 1 : 2;
        pg8::Sched Sc; Sc.init(256, 4, G, bx, 16, ws + WS_WD + (size_t)16 * 1024 * 2048 * EB, (size_t)1024 * 2048 * EB, (size_t)256 * 2048 * EB); Sc.reph = GREPH(16);
        pg8::EpiDown E{(bf16*)(ws + WS_Y), (const float*)(ws + WS_GATE)};
        pg8::gemm_phase<pg8::EpiDown, false, FP8_DOWN != 0>(lds, (const char*)(ws + WS_H), 2048 * EB / 2, Sc, E, ldsidx, nullptr, kwave);
    }
    SEAM(16);
    if (IN(17)) combine_phase(a, 1, kwave);
#undef IN
#undef SEAM
#undef FILL_TAIL
}

struct NaiveG {
    const bf16* A; int lda; const int* rowidx;
    const float* W; const float* W2; int ldw; size_t wstride_e;
    int M, N, K, mode;
    bf16* o0; bf16* o1; bf16* o2; int kvw;
    const float* base_lat; const float* base_ctx; float* out_lat; float* out_ctx; const float* g1;
    const float* gate;
};
__global__ void __launch_bounds__(256) naive_gemm(NaiveG g) {
    const int lane = threadIdx.x & 63, wave = threadIdx.x >> 6;
    const int tiles_n = g.N / 64; const long ntiles = (long)(g.M / 32) * tiles_n;
    const int fr = lane & 15, fq = lane >> 4;
    for (long wt = (long)blockIdx.x * 4 + wave; wt < ntiles; wt += (long)gridDim.x * 4) {
        const int tm = (int)(wt / tiles_n), tn = (int)(wt % tiles_n), r0 = tm * 32, c0 = tn * 64;
        const int e = g.wstride_e ? r0 / SLOTS_E : 0;
        const float* W = g.W + (size_t)e * g.wstride_e; const float* W2 = g.W2 ? g.W2 + (size_t)e * g.wstride_e : nullptr;
        const bf16* arow[2];
#pragma unroll
        for (int mi = 0; mi < 2; ++mi) { const int m = r0 + 16 * mi + fr; const int ar = g.rowidx ? g.rowidx[m] : m; arow[mi] = g.A + (size_t)ar * g.lda + 8 * fq; }
        f32x4 acc[2][4], acc2[2][4];
#pragma unroll
        for (int mi = 0; mi < 2; ++mi)
#pragma unroll
            for (int ni = 0; ni < 4; ++ni) { acc[mi][ni] = (f32x4){0.f, 0.f, 0.f, 0.f}; acc2[mi][ni] = (f32x4){0.f, 0.f, 0.f, 0.f}; }
        for (int k0 = 0; k0 < g.K; k0 += 32) {
            bf16x8 af[2];
#pragma unroll
            for (int mi = 0; mi < 2; ++mi) af[mi] = *(const bf16x8*)(arow[mi] + k0);
#pragma unroll
            for (int ni = 0; ni < 4; ++ni) {
                const float* wp = W + (size_t)(k0 + 8 * fq) * g.ldw + c0 + 16 * ni + fr;
                bf16x8 bfr;
#pragma unroll
                for (int j = 0; j < 8; ++j) bfr[j] = (short)f2bf(wp[(size_t)j * g.ldw]);
#pragma unroll
                for (int mi = 0; mi < 2; ++mi) acc[mi][ni] = __builtin_amdgcn_mfma_f32_16x16x32_bf16(af[mi], bfr, acc[mi][ni], 0, 0, 0);
                if (W2) {
                    const float* wp2 = W2 + (size_t)(k0 + 8 * fq) * g.ldw + c0 + 16 * ni + fr;
#pragma unroll
                    for (int j = 0; j < 8; ++j) bfr[j] = (short)f2bf(wp2[(size_t)j * g.ldw]);
#pragma unroll
                    for (int mi = 0; mi < 2; ++mi) acc2[mi][ni] = __builtin_amdgcn_mfma_f32_16x16x32_bf16(af[mi], bfr, acc2[mi][ni], 0, 0, 0);
                }
            }
        }
#pragma unroll
        for (int mi = 0; mi < 2; ++mi)
#pragma unroll
            for (int ni = 0; ni < 4; ++ni)
#pragma unroll
                for (int i = 0; i < 4; ++i) {
                    const int row = r0 + 16 * mi + 4 * fq + i, col = c0 + 16 * ni + fr; const float v = acc[mi][ni][i];
                    if (g.mode == 0) {
                        const int nq = 1024;
                        if (col < nq) g.o0[(size_t)row * 1024 + col] = (bf16)f2bf(v);
                        else if (col < nq + g.kvw) g.o1[(size_t)row * g.kvw + col - nq] = (bf16)f2bf(v);
                        else g.o2[(size_t)row * g.kvw + col - nq - g.kvw] = (bf16)f2bf(v);
                    } else if (g.mode == 1) {
                        const bool lat = row < NLAT; const int r = lat ? row / S : 4;
                        const size_t off = lat ? (size_t)row * D + col : (size_t)(row - NLAT) * D + col;
                        const float bs = lat ? g.base_lat[off] : g.base_ctx[off];
                        (lat ? g.out_lat : g.out_ctx)[off] = bs + g.g1[r * 6144 + col] * v;
                    } else if (g.mode == 2) {
                        const float u = acc2[mi][ni][i]; g.o0[(size_t)row * FF + col] = (bf16)f2bf(silu_f(v) * u);
                    } else {
                        g.o0[(size_t)row * D + col] = (bf16)f2bf(v * g.gate[row]);
                    }
                }
    }
}
__global__ void __launch_bounds__(256) naive_qknorm(bf16* Q, bf16* Kb, int kvw, const float* qg, const float* kg, const float* ropet, int rope) {
    const int lane = threadIdx.x & 63, wave = threadIdx.x >> 6;
    const int nkh = kvw / 64;
    for (int row = blockIdx.x * 4 + wave; row < NROWS; row += gridDim.x * 4) {
        const bool lat = row < NLAT; const int pos = row % S;
        for (int h = 0; h < 16 + nkh; ++h) {
            bf16* p = h < 16 ? Q + (size_t)row * 1024 + h * 64 + lane : Kb + (size_t)row * kvw + (h - 16) * 64 + lane;
            const float x = bf2f(*p);
            const float ss = wave_sum(x * x);
            float y = x * (1.0f / sqrtf(ss * (1.0f / 64.0f) + EPS)) * (h < 16 ? qg[lane] : kg[lane]);
            if (rope && lat) {
                const int half = lane >> 5, dd = lane & 31, f = dd & 15; const int v = half == 0 ? pos / 64 : pos % 64;
                const float cs = ropet[v * 16 + f], sn = ropet[128 * 16 + v * 16 + f];
                const float other = __shfl_xor(y, 16);
                y = (dd < 16) ? y * cs - other * sn : other * sn + y * cs;
            }
            *p = (bf16)f2bf(y);
        }
    }
}
__global__ void __launch_bounds__(256) naive_attn_a(const bf16* Q, const bf16* Kb, const bf16* Vb, bf16* O, const float* sink, float sscale) {
    const int lane = threadIdx.x & 63, wave = threadIdx.x >> 6;
    const long total = (long)NROWS * 16;
    for (long gw = (long)blockIdx.x * 4 + wave; gw < total; gw += (long)gridDim.x * 4) {
        const int row = (int)(gw >> 4), head = (int)(gw & 15), kvh = head >> 2;
        const bool lat = row < NLAT; const int b = lat ? row / S : (row - NLAT) / CTX, pos = row % S;
        float q[64];
#pragma unroll
        for (int c = 0; c < 8; ++c) { const u32x4 w = *(const u32x4*)(Q + (size_t)row * 1024 + head * 64 + 8 * c);
            q[8 * c] = bf2f(w.x & 0xffffu); q[8 * c + 1] = bf2f(w.x >> 16); q[8 * c + 2] = bf2f(w.y & 0xffffu); q[8 * c + 3] = bf2f(w.y >> 16);
            q[8 * c + 4] = bf2f(w.z & 0xffffu); q[8 * c + 5] = bf2f(w.z >> 16); q[8 * c + 6] = bf2f(w.w & 0xffffu); q[8 * c + 7] = bf2f(w.w >> 16); }
        const int klo = lat ? max(pos - 128, 0) : 0, khi = lat ? min(pos + 128, S - 1) : -1;
        float sc[9]; int krow[9];
        const float sk = sink[head];
        float mx = sk;
#pragma unroll
        for (int t = 0; t < 9; ++t) {
            int kr; bool valid;
            if (t < 5) { const int kp = klo + 64 * t + lane; valid = kp <= khi; kr = b * S + kp; }
            else { valid = true; kr = NLAT + b * CTX + 64 * (t - 5) + lane; }
            krow[t] = valid ? kr : -1; float s = -1e30f;
            if (valid) { const bf16* kp_ = Kb + (size_t)kr * 256 + kvh * 64; float d = 0.f;
#pragma unroll
                for (int c = 0; c < 8; ++c) { const u32x4 w = *(const u32x4*)(kp_ + 8 * c);
                    d += q[8 * c] * bf2f(w.x & 0xffffu) + q[8 * c + 1] * bf2f(w.x >> 16) + q[8 * c + 2] * bf2f(w.y & 0xffffu) + q[8 * c + 3] * bf2f(w.y >> 16)
                       + q[8 * c + 4] * bf2f(w.z & 0xffffu) + q[8 * c + 5] * bf2f(w.z >> 16) + q[8 * c + 6] * bf2f(w.w & 0xffffu) + q[8 * c + 7] * bf2f(w.w >> 16); }
                s = d * sscale; }
            sc[t] = s; mx = fmaxf(mx, s);
        }
        mx = wave_max(mx);
        float den = 0.f;
#pragma unroll
        for (int t = 0; t < 9; ++t) { sc[t] = krow[t] >= 0 ? expf(sc[t] - mx) : 0.f; den += sc[t]; }
        den = wave_sum(den) + expf(sk - mx);
        float o = 0.f;
#pragma unroll
        for (int t = 0; t < 9; ++t)
            for (int j = 0; j < 64; ++j) { const int kr = __shfl(krow[t], j); const float p = __shfl(sc[t], j); if (kr >= 0) o += p * bf2f(Vb[(size_t)kr * 256 + kvh * 64 + lane]); }
        O[(size_t)row * 1024 + head * 64 + lane] = (bf16)f2bf(o / den);
    }
}
__global__ void __launch_bounds__(256) naive_attn_b(const bf16* Q, const bf16* Kb, const bf16* Vb, bf16* O, const float* rpb, float sscale) {
    const int lane = threadIdx.x & 63, wave = threadIdx.x >> 6;
    const long total = (long)NLAT * 16;
    for (long gw = (long)blockIdx.x * 4 + wave; gw < total; gw += (long)gridDim.x * 4) {
        const int row = (int)(gw >> 4), head = (int)(gw & 15);
        const int b = row / S, pos = row % S, r = pos / 64, c = pos % 64;
        const int rs = min(max(r - 4, 0), 120), wst = min(max(c - 8, 0), 48);
        float q[64];
#pragma unroll
        for (int cc = 0; cc < 8; ++cc) { const u32x4 w = *(const u32x4*)(Q + (size_t)row * 1024 + head * 64 + 8 * cc);
            q[8 * cc] = bf2f(w.x & 0xffffu); q[8 * cc + 1] = bf2f(w.x >> 16); q[8 * cc + 2] = bf2f(w.y & 0xffffu); q[8 * cc + 3] = bf2f(w.y >> 16);
            q[8 * cc + 4] = bf2f(w.z & 0xffffu); q[8 * cc + 5] = bf2f(w.z >> 16); q[8 * cc + 6] = bf2f(w.w & 0xffffu); q[8 * cc + 7] = bf2f(w.w >> 16); }
        float sc[6]; int krow[6]; float mx = -1e30f;
#pragma unroll
        for (int t = 0; t < 6; ++t) {
            int kr; float bias = 0.f;
            if (t < 2) { const int j = 64 * t + lane, krr = rs + (j >> 4), kc = wst + (j & 15); kr = b * S + krr * 64 + kc; bias = rpb[(head * 15 + (krr - r + 7)) * 31 + (kc - c + 15)]; }
            else kr = NLAT + b * CTX + 64 * (t - 2) + lane;
            krow[t] = kr;
            const bf16* kp_ = Kb + (size_t)kr * 1024 + head * 64; float d = 0.f;
#pragma unroll
            for (int cc = 0; cc < 8; ++cc) { const u32x4 w = *(const u32x4*)(kp_ + 8 * cc);
                d += q[8 * cc] * bf2f(w.x & 0xffffu) + q[8 * cc + 1] * bf2f(w.x >> 16) + q[8 * cc + 2] * bf2f(w.y & 0xffffu) + q[8 * cc + 3] * bf2f(w.y >> 16)
                   + q[8 * cc + 4] * bf2f(w.z & 0xffffu) + q[8 * cc + 5] * bf2f(w.z >> 16) + q[8 * cc + 6] * bf2f(w.w & 0xffffu) + q[8 * cc + 7] * bf2f(w.w >> 16); }
            sc[t] = d * sscale + bias; mx = fmaxf(mx, sc[t]);
        }
        mx = wave_max(mx);
        float den = 0.f;
#pragma unroll
        for (int t = 0; t < 6; ++t) { sc[t] = expf(sc[t] - mx); den += sc[t]; }
        den = wave_sum(den);
        float o = 0.f;
#pragma unroll
        for (int t = 0; t < 6; ++t)
            for (int j = 0; j < 64; ++j) { const int kr = __shfl(krow[t], j); const float p = __shfl(sc[t], j); o += p * bf2f(Vb[(size_t)kr * 1024 + head * 64 + lane]); }
        O[(size_t)row * 1024 + head * 64 + lane] = (bf16)f2bf(o / den);
    }
}

extern "C" void kernel_launch(void* const* d_in, const int* in_sizes, int n_in, void* d_out, int out_size, void* d_ws, size_t ws_size, hipStream_t stream) {
    static int grid = 0;
    if (grid == 0) {
        if (n_in != 22 || out_size != NLAT * D || ws_size < WS_END) { fprintf(stderr, "kernel_launch: unexpected shapes n_in %d out %d ws %zu\n", n_in, out_size, ws_size); grid = -1; return; }
        int dev = 0, cus = 0, per_cu = 0;
        hipGetDevice(&dev); hipDeviceGetAttribute(&cus, hipDeviceAttributeMultiprocessorCount, dev);
        hipFuncSetAttribute((const void*)mega, hipFuncAttributeMaxDynamicSharedMemorySize, LDS_BYTES);
        hipOccupancyMaxActiveBlocksPerMultiprocessor(&per_cu, (const void*)mega, NTHREADS, LDS_BYTES);
        (void)hipGetLastError();
        if (per_cu < 1) fprintf(stderr, "kernel_launch: occupancy query says %d blocks/CU\n", per_cu);
        grid = cus;
    }
    if (grid < 0) return;
    unsigned char* ws = (unsigned char*)d_ws;
    hipMemsetAsync(ws + WS_CTL, 0, 1 * MiB, stream);
    Args a{};
    for (int i = 0; i < 22; ++i) a.in[i] = (const float*)d_in[i];
    a.out = (float*)d_out; a.ws = ws;
    auto run = [&](int p) { a.ph_lo = p; a.ph_hi = p + 1; hipLaunchKernelGGL(mega, dim3(grid), dim3(NTHREADS), LDS_BYTES, stream, a); };
    const float* mod = (const float*)(ws + WS_MOD);
    bf16* HL = (bf16*)(ws + WS_HL); bf16* Qb = (bf16*)(ws + WS_Q); bf16* Kb = (bf16*)(ws + WS_K); bf16* Vb = (bf16*)(ws + WS_V); bf16* Ob = (bf16*)(ws + WS_O);
    bf16* Hb = (bf16*)(ws + WS_H); bf16* Yb = (bf16*)(ws + WS_Y);
    const int NG = 2048;
#if ONE_LAUNCH
    a.ph_lo = 0; a.ph_hi = 18; hipLaunchKernelGGL(mega, dim3(grid), dim3(NTHREADS), LDS_BYTES, stream, a);
    (void)run; (void)mod; (void)HL; (void)Qb; (void)Kb; (void)Vb; (void)Ob; (void)Hb; (void)Yb; (void)NG;
#else
    run(0); run(1);
    for (int l = 0; l < 2; ++l) {
#if FAST_QKV
        run(l == 0 ? 2 : 10);
        const float sscale = 1.0f / LOG2E;
#else
        { NaiveG g{}; g.A = HL; g.lda = D; g.W = l == 0 ? a.in[8] : a.in[13]; g.ldw = l == 0 ? QKVA_N : QKVB_N; g.M = NROWS; g.N = g.ldw; g.K = D; g.mode = 0;
          g.o0 = Qb; g.o1 = Kb; g.o2 = Vb; g.kvw = l == 0 ? 256 : 1024;
          hipLaunchKernelGGL(naive_gemm, dim3(NG), dim3(256), 0, stream, g); }
        hipLaunchKernelGGL(naive_qknorm, dim3(NG), dim3(256), 0, stream, Qb, Kb, l == 0 ? 256 : 1024, l == 0 ? a.in[9] : a.in[14], l == 0 ? a.in[10] : a.in[15], (const float*)(ws + WS_ROPE), l == 0 ? 1 : 0);
        const float sscale = 0.125f;
#endif
#if FAST_ATTN_A
        if (l == 0) run(3);
#else
        if (l == 0) hipLaunchKernelGGL(naive_attn_a, dim3(NG), dim3(256), 0, stream, (const bf16*)Qb, (const bf16*)Kb, (const bf16*)Vb, Ob, a.in[11], sscale);
#endif
#if FAST_ATTN_B
        if (l == 1) run(11);
#else
        if (l == 1) hipLaunchKernelGGL(naive_attn_b, dim3(NG), dim3(256), 0, stream, (const bf16*)Qb, (const bf16*)Kb, (const bf16*)Vb, Ob, a.in[16], sscale);
#endif
#if FAST_OPROJ
        run(l == 0 ? 4 : 12);
#else
        { NaiveG g{}; g.A = Ob; g.lda = D; g.W = l == 0 ? a.in[12] : a.in[17]; g.ldw = D; g.M = l == 0 ? NROWS : NLAT; g.N = D; g.K = D; g.mode = 1;
          g.base_lat = l == 0 ? a.in[0] : (const float*)d_out; g.base_ctx = a.in[2]; g.out_lat = (float*)d_out; g.out_ctx = (float*)(ws + WS_XC); g.g1 = mod + l * 5 * 6144 + 2 * 1024;
          hipLaunchKernelGGL(naive_gemm, dim3(NG), dim3(256), 0, stream, g); }
#endif
        run(l == 0 ? 5 : 13);
        run(l == 0 ? 6 : 14);
#if FAST_G1
        run(l == 0 ? 7 : 15);
#else
        { NaiveG g{}; g.A = HL; g.lda = D; g.rowidx = (const int*)(ws + WS_ROWIDX); g.W = a.in[19] + (size_t)l * 16 * 1024 * 2048; g.W2 = a.in[20] + (size_t)l * 16 * 1024 * 2048; g.ldw = FF; g.wstride_e = (size_t)1024 * 2048;
          g.M = NSLOT; g.N = FF; g.K = D; g.mode = 2; g.o0 = Hb;
          hipLaunchKernelGGL(naive_gemm, dim3(NG), dim3(256), 0, stream, g); }
#endif
#if FAST_G2
        run(l == 0 ? 8 : 16);
#else
        { NaiveG g{}; g.A = Hb; g.lda = FF; g.W = a.in[21] + (size_t)l * 16 * 2048 * 1024; g.ldw = D; g.wstride_e = (size_t)2048 * 1024;
          g.M = NSLOT; g.N = D; g.K = FF; g.mode = 3; g.o0 = Yb; g.gate = (const float*)(ws + WS_GATE);
          hipLaunchKernelGGL(naive_gemm, dim3(NG), dim3(256), 0, stream, g); }
#endif
        run(l == 0 ? 9 : 17);
    }
#endif
}
```

```cpp
#include <hip/hip_runtime.h>
#include <cstdio>
#include <cstdint>

#define LAS __attribute__((address_space(3)))
typedef unsigned short bf16;
typedef float f32x4 __attribute__((ext_vector_type(4)));
typedef unsigned u32x4 __attribute__((ext_vector_type(4)));
typedef unsigned u32x2 __attribute__((ext_vector_type(2)));
typedef short bf16x8 __attribute__((ext_vector_type(8)));

constexpr int D = 1024, NB = 4, S = 8192, CTX = 256, NLAT = NB * S, NCTX = NB * CTX, NROWS = NLAT + NCTX;
constexpr int NE = 16, FF = 2048, CAPL = 1024, CAPC = 32;
constexpr int SLOTS_E = 4352, NSLOT = NE * SLOTS_E;
constexpr int QKVA_N = 1536, QKVB_N = 3072;
constexpr float EPS = 1e-6f;
constexpr float LOG2E = 1.4426950408889634f;

constexpr size_t MiB = 1u << 20;
constexpr size_t WS_CTL = 0;
constexpr size_t WS_MOD = 1 * MiB;
constexpr size_t WS_ROPE = 1 * MiB + 512 * 1024;
constexpr size_t WS_AFF = 2 * MiB;
constexpr size_t WS_ROWIDX = 5 * MiB;
constexpr size_t WS_GATE = 5 * MiB + 512 * 1024;
constexpr size_t WS_INV = 6 * MiB;
constexpr size_t WS_XC = 9 * MiB;
constexpr size_t WS_WQKVA = 13 * MiB;
constexpr size_t WS_WOA = 16 * MiB;
constexpr size_t WS_WQKVB = 18 * MiB;
constexpr size_t WS_WOB = 24 * MiB;
constexpr size_t WS_WGU = 26 * MiB;
constexpr size_t WS_WD = 282 * MiB;
constexpr size_t WS_HL = 410 * MiB;
constexpr size_t WS_R1 = 476 * MiB;
constexpr size_t WS_Q = WS_R1, WS_K = WS_R1 + 66 * MiB, WS_V = WS_R1 + 132 * MiB, WS_O = WS_R1 + 198 * MiB;
constexpr size_t WS_H = WS_R1;
constexpr size_t WS_Y = 748 * MiB;
constexpr size_t WS_END = 884 * MiB;

#ifndef FAST_QKV
#define FAST_QKV 1
#endif
#ifndef FAST_OPROJ
#define FAST_OPROJ 1
#endif
#ifndef PROBE_MASK
#define PROBE_MASK 0
#endif
#ifndef PROBE_GEMM
#define PROBE_GEMM -1
#endif
#ifndef PROBE_REPH
#define PROBE_REPH 4
#endif
#define GREPH(k) ((k) == PROBE_GEMM ? PROBE_REPH : 2)
#define NREP(k) (((PROBE_MASK >> (k)) & 1) ? 2 : 1)
#ifndef FP8_DOWN
#define FP8_DOWN 1
#endif
#ifndef FP8_Y
#define FP8_Y 1
#endif
constexpr float Y8_SCALE = 32.0f;
#ifndef FP8_O
#define FP8_O 1
#endif
constexpr float O8_SCALE = 16.0f;
#ifndef FP8_GU
#define FP8_GU 1
#endif
constexpr float W8_SCALE = 32.0f, W8_INV = 1.0f / 32.0f;
#ifndef ONE_LAUNCH
#define ONE_LAUNCH 1
#endif
#ifndef FAST_ATTN_A
#define FAST_ATTN_A 1
#endif
#ifndef FAST_ATTN_B
#define FAST_ATTN_B 1
#endif
#ifndef FAST_G1
#define FAST_G1 1
#endif
#ifndef FAST_G2
#define FAST_G2 1
#endif
constexpr int NWAVES = 8, NTHREADS = 512;
constexpr int LDS_BYTES = 163840;
constexpr int IDX_OFF = 131072 + 1024;
constexpr float QSCALE = 0.125f * 1.4426950408889634f;

__device__ __forceinline__ float bf2f(unsigned h) { return __uint_as_float(h << 16); }
__device__ __forceinline__ unsigned f2bf(float f) { unsigned u = __float_as_uint(f); return (u + 0x7fffu + ((u >> 16) & 1u)) >> 16; }
__device__ __forceinline__ unsigned pk2(float lo, float hi) { return f2bf(lo) | (f2bf(hi) << 16); }
__device__ __forceinline__ float wave_sum(float v) {
#pragma unroll
    for (int o = 32; o >= 1; o >>= 1) v += __shfl_xor(v, o);
    return v;
}
__device__ __forceinline__ float wave_max(float v) {
#pragma unroll
    for (int o = 32; o >= 1; o >>= 1) v = fmaxf(v, __shfl_xor(v, o));
    return v;
}
__device__ __forceinline__ int wave_sum_i(int v) {
#pragma unroll
    for (int o = 32; o >= 1; o >>= 1) v += __shfl_xor(v, o);
    return v;
}
__device__ __forceinline__ int lane_now() { int l; asm volatile("v_mbcnt_lo_u32_b32 %0, -1, 0\n\tv_mbcnt_hi_u32_b32 %0, -1, %0" : "=v"(l)); return l; }
#define TIDX (kwave * 64 + lane_now())
__device__ __forceinline__ float silu_f(float x) { return x / (1.0f + expf(-x)); }

struct Args { const float* in[22]; float* out; unsigned char* ws; int ph_lo, ph_hi; };

__device__ __forceinline__ int qk_rowmap(int n) {
    const int hh = n >> 6, d = n & 63, pn = hh >> 2, wc = hh & 3, bj = d >> 5, dd = d & 31, nn = dd >> 4, fq = (dd & 15) >> 2, i = dd & 3;
    return 256 * pn + 128 * bj + 32 * wc + 8 * fq + 4 * nn + i;
}
__device__ __forceinline__ int conv_rowmap(int mode, int n) {
    switch (mode) {
        case 1: return 256 * (n >> 7) + (n & 127);
        case 2: return 256 * (n >> 7) + 128 + (n & 127);
        case 3: return n < 1280 ? qk_rowmap(n) : n;
        case 4: return n < 2048 ? qk_rowmap(n) : n;
        default: return n;
    }
}
struct ConvJob { const float* W; bf16* Wt; int K, N, mode, item; };
__device__ __forceinline__ void conv_load(const ConvJob& j, f32x4 (&v)[8], int lane) {
    const int nblk = j.N / 32, kb = j.item / nblk, nbk = j.item % nblk, k0 = 64 * kb, n0 = 32 * nbk;
    const int nq = lane & 7, kg = lane >> 3;
#pragma unroll
    for (int i = 0; i < 8; ++i) v[i] = __builtin_nontemporal_load((const f32x4*)(j.W + (size_t)(k0 + 8 * kg + i) * j.N + n0 + 4 * nq));
}
__device__ __forceinline__ void conv_store(const ConvJob& j, const f32x4 (&v)[8], int lane) {
    const int nblk = j.N / 32, kb = j.item / nblk, nbk = j.item % nblk, k0 = 64 * kb, n0 = 32 * nbk;
    const int nq = lane & 7, kg = lane >> 3;
#pragma unroll
    for (int c = 0; c < 4; ++c) {
        u32x4 o; o.x = pk2(v[0][c], v[1][c]); o.y = pk2(v[2][c], v[3][c]); o.z = pk2(v[4][c], v[5][c]); o.w = pk2(v[6][c], v[7][c]);
        const int row = conv_rowmap(j.mode, n0 + 4 * nq + c);
        __builtin_nontemporal_store(o, (u32x4*)(j.Wt + (size_t)row * j.K + k0 + 8 * kg));
    }
}
__device__ __forceinline__ void p0_phase(const Args& a, LAS unsigned char* lds, const int kwave) {
    const int tid = TIDX, lane = tid & 63, wave = tid >> 6;
    unsigned char* ws = a.ws;
    {
        float* rc = (float*)(ws + WS_ROPE); float* rs = rc + 128 * 16;
        const int per = (128 * 16 + (int)gridDim.x - 1) / (int)gridDim.x, i = blockIdx.x * per + tid;
        if (tid < per && i < 128 * 16) { const int v = i >> 4, f = i & 15; const double inv = pow(10000.0, -(double)f / 16.0), ang = (double)v * inv; rc[i] = (float)cos(ang); rs[i] = (float)sin(ang); }
    }
    if (blockIdx.x == 1) {
        int* rowidx = (int*)(ws + WS_ROWIDX); float* gate = (float*)(ws + WS_GATE);
        for (int i = tid; i < NE * 128; i += NTHREADS) { const int e = i >> 7, p = i & 127; rowidx[e * SLOTS_E + 4224 + p] = 0; gate[e * SLOTS_E + 4224 + p] = 0.f; }
    }
    {
        LAS float* sc = (LAS float*)lds;
        LAS float* red = sc + 5 * 1024;
        bool have = false;
        for (int u = blockIdx.x; u < 192; u += gridDim.x) {
            if (!have) {
                for (int i = tid; i < 5 * 1024; i += NTHREADS) { const int r = i >> 10, k = i & 1023; const float cv = r < 4 ? a.in[1][r * 1024 + k] : a.in[3][k]; sc[i] = silu_f(cv); }
                __syncthreads(); have = true;
            }
            const int l = u / 96, cb = u % 96, col = cb * 64 + lane;
            const float* W = a.in[4] + (size_t)l * 1024 * 6144;
            float acc[5] = {0.f, 0.f, 0.f, 0.f, 0.f};
            for (int kk = 0; kk < 128; ++kk) { const int k = wave * 128 + kk; const float wv = W[(size_t)k * 6144 + col];
#pragma unroll
                for (int r = 0; r < 5; ++r) acc[r] += sc[r * 1024 + k] * wv; }
#pragma unroll
            for (int r = 0; r < 5; ++r) red[(wave * 5 + r) * 64 + lane] = acc[r];
            __syncthreads();
            if (tid < 320) { const int r = tid >> 6, ln = tid & 63; float s = 0.f;
#pragma unroll
                for (int w = 0; w < 8; ++w) s += red[(w * 5 + r) * 64 + ln];
                const int cc = cb * 64 + ln;
                ((float*)(ws + WS_MOD))[(l * 5 + r) * 6144 + cc] = s + a.in[5][l * 6144 + cc]; }
            __syncthreads();
        }
    }
}

__device__ __forceinline__ void norm_mod(const f32x4 (&v)[4], f32x4 (&y)[4], const float* g, const float* sh, const float* sc, int lane) {
    float ss = 0.f;
#pragma unroll
    for (int j = 0; j < 4; ++j) ss += (v[j][0] * v[j][0] + v[j][1] * v[j][1]) + (v[j][2] * v[j][2] + v[j][3] * v[j][3]);
    ss = wave_sum(ss);
    const float rstd = 1.0f / sqrtf(ss * (1.0f / D) + EPS);
#pragma unroll
    for (int j = 0; j < 4; ++j) { const int col = 4 * lane + 256 * j; const f32x4 gg = *(const f32x4*)(g + col), s0 = *(const f32x4*)(sh + col), s1 = *(const f32x4*)(sc + col);
        y[j] = (v[j] * rstd * gg) * (1.0f + s1) + s0; }
}
__device__ __forceinline__ void store_bf16_row(bf16* orow, const f32x4 (&y)[4], int lane) {
#pragma unroll
    for (int j = 0; j < 4; ++j) { u32x2 w; w.x = pk2(y[j][0], y[j][1]); w.y = pk2(y[j][2], y[j][3]); *(u32x2*)(orow + 4 * lane + 256 * j) = w; }
}
__device__ __forceinline__ void norm1_l0_phase(const Args& a, const int kwave) {
    const int lane = TIDX & 63, wave = TIDX >> 6;
    const int gw = blockIdx.x * NWAVES + wave, NGW = gridDim.x * NWAVES;
    const float* mod = (const float*)(a.ws + WS_MOD); bf16* HL = (bf16*)(a.ws + WS_HL);
    for (int row = gw; row < NROWS; row += NGW) {
        const bool lat = row < NLAT; const int r = lat ? row / S : 4;
        const float* xr = lat ? a.in[0] + (size_t)row * D : a.in[2] + (size_t)(row - NLAT) * D;
        f32x4 v[4], y[4];
#pragma unroll
        for (int j = 0; j < 4; ++j) v[j] = *(const f32x4*)(xr + 4 * lane + 256 * j);
        const float* m = mod + (0 * 5 + r) * 6144;
        norm_mod(v, y, a.in[6], m, m + 1024, lane);
        store_bf16_row(HL + (size_t)row * D, y, lane);
    }
}
template <int CTRL> __device__ __forceinline__ float dppf(float v) { return __builtin_bit_cast(float, __builtin_amdgcn_update_dpp(0, __builtin_bit_cast(int, v), CTRL, 0xF, 0xF, true)); }
__device__ __forceinline__ float row16_max(float v) { v = fmaxf(v, dppf<0xB1>(v)); v = fmaxf(v, dppf<0x4E>(v)); v = fmaxf(v, dppf<0x141>(v)); v = fmaxf(v, dppf<0x140>(v)); return v; }
__device__ __forceinline__ float row16_sum(float v) { v += dppf<0xB1>(v); v += dppf<0x4E>(v); v += dppf<0x141>(v); v += dppf<0x140>(v); return v; }
__device__ __forceinline__ void norm2_router_phase(const Args& a, int l, int nrows, LAS unsigned char* lds, const int kwave) {
    const int tid = TIDX, lane = tid & 63, wave = __builtin_amdgcn_readfirstlane(tid >> 6);
    constexpr int WP = 1028;
    LAS float* WT = (LAS float*)lds;
    LAS float* plog = (LAS float*)(lds + 16 * WP * 4);
    LAS float* pss = plog + 2 * 8 * 256;
    LAS float* part = pss + 2 * 8 * 16;
    LAS float* csh = part + 32 * 16;
    const float* wr = a.in[18] + (size_t)l * 1024 * 16;
    const float* mod = (const float*)(a.ws + WS_MOD); bf16* HL = (bf16*)(a.ws + WS_HL);
    const float* XC = (const float*)(a.ws + WS_XC); float* AFF = (float*)(a.ws + WS_AFF);
    const float* gn = a.in[7] + l * 1024;
    const int ngroups = nrows / 16, G = gridDim.x;
    const int g_lo = (int)(((long)blockIdx.x * ngroups) / G), g_hi = (int)(((long)(blockIdx.x + 1) * ngroups) / G);
    const int rowl = lane & 15, kq = lane >> 4, colb = 128 * wave + 4 * kq;
    int cur_r = -1; f32x4 Gv[8], Sv[8], xn[8];
    for (int grp = g_lo; grp < g_hi; ++grp) {
        const int row0 = grp * 16; const bool lat = row0 < NLAT; const int b = lat ? row0 / S : (row0 - NLAT) / CTX, r = lat ? b : 4;
        const float* m = mod + (l * 5 + r) * 6144 + 3 * 1024;
        if (r != cur_r) {
            __syncthreads();
            const int e = tid & 15; float ps = 0.f;
#pragma unroll 16
            for (int it = 0; it < 32; ++it) { const int k = (tid >> 4) + 32 * it; const float w = wr[k * 16 + e]; WT[e * WP + k] = w * gn[k] * (1.0f + m[1024 + k]); ps += m[k] * w; }
            part[(tid >> 4) * 16 + e] = ps;
            __syncthreads();
            if (tid < 16) { float s = 0.f;
#pragma unroll 4
                for (int j = 0; j < 32; ++j) s += part[j * 16 + tid];
                csh[tid] = s; }
            __syncthreads();
#pragma unroll
            for (int c = 0; c < 8; ++c) { const int col = colb + 16 * c; const f32x4 g4 = *(const f32x4*)(gn + col), s1 = *(const f32x4*)(m + 1024 + col); Gv[c] = g4 * (1.0f + s1); Sv[c] = *(const f32x4*)(m + col); }
            cur_r = r;
        }
        const int par = grp & 1;
        f32x4 x[8];
        if (grp == g_lo) { const float* xr = (lat ? a.out + (size_t)(row0 + rowl) * D : XC + (size_t)(row0 + rowl - NLAT) * D) + colb;
#pragma unroll
            for (int c = 0; c < 8; ++c) xn[c] = *(const f32x4*)(xr + 16 * c); }
#pragma unroll
        for (int c = 0; c < 8; ++c) x[c] = xn[c];
        if (grp + 1 < g_hi) { const int rown = (grp + 1) * 16 + rowl; const float* xr = (rown < NLAT ? a.out + (size_t)rown * D : XC + (size_t)(rown - NLAT) * D) + colb;
#pragma unroll
            for (int c = 0; c < 8; ++c) xn[c] = *(const f32x4*)(xr + 16 * c); }
        float ss = 0.f; f32x4 acc0 = {0.f, 0.f, 0.f, 0.f}, acc1 = {0.f, 0.f, 0.f, 0.f};
#pragma unroll
        for (int c = 0; c < 8; ++c) {
            const f32x4 w4 = *(const LAS f32x4*)(WT + rowl * WP + colb + 16 * c);
            ss += (x[c][0] * x[c][0] + x[c][1] * x[c][1]) + (x[c][2] * x[c][2] + x[c][3] * x[c][3]);
            acc0 = __builtin_amdgcn_mfma_f32_16x16x4f32(x[c][0], w4[0], acc0, 0, 0, 0);
            acc1 = __builtin_amdgcn_mfma_f32_16x16x4f32(x[c][1], w4[1], acc1, 0, 0, 0);
            acc0 = __builtin_amdgcn_mfma_f32_16x16x4f32(x[c][2], w4[2], acc0, 0, 0, 0);
            acc1 = __builtin_amdgcn_mfma_f32_16x16x4f32(x[c][3], w4[3], acc1, 0, 0, 0);
        }
        ss += __shfl_xor(ss, 16); ss += __shfl_xor(ss, 32);
        *(LAS f32x4*)(plog + (par * 8 + wave) * 256 + lane * 4) = acc0 + acc1;
        if (kq == 0) pss[(par * 8 + wave) * 16 + rowl] = ss;
        asm volatile("s_waitcnt lgkmcnt(0)" ::: "memory"); __builtin_amdgcn_s_barrier(); asm volatile("" ::: "memory");
        float st = 0.f;
#pragma unroll
        for (int w = 0; w < 8; ++w) st += pss[(par * 8 + w) * 16 + rowl];
        const float rstd = 1.0f / sqrtf(st * (1.0f / D) + EPS);
        if (wave < 4) {
            const int t = 4 * kq + wave;
            float stt = 0.f, lg = 0.f;
#pragma unroll
            for (int w = 0; w < 8; ++w) { stt += pss[(par * 8 + w) * 16 + t]; lg += plog[(par * 8 + w) * 256 + lane * 4 + wave]; }
            const float rj = 1.0f / sqrtf(stt * (1.0f / D) + EPS);
            const float v = lg * rj + csh[rowl];
            const float mx = row16_max(v);
            const float p = expf(v - mx);
            const float af = p / row16_sum(p);
            if (lat) AFF[(size_t)(b * 16 + rowl) * S + (row0 - b * S) + t] = af;
            else AFF[(size_t)64 * S + (size_t)(b * 16 + rowl) * CTX + (row0 - NLAT - b * CTX) + t] = af;
        }
        if (FP8_GU) {
            unsigned char* orow8 = (unsigned char*)HL + (size_t)(row0 + rowl) * D + 128 * wave + 16 * kq;
            unsigned d[8];
#pragma unroll
            for (int c = 0; c < 8; ++c) { const f32x4 y = (x[c] * rstd) * Gv[c] + Sv[c]; int w = 0; w = __builtin_amdgcn_cvt_pk_fp8_f32(y[0], y[1], w, false); w = __builtin_amdgcn_cvt_pk_fp8_f32(y[2], y[3], w, true); d[c] = (unsigned)w; }
#pragma unroll
            for (int q = 0; q < 2; ++q) {
                { auto t = __builtin_amdgcn_permlane16_swap(d[4 * q], d[4 * q + 1], false, false); d[4 * q] = t[0]; d[4 * q + 1] = t[1]; }
                { auto t = __builtin_amdgcn_permlane16_swap(d[4 * q + 2], d[4 * q + 3], false, false); d[4 * q + 2] = t[0]; d[4 * q + 3] = t[1]; }
                { auto t = __builtin_amdgcn_permlane32_swap(d[4 * q], d[4 * q + 2], false, false); d[4 * q] = t[0]; d[4 * q + 2] = t[1]; }
                { auto t = __builtin_amdgcn_permlane32_swap(d[4 * q + 1], d[4 * q + 3], false, false); d[4 * q + 1] = t[0]; d[4 * q + 3] = t[1]; }
                u32x4 w; w.x = d[4 * q]; w.y = d[4 * q + 1]; w.z = d[4 * q + 2]; w.w = d[4 * q + 3];
                *(u32x4*)(orow8 + 64 * q) = w;
            }
        } else {
            bf16* orow = HL + (size_t)(row0 + rowl) * D + colb;
#pragma unroll
            for (int c = 0; c < 8; ++c) { const f32x4 y = (x[c] * rstd) * Gv[c] + Sv[c]; u32x2 w; w.x = pk2(y[0], y[1]); w.y = pk2(y[2], y[3]); *(u32x2*)(orow + 16 * c) = w; }
        }
    }
}
__device__ __forceinline__ int block_sum_i(int v, LAS int* sm, int lane, int wave) {
    v = wave_sum_i(v);
    if (lane == 0) sm[wave] = v;
    __syncthreads();
    int t = 0;
#pragma unroll
    for (int w = 0; w < NWAVES; ++w) t += sm[w];
    __syncthreads();
    return t;
}
__device__ __forceinline__ void select_phase(const Args& a, int npairs, LAS unsigned char* lds, const int kwave) {
    const int tid = TIDX, lane = tid & 63, wave = tid >> 6;
    LAS int* sm = (LAS int*)lds;
    const float* AFF = (const float*)(a.ws + WS_AFF);
    int* ROWIDX = (int*)(a.ws + WS_ROWIDX); float* GATE = (float*)(a.ws + WS_GATE); int* INV = (int*)(a.ws + WS_INV);
    for (int p = blockIdx.x; p < npairs; p += gridDim.x) {
        const bool lat = p < 64; const int pp = lat ? p : p - 64, b = pp >> 4, e = pp & 15;
        const int n = lat ? S : CTX, cap = lat ? CAPL : CAPC;
        const float* aff = lat ? AFF + (size_t)pp * S : AFF + (size_t)64 * S + (size_t)pp * CTX;
        const int slot_base = lat ? e * SLOTS_E + b * CAPL : e * SLOTS_E + 4096 + b * CAPC;
        const int row_base = lat ? b * S : NLAT + b * CTX;
        unsigned key[16]; const int base = tid * 16;
        if (base < n) {
#pragma unroll
            for (int j = 0; j < 4; ++j) { const f32x4 t = *(const f32x4*)(aff + base + 4 * j); key[4 * j] = __float_as_uint(t[0]); key[4 * j + 1] = __float_as_uint(t[1]); key[4 * j + 2] = __float_as_uint(t[2]); key[4 * j + 3] = __float_as_uint(t[3]); }
        } else {
#pragma unroll
            for (int j = 0; j < 16; ++j) key[j] = 0u;
        }
        unsigned kor = 0u, kand = ~0u;
        if (base < n) {
#pragma unroll
            for (int j = 0; j < 16; ++j) { kor |= key[j]; kand &= key[j]; } }
#pragma unroll
        for (int o = 32; o >= 1; o >>= 1) { kor |= (unsigned)__shfl_xor((int)kor, o); kand &= (unsigned)__shfl_xor((int)kand, o); }
        if (lane == 0) { sm[48 + wave] = (int)kor; sm[56 + wave] = (int)kand; }
        __syncthreads();
#pragma unroll
        for (int w = 0; w < NWAVES; ++w) { kor |= (unsigned)sm[48 + w]; kand &= (unsigned)sm[56 + w]; }
        const unsigned same = ~(kor ^ kand);
        unsigned T = kand & same;
        int it = 0;
        for (int bit = 30; bit >= 0; --bit) {
            if ((same >> bit) & 1u) continue;
            const unsigned cand = T | (1u << bit); int cnt = 0;
#pragma unroll
            for (int j = 0; j < 16; ++j) cnt += (key[j] >= cand) ? 1 : 0;
            cnt = wave_sum_i(cnt);
            LAS int* buf = sm + 64 + (it & 1) * 8;
            if (lane == 0) buf[wave] = cnt;
            __syncthreads();
            int tot = 0;
#pragma unroll
            for (int w = 0; w < NWAVES; ++w) tot += buf[w];
            if (tot >= cap) T = cand;
            ++it;
        }
        __syncthreads();
        int cgt = 0, ceq = 0;
#pragma unroll
        for (int j = 0; j < 16; ++j) { cgt += (key[j] > T) ? 1 : 0; ceq += (key[j] == T) ? 1 : 0; }
        int igt = cgt, ieq = ceq;
#pragma unroll
        for (int o = 1; o < 64; o <<= 1) { const int t1 = __shfl_up(igt, o), t2 = __shfl_up(ieq, o); if (lane >= o) { igt += t1; ieq += t2; } }
        if (lane == 63) { sm[16 + wave] = igt; sm[32 + wave] = ieq; }
        __syncthreads();
        int pgt = igt - cgt, peq = ieq - ceq, totgt = 0;
#pragma unroll
        for (int w = 0; w < NWAVES; ++w) { const int g = sm[16 + w], q = sm[32 + w]; if (w < wave) { pgt += g; peq += q; } totgt += g; }
        __syncthreads();
        const int need = cap - totgt;
        if (base < n) {
            int g = pgt, q = peq;
#pragma unroll
            for (int j = 0; j < 16; ++j) {
                const unsigned k = key[j]; const int row = row_base + base + j;
                const bool sel = (k > T) || (k == T && q < need);
                int slot = -1;
                if (sel) { slot = slot_base + g + (q < need ? q : need); ROWIDX[slot] = row; GATE[slot] = __uint_as_float(k); }
                INV[(size_t)row * 16 + e] = slot;
                g += (k > T) ? 1 : 0; q += (k == T) ? 1 : 0;
            }
        }
    }
}
__device__ __forceinline__ void combine_phase(const Args& a, int l, const int kwave) {
    const int lane = TIDX & 63, wave = TIDX >> 6;
    const int gw = blockIdx.x * NWAVES + wave, NGW = gridDim.x * NWAVES;
    const float* mod = (const float*)(a.ws + WS_MOD); bf16* HL = (bf16*)(a.ws + WS_HL);
    const float* XC = (const float*)(a.ws + WS_XC); const int* INV = (const int*)(a.ws + WS_INV); const bf16* Y = (const bf16*)(a.ws + WS_Y);
    const int nrows = (l == 0) ? NROWS : NLAT;
    int row = gw;
    int inv_n = -1; f32x4 vn[4];
    if (row < nrows) { inv_n = (lane < 16) ? INV[(size_t)row * 16 + lane] : -1; const float* xr0 = row < NLAT ? a.out + (size_t)row * D : XC + (size_t)(row - NLAT) * D;
#pragma unroll
        for (int j = 0; j < 4; ++j) vn[j] = *(const f32x4*)(xr0 + 4 * lane + 256 * j); }
    for (; row < nrows; row += NGW) {
        const bool lat = row < NLAT; const int r = lat ? row / S : 4;
        const int inv = inv_n; f32x4 v[4], acc[4];
#pragma unroll
        for (int j = 0; j < 4; ++j) { v[j] = vn[j]; acc[j] = (f32x4){0.f, 0.f, 0.f, 0.f}; }
        float* xr = lat ? a.out + (size_t)row * D : (float*)XC + (size_t)(row - NLAT) * D;
        const int nrow = row + NGW;
        if (nrow < nrows) { inv_n = (lane < 16) ? INV[(size_t)nrow * 16 + lane] : -1; const float* xrn = nrow < NLAT ? a.out + (size_t)nrow * D : XC + (size_t)(nrow - NLAT) * D;
#pragma unroll
            for (int j = 0; j < 4; ++j) vn[j] = *(const f32x4*)(xrn + 4 * lane + 256 * j); }
        unsigned long long mask = __ballot(inv >= 0);
        while (mask) {
            int sl[4];
#pragma unroll
            for (int q = 0; q < 4; ++q) { if (mask) { const int e = __builtin_ctzll(mask); mask &= mask - 1; sl[q] = __builtin_amdgcn_readlane(inv, e); } else sl[q] = -1; }
            if (FP8_Y) {
                unsigned w[4][4];
#pragma unroll
                for (int q = 0; q < 4; ++q) if (sl[q] >= 0) { const unsigned char* yr = (const unsigned char*)Y + (size_t)sl[q] * D;
#pragma unroll
                    for (int j = 0; j < 4; ++j) w[q][j] = *(const unsigned*)(yr + 4 * lane + 256 * j); }
#pragma unroll
                for (int q = 0; q < 4; ++q) if (sl[q] >= 0) {
#pragma unroll
                    for (int j = 0; j < 4; ++j) { acc[j][0] += __builtin_amdgcn_cvt_f32_fp8((int)w[q][j], 0); acc[j][1] += __builtin_amdgcn_cvt_f32_fp8((int)w[q][j], 1); acc[j][2] += __builtin_amdgcn_cvt_f32_fp8((int)w[q][j], 2); acc[j][3] += __builtin_amdgcn_cvt_f32_fp8((int)w[q][j], 3); } }
            } else {
                u32x2 w[4][4];
#pragma unroll
                for (int q = 0; q < 4; ++q) if (sl[q] >= 0) { const bf16* yr = Y + (size_t)sl[q] * D;
#pragma unroll
                    for (int j = 0; j < 4; ++j) w[q][j] = *(const u32x2*)(yr + 4 * lane + 256 * j); }
#pragma unroll
                for (int q = 0; q < 4; ++q) if (sl[q] >= 0) {
#pragma unroll
                    for (int j = 0; j < 4; ++j) { acc[j][0] += bf2f(w[q][j].x & 0xffffu); acc[j][1] += bf2f(w[q][j].x >> 16); acc[j][2] += bf2f(w[q][j].y & 0xffffu); acc[j][3] += bf2f(w[q][j].y >> 16); } }
            }
        }
        const float* g2 = mod + (l * 5 + r) * 6144 + 5 * 1024;
#pragma unroll
        for (int j = 0; j < 4; ++j) { const f32x4 gg = *(const f32x4*)(g2 + 4 * lane + 256 * j) * (FP8_Y ? 1.0f / Y8_SCALE : 1.0f); v[j] = v[j] + gg * acc[j]; }
        if (lat) {
#pragma unroll
            for (int j = 0; j < 4; ++j) *(f32x4*)(xr + 4 * lane + 256 * j) = v[j];
        }
        if (l == 0) {
            f32x4 y[4]; const float* m = mod + (1 * 5 + r) * 6144;
            norm_mod(v, y, a.in[6] + 1024, m, m + 1024, lane);
            store_bf16_row(HL + (size_t)row * D, y, lane);
        }
    }
}

namespace pg8 {
constexpr int BM = 256, BK = 64, HALF = 128, HTB = HALF * BK * 2, STAGE_BYTES = 8 * HTB, NXCD = 8, WGM = 8;
__host__ __device__ __forceinline__ int lds_byte(int r, int c) { const int st = (r >> 4) * 2 + (c >> 5), rr = r & 15, cc = c & 31, ob = rr * 64 + cc * 2; return st * 1024 + (ob ^ (((ob >> 9) & 1) << 5)); }
__host__ __device__ __forceinline__ void stage_rc(int b, int& R, int& C) { const int st = b / 1024, sb = b % 1024, swz = sb ^ (((sb >> 9) & 1) << 5); R = (st >> 1) * 16 + swz / 64; C = (st & 1) * 32 + (swz % 64) / 2; }
__host__ __device__ __forceinline__ int perm32(int rho) { const int n = rho >> 4, i = rho & 15; return 8 * (i >> 2) + 4 * n + (i & 3); }
struct Unit { int pm, pn; };
struct Sched {
    int reph = 2;
    int nM, nN, nwg, G, c, mpe;
    const char* Bt; size_t b_estride, b_tstride;
    __device__ __forceinline__ void init(int nM_, int nN_, int G_, int c_, int mpe_, const void* Bt_, size_t es, size_t ts) { nM = nM_; nN = nN_; nwg = nM * nN; G = G_; c = c_; mpe = mpe_; Bt = (const char*)Bt_; b_estride = es; b_tstride = ts; }
    __device__ __forceinline__ bool next(int i, Unit& u) const {
        const long L = (long)i * G + c; if (L >= (long)nwg * reph / 2) return false;
        int wgid = (int)(L % nwg); { const int q = nwg / NXCD, r = nwg % NXCD, xcd = wgid % NXCD, off = wgid / NXCD; wgid = (xcd < r ? xcd * (q + 1) : r * (q + 1) + (xcd - r) * q) + off; }
        const int nig = WGM * nN, gid = wgid / nig, fm = gid * WGM, gsz = (nM - fm) < WGM ? (nM - fm) : WGM;
        int pm = fm + ((wgid % nig) % gsz); u.pn = (wgid % nig) / gsz;
        if (mpe) { const int e = pm / mpe; pm = e * 17 + (pm - e * mpe); }
        u.pm = pm; return true;
    }
    __device__ __forceinline__ const char* b_base(const Unit& u) const { const int e = mpe ? u.pm / 17 : 0; return Bt + (size_t)e * b_estride + (size_t)u.pn * b_tstride; }
};
__device__ __forceinline__ unsigned cvt_pk_bf16(float lo, float hi) { unsigned r; asm volatile("v_cvt_pk_bf16_f32 %0, %1, %2" : "=v"(r) : "v"(lo), "v"(hi)); return r; }

__device__ __forceinline__ u32x4 widen16(u32x2 a, u32x2 b) {
    auto r0 = __builtin_amdgcn_permlane16_swap(a.x, b.x, false, false); auto r1 = __builtin_amdgcn_permlane16_swap(a.y, b.y, false, false);
    u32x4 w; w.x = r0[0]; w.y = r1[0]; w.z = r0[1]; w.w = r1[1]; return w;
}
struct EpiQKV {
    static constexpr bool PERM = true;
    bf16* Q; bf16* Kb; bf16* Vb; int kvw, nqt, nkt; const float* qg; const float* kg; const float* ropet; int rope; float qscale;
    __device__ __forceinline__ void operator()(const f32x4 (&acc)[2][2][4][2], const Unit& u, int wr, int wc, int fr, int fq) const {
        const int row0 = u.pm * BM + wr * 64 + fr;
        if (u.pn >= nqt + nkt) {
            const int colt = (u.pn - nqt - nkt) * BM + wc * 32 + 8 * fq;
#pragma unroll
            for (int ai = 0; ai < 2; ++ai)
#pragma unroll
                for (int m = 0; m < 4; ++m) { bf16* rowp = Vb + (size_t)(row0 + ai * HALF + m * 16) * kvw + colt;
#pragma unroll
                    for (int bj = 0; bj < 2; ++bj) { const f32x4 v0 = acc[ai][bj][m][0], v1 = acc[ai][bj][m][1]; u32x4 w; w.x = cvt_pk_bf16(v0[0], v0[1]); w.y = cvt_pk_bf16(v0[2], v0[3]); w.z = cvt_pk_bf16(v1[0], v1[1]); w.w = cvt_pk_bf16(v1[2], v1[3]);
                        *(u32x4*)(rowp + bj * HALF) = w; } }
            return;
        }
        const bool isq = u.pn < nqt; const int head = isq ? 4 * u.pn + wc : 4 * (u.pn - nqt) + wc;
        const float* gain = isq ? qg : kg; const float scale = isq ? qscale : 1.0f;
        bf16* dst = (isq ? Q : Kb) + head * 64 + 4 * fq; const int ld = isq ? 1024 : kvw;
        f32x4 gv[2][2];
#pragma unroll
        for (int bj = 0; bj < 2; ++bj)
#pragma unroll
            for (int n = 0; n < 2; ++n) gv[bj][n] = *(const f32x4*)(gain + 32 * bj + 16 * n + 4 * fq);
        const bool dorope = rope && (u.pm < NLAT / BM);
#pragma unroll
        for (int ai = 0; ai < 2; ++ai)
#pragma unroll
            for (int m = 0; m < 4; ++m) {
                const int row = row0 + ai * HALF + m * 16;
                float ss = 0.f;
#pragma unroll
                for (int bj = 0; bj < 2; ++bj)
#pragma unroll
                    for (int n = 0; n < 2; ++n) { const f32x4 x = acc[ai][bj][m][n]; ss += (x[0] * x[0] + x[1] * x[1]) + (x[2] * x[2] + x[3] * x[3]); }
                ss += __shfl_xor(ss, 16); ss += __shfl_xor(ss, 32);
                const float rstd = scale / sqrtf(ss * (1.0f / 64.0f) + EPS);
                f32x4 y[2][2];
#pragma unroll
                for (int bj = 0; bj < 2; ++bj)
#pragma unroll
                    for (int n = 0; n < 2; ++n) y[bj][n] = acc[ai][bj][m][n] * rstd * gv[bj][n];
                if (dorope) { const int pos = row & (S - 1);
#pragma unroll
                    for (int bj = 0; bj < 2; ++bj) { const int v = bj == 0 ? (pos >> 6) : (pos & 63); const f32x4 cs = *(const f32x4*)(ropet + v * 16 + 4 * fq), sn = *(const f32x4*)(ropet + 2048 + v * 16 + 4 * fq);
                        const f32x4 a0 = y[bj][0], a1 = y[bj][1]; y[bj][0] = a0 * cs - a1 * sn; y[bj][1] = a0 * sn + a1 * cs; } }
                bf16* rowp = dst + (size_t)row * ld - 4 * fq + ((fq & 1) ? 16 + 4 * (fq - 1) : 4 * fq);
#pragma unroll
                for (int bj = 0; bj < 2; ++bj) {
                    u32x2 wa, wb; wa.x = cvt_pk_bf16(y[bj][0][0], y[bj][0][1]); wa.y = cvt_pk_bf16(y[bj][0][2], y[bj][0][3]); wb.x = cvt_pk_bf16(y[bj][1][0], y[bj][1][1]); wb.y = cvt_pk_bf16(y[bj][1][2], y[bj][1][3]);
                    *(u32x4*)(rowp + 32 * bj) = widen16(wa, wb); }
            }
    }
};
struct EpiOproj {
    static constexpr bool PERM = false;
    const float* base_lat; const float* base_ctx; float* out_lat; float* out_ctx; const float* g1; float accscale;
    __device__ __forceinline__ void operator()(const f32x4 (&acc)[2][2][4][2], const Unit& u, int wr, int wc, int fr, int fq) const {
        const bool lat = u.pm < NLAT / BM; const int r = lat ? (u.pm >> 5) : 4;
        const int col0 = u.pn * BM + wc * 32 + 4 * fq;
        const int row0 = (lat ? u.pm * BM : u.pm * BM - NLAT) + wr * 64 + fr;
        const float* bs = lat ? base_lat : base_ctx; float* os = lat ? out_lat : out_ctx;
        f32x4 gv[2][2];
#pragma unroll
        for (int bj = 0; bj < 2; ++bj)
#pragma unroll
            for (int n = 0; n < 2; ++n) gv[bj][n] = *(const f32x4*)(g1 + r * 6144 + col0 + bj * HALF + n * 16) * accscale;
#pragma unroll
        for (int ai = 0; ai < 2; ++ai)
#pragma unroll
            for (int mp = 0; mp < 2; ++mp) {
                f32x4 pre[2][2][2];
#pragma unroll
                for (int mm = 0; mm < 2; ++mm) { const size_t off = (size_t)(row0 + ai * HALF + (2 * mp + mm) * 16) * D + col0;
#pragma unroll
                    for (int bj = 0; bj < 2; ++bj)
#pragma unroll
                        for (int n = 0; n < 2; ++n) pre[mm][bj][n] = *(const f32x4*)(bs + off + bj * HALF + n * 16); }
                asm volatile("" ::: "memory");
#pragma unroll
                for (int mm = 0; mm < 2; ++mm) { const size_t off = (size_t)(row0 + ai * HALF + (2 * mp + mm) * 16) * D + col0;
#pragma unroll
                    for (int bj = 0; bj < 2; ++bj)
#pragma unroll
                        for (int n = 0; n < 2; ++n) *(f32x4*)(os + off + bj * HALF + n * 16) = pre[mm][bj][n] + gv[bj][n] * acc[ai][bj][2 * mp + mm][n]; }
                asm volatile("" ::: "memory");
            }
    }
};
__device__ __forceinline__ float silu_fast(float x) { return x * __builtin_amdgcn_rcpf(1.0f + __expf(-x)); }
struct EpiGU {
    static constexpr bool PERM = true;
    bf16* H; float inscale;
    __device__ __forceinline__ void operator()(const f32x4 (&acc)[2][2][4][2], const Unit& u, int wr, int wc, int fr, int fq) const {
        const int row0 = u.pm * BM + wr * 64 + fr, col0 = u.pn * HALF + wc * 32 + 8 * fq;
#pragma unroll
        for (int ai = 0; ai < 2; ++ai)
#pragma unroll
            for (int mp = 0; mp < 2; ++mp) {
                u32x2 w8[2]; u32x4 wb[2];
#pragma unroll
                for (int mm = 0; mm < 2; ++mm) { const int m = 2 * mp + mm;
                    const f32x4 g0 = acc[ai][0][m][0] * inscale, g1 = acc[ai][0][m][1] * inscale, u0 = acc[ai][1][m][0] * inscale, u1 = acc[ai][1][m][1] * inscale;
                    float hv[8];
#pragma unroll
                    for (int i = 0; i < 4; ++i) { hv[i] = silu_fast(g0[i]) * u0[i]; hv[4 + i] = silu_fast(g1[i]) * u1[i]; }
                    if (FP8_DOWN) {
                        int w0 = 0, w1 = 0;
                        w0 = __builtin_amdgcn_cvt_pk_fp8_f32(hv[0], hv[1], w0, false); w0 = __builtin_amdgcn_cvt_pk_fp8_f32(hv[2], hv[3], w0, true);
                        w1 = __builtin_amdgcn_cvt_pk_fp8_f32(hv[4], hv[5], w1, false); w1 = __builtin_amdgcn_cvt_pk_fp8_f32(hv[6], hv[7], w1, true);
                        w8[mm].x = (unsigned)w0; w8[mm].y = (unsigned)w1;
                    } else { wb[mm].x = cvt_pk_bf16(hv[0], hv[1]); wb[mm].y = cvt_pk_bf16(hv[2], hv[3]); wb[mm].z = cvt_pk_bf16(hv[4], hv[5]); wb[mm].w = cvt_pk_bf16(hv[6], hv[7]); }
                }
                if (FP8_DOWN) {
                    const int m = 2 * mp + (fq & 1);
                    *(u32x4*)((unsigned char*)H + (size_t)(row0 + ai * HALF + m * 16) * FF + col0 - 8 * (fq & 1)) = widen16(w8[0], w8[1]);
                } else {
#pragma unroll
                    for (int mm = 0; mm < 2; ++mm) *(u32x4*)(H + (size_t)(row0 + ai * HALF + (2 * mp + mm) * 16) * FF + col0) = wb[mm];
                }
            }
    }
};
struct EpiDown {
    static constexpr bool PERM = true;
    bf16* Y; const float* gate;
    __device__ __forceinline__ void operator()(const f32x4 (&acc)[2][2][4][2], const Unit& u, int wr, int wc, int fr, int fq) const {
        const int row0 = u.pm * BM + wr * 64 + fr, col0 = u.pn * BM + wc * 32 + 8 * fq;
        static_assert(FP8_Y, "fp8 Y only");
        const float gsc = (FP8_DOWN ? W8_INV : 1.0f) * Y8_SCALE;
#pragma unroll
        for (int ai = 0; ai < 2; ++ai) {
            float gt4[4];
#pragma unroll
            for (int m = 0; m < 4; ++m) gt4[m] = gate[row0 + ai * HALF + m * 16] * gsc;
#pragma unroll
            for (int mp = 0; mp < 2; ++mp) {
#pragma unroll
                for (int bj = 0; bj < 2; ++bj) {
                    u32x2 w8[2];
#pragma unroll
                    for (int mm = 0; mm < 2; ++mm) { const int m = 2 * mp + mm; const float gt = gt4[m];
                        const f32x4 v0 = acc[ai][bj][m][0] * gt, v1 = acc[ai][bj][m][1] * gt;
                        int w0 = 0, w1 = 0;
                        w0 = __builtin_amdgcn_cvt_pk_fp8_f32(v0[0], v0[1], w0, false); w0 = __builtin_amdgcn_cvt_pk_fp8_f32(v0[2], v0[3], w0, true);
                        w1 = __builtin_amdgcn_cvt_pk_fp8_f32(v1[0], v1[1], w1, false); w1 = __builtin_amdgcn_cvt_pk_fp8_f32(v1[2], v1[3], w1, true);
                        w8[mm].x = (unsigned)w0; w8[mm].y = (unsigned)w1; }
                    *(u32x4*)((unsigned char*)Y + (size_t)(row0 + ai * HALF + (2 * mp + (fq & 1)) * 16) * D + col0 - 8 * (fq & 1) + bj * HALF) = widen16(w8[0], w8[1]);
                }
            }
        }
    }
};
typedef int v8i32 __attribute__((ext_vector_type(8)));
typedef int v4i32 __attribute__((ext_vector_type(4)));
template <class Epi, bool GATHER, bool FP8 = false>
__device__ __forceinline__ void gemm_phase(LAS unsigned char* lds, const char* Abase, int K, const Sched& S, const Epi& E, LAS int* ldsidx, const int* rowidx, const int kwave) {
    const int tid = TIDX, wid = __builtin_amdgcn_readfirstlane(tid >> 6), lane = tid & 63, wr = wid >> 2, wc = wid & 3, fr = lane & 15, fq = lane >> 4;
    const int nt = K / BK;
    int Rst[2], Cst[2]; unsigned voffB[2];
#pragma unroll
    for (int i = 0; i < 2; ++i) { int R, C; stage_rc(tid * 16 + i * 8192, R, C); Rst[i] = R; Cst[i] = C; const int Rb = Epi::PERM ? ((R & ~31) + perm32(R & 31)) : R; voffB[i] = (unsigned)(Rb * K + C) * 2u; }
    const size_t kstep = (size_t)(BK * 2);
    const size_t hstep = (size_t)HALF * K * 2;
    const unsigned ldsw = (unsigned)wid * 1024u;
    constexpr bool ASM_STAGE = FP8;
    const unsigned ldsbase = (unsigned)__builtin_amdgcn_readfirstlane((int)((unsigned)(uintptr_t)lds + ldsw));
    const int aoff = lds_byte(wr * 64 + fr, fq * 8), boff = lds_byte(wc * 32 + fr, fq * 8);
    Unit cur, nxt; int ui = 0;
    if (!S.next(0, cur)) return;
    if (GATHER) {
        Unit t_; for (int i = 0; S.next(i, t_); ++i) if (tid < 256) ldsidx[i * 256 + tid] = rowidx[t_.pm * 256 + tid];
        __syncthreads();
    }
#define PG8_SA(b, h) (((b) * 2 + (h)) * HTB)
#define PG8_SB(b, h) ((4 + (b) * 2 + (h)) * HTB)
#define PG8_GLDS_ASM(off32, gbase, ldsdst) do { unsigned keep_; asm volatile("s_nop 4\n\ts_mov_b32 %0, m0\n\ts_mov_b32 m0, %3\n\ts_nop 0\n\tglobal_load_lds_dwordx4 %1, %2\n\ts_mov_b32 m0, %0" \
        : "=&s"(keep_) : "v"(off32), "s"((const char*)(gbase)), "s"(ldsdst) : "memory"); } while (0)
#define PG8_STAGE(bufoff, gbase, voff) do { if constexpr (ASM_STAGE) { PG8_GLDS_ASM((voff)[0], gbase, ldsbase + (unsigned)(bufoff)); PG8_GLDS_ASM((voff)[1], gbase, ldsbase + (unsigned)((bufoff) + 8192)); } \
        else { _Pragma("unroll") for (int _i = 0; _i < 2; ++_i) \
        __builtin_amdgcn_global_load_lds((const unsigned*)((const char*)(gbase) + (voff)[_i]), (LAS unsigned*)(lds + (bufoff) + ldsw + _i * 8192), 16, 0, 0); } } while (0)
#define PG8_AOFF(vo, u_, ui_) do { const int _t = TIDX; _Pragma("unroll") for (int _i = 0; _i < 2; ++_i) { int _R, _C; stage_rc(_t * 16 + _i * 8192, _R, _C); _Pragma("unroll") for (int _h = 0; _h < 2; ++_h) { \
        const int _row = GATHER ? ldsidx[(ui_) * 256 + _h * HALF + _R] : (u_).pm * BM + _h * HALF + _R; vo[_h][_i] = (unsigned)(_row * K + _C) * 2u; } } } while (0)
#define PG8_LD2(p) __builtin_shufflevector(*(const LAS v4i32*)(p), *(const LAS v4i32*)((p) + 1024), 0, 1, 2, 3, 4, 5, 6, 7)
#define PG8_LDA(dst, b, h) do { _Pragma("unroll") for (int m = 0; m < 4; ++m) dst[m] = PG8_LD2(lds + PG8_SA(b, h) + aoff + m * 2048); } while (0)
#define PG8_LDB(dst, b, h) do { _Pragma("unroll") for (int n = 0; n < 2; ++n) dst[n] = PG8_LD2(lds + PG8_SB(b, h) + boff + n * 2048); } while (0)
#define PG8_H0(x) __builtin_bit_cast(bf16x8, __builtin_shufflevector(x, x, 0, 1, 2, 3))
#define PG8_H1(x) __builtin_bit_cast(bf16x8, __builtin_shufflevector(x, x, 4, 5, 6, 7))
#define PG8_MMA(ai, bj, At, Bt) do { __builtin_amdgcn_s_setprio(1); \
        if constexpr (FP8) { _Pragma("unroll") for (int m = 0; m < 4; ++m) _Pragma("unroll") for (int n = 0; n < 2; ++n) \
            acc[ai][bj][m][n] = __builtin_amdgcn_mfma_scale_f32_16x16x128_f8f6f4(Bt[n], At[m], acc[ai][bj][m][n], 0, 0, 0, 0x7f7f7f7f, 0, 0x7f7f7f7f); } \
        else { _Pragma("unroll") for (int m = 0; m < 4; ++m) _Pragma("unroll") for (int n = 0; n < 2; ++n) { \
            acc[ai][bj][m][n] = __builtin_amdgcn_mfma_f32_16x16x32_bf16(PG8_H0(Bt[n]), PG8_H0(At[m]), acc[ai][bj][m][n], 0, 0, 0); \
            acc[ai][bj][m][n] = __builtin_amdgcn_mfma_f32_16x16x32_bf16(PG8_H1(Bt[n]), PG8_H1(At[m]), acc[ai][bj][m][n], 0, 0, 0); } } \
        __builtin_amdgcn_s_setprio(0); } while (0)
#define PG8_WAIT_V(n) asm volatile("s_waitcnt vmcnt(" #n ")" ::: "memory")
#define PG8_WAIT_L(n) asm volatile("s_waitcnt lgkmcnt(" #n ")" ::: "memory")
#define PG8_BAR __builtin_amdgcn_s_barrier()
#define PG8_SCHED __builtin_amdgcn_sched_barrier(0)
    f32x4 acc[2][2][4][2];
#pragma unroll
    for (int a = 0; a < 2; ++a)
#pragma unroll
        for (int b = 0; b < 2; ++b)
#pragma unroll
            for (int m = 0; m < 4; ++m)
#pragma unroll
                for (int n = 0; n < 2; ++n) acc[a][b][m][n] = (f32x4){0.f, 0.f, 0.f, 0.f};
    v8i32 At[4], B0[2], B1[2];
    unsigned voC[2][2];
    const size_t hstepA = GATHER ? 0 : hstep;
    const char* cA = Abase; const char* nA = Abase;
    if (GATHER) { PG8_AOFF(voC, cur, 0); }
    else {
#pragma unroll
        for (int i = 0; i < 2; ++i) { voC[0][i] = (unsigned)(Rst[i] * K + Cst[i]) * 2u; voC[1][i] = voC[0][i]; }
        cA = Abase + (size_t)cur.pm * 2 * hstep;
    }
    const char* cB = S.b_base(cur);
    PG8_STAGE(PG8_SB(0, 0), cB, voffB); PG8_STAGE(PG8_SB(0, 1), cB + hstep, voffB); PG8_STAGE(PG8_SA(0, 0), cA, voC[0]); PG8_STAGE(PG8_SA(0, 1), cA + hstepA, voC[1]);
    if (wr == 1) PG8_BAR;
    PG8_WAIT_V(2); PG8_BAR;
    PG8_STAGE(PG8_SB(1, 0), cB + kstep, voffB); PG8_STAGE(PG8_SA(1, 0), cA + kstep, voC[0]); PG8_STAGE(PG8_SB(1, 1), cB + hstep + kstep, voffB);
    PG8_WAIT_V(6); PG8_BAR;
    for (;;) {
        const bool has_next = S.next(ui + 1, nxt);
        if (!GATHER) nA = has_next ? Abase + (size_t)nxt.pm * 2 * hstep : cA;
        const char* nB = has_next ? S.b_base(nxt) : cB;
#pragma nounroll
        for (int t = 0; t < nt; t += 2) {
            const bool last = (t == nt - 2);
            const char* kA1 = cA + (size_t)(t + 1) * kstep;
            const char* kA2 = last ? nA : cA + (size_t)(t + 2) * kstep; const char* kA3 = kA2 + kstep;
            const char* b2 = last ? nB : cB + (size_t)(t + 2) * kstep; const char* b3 = b2 + kstep;
            PG8_LDB(B0, 0, 0); PG8_LDB(B1, 0, 1); PG8_SCHED; PG8_LDA(At, 0, 0); PG8_STAGE(PG8_SA(1, 1), kA1 + hstepA, voC[1]);
            if (GATHER) { if (last && has_next) { PG8_AOFF(voC, nxt, ui + 1); } }
            PG8_WAIT_V(8); PG8_WAIT_L(0); PG8_BAR; PG8_MMA(0, 0, At, B0); PG8_MMA(0, 1, At, B1); PG8_BAR; PG8_SCHED;
            PG8_LDA(At, 0, 1); PG8_STAGE(PG8_SB(0, 0), b2, voffB); PG8_STAGE(PG8_SB(0, 1), b2 + hstep, voffB); PG8_STAGE(PG8_SA(0, 0), kA2, voC[0]);
            PG8_WAIT_V(8); PG8_WAIT_L(0); PG8_BAR; PG8_MMA(1, 0, At, B0); PG8_MMA(1, 1, At, B1); PG8_BAR; PG8_SCHED;
            PG8_LDB(B0, 1, 0); PG8_LDB(B1, 1, 1); PG8_SCHED; PG8_LDA(At, 1, 0); PG8_STAGE(PG8_SA(0, 1), kA2 + hstepA, voC[1]);
            PG8_WAIT_V(8); PG8_WAIT_L(0); PG8_BAR; PG8_MMA(0, 0, At, B0); PG8_MMA(0, 1, At, B1); PG8_BAR; PG8_SCHED;
            PG8_LDA(At, 1, 1); PG8_STAGE(PG8_SB(1, 0), b3, voffB); PG8_STAGE(PG8_SB(1, 1), b3 + hstep, voffB); PG8_STAGE(PG8_SA(1, 0), kA3, voC[0]);
            PG8_WAIT_V(8); PG8_WAIT_L(0); PG8_BAR; PG8_MMA(1, 0, At, B0); PG8_MMA(1, 1, At, B1); PG8_BAR; PG8_SCHED;
        }
        if (wr == 0) PG8_BAR;
        { int fr_e = fr, fq_e = fq; asm volatile("" : "+v"(fr_e), "+v"(fq_e));
          E(acc, cur, wr, wc, fr_e, fq_e); }
        if (!has_next) break;
#pragma unroll
        for (int a = 0; a < 2; ++a)
#pragma unroll
            for (int b = 0; b < 2; ++b)
#pragma unroll
                for (int m = 0; m < 4; ++m)
#pragma unroll
                    for (int n = 0; n < 2; ++n) acc[a][b][m][n] = (f32x4){0.f, 0.f, 0.f, 0.f};
        cur = nxt; cB = nB; ++ui;
        if (!GATHER) cA = nA;
        if (wr == 1) PG8_BAR;
    }
    PG8_WAIT_V(0);
    PG8_BAR;
#undef PG8_SA
#undef PG8_SB
#undef PG8_STAGE
#undef PG8_GLDS_ASM
#undef PG8_AOFF
#undef PG8_LDA
#undef PG8_LDB
#undef PG8_MMA
#undef PG8_LD2
#undef PG8_H0
#undef PG8_H1
#undef PG8_WAIT_V
#undef PG8_WAIT_L
#undef PG8_BAR
#undef PG8_SCHED
}
}


namespace att {
typedef float f32x16 __attribute__((ext_vector_type(16)));
typedef short s16x4 __attribute__((ext_vector_type(4)));
constexpr int TILEB = 8192, OFF_K = 0, OFF_V = 4 * TILEB, OFF_BIAS = 8 * TILEB, BIAS_PITCH = 160, BIAS_ORG = 64, OFF_QBOX = 80 * 1024  ;
constexpr float NEG = -1e30f;
__device__ __forceinline__ int crow(int r, int h) { return (r & 3) + 8 * (r >> 2) + 4 * h; }
struct StageOff { unsigned k, v; };
__device__ __forceinline__ StageOff stage_off(int tid, int ld) {
    const int row = tid >> 3, ch = tid & 7; StageOff o;
    o.k = (unsigned)(row * ld + ((ch ^ ((row >> 1) & 7)) << 3)) * 2u; o.v = (unsigned)(row * ld + ((ch ^ (((row >> 1) & 1) << 2)) << 3)) * 2u; return o;
}
#define ATT_GLDS(voff, gbase, ldsdst, imm) do { unsigned keep_; asm volatile("s_mov_b32 %0, m0\n\ts_mov_b32 m0, %3\n\ts_nop 0\n\tglobal_load_lds_dwordx4 %1, %2 offset:" #imm "\n\ts_mov_b32 m0, %0" \
        : "=&s"(keep_) : "v"(voff), "s"((const char*)(gbase)), "s"(ldsdst) : "memory"); } while (0)
__device__ __forceinline__ void stage_tile_at(LAS unsigned char* kdst, LAS unsigned char* vdst, const bf16* kbase, const bf16* vbase, const StageOff& so, int wave) {
    const unsigned kd = (unsigned)__builtin_amdgcn_readfirstlane((int)(unsigned)(uintptr_t)(kdst + wave * 1024));
    const unsigned vd = (unsigned)__builtin_amdgcn_readfirstlane((int)(unsigned)(uintptr_t)(vdst + wave * 1024));
    ATT_GLDS(so.k, kbase, kd, 0);
    ATT_GLDS(so.v, vbase, vd, 0);
}
__device__ __forceinline__ void stage_tile(LAS unsigned char* lds, int slot, const bf16* kbase, const bf16* vbase, const StageOff& so, int wave) {
    const unsigned kd = (unsigned)__builtin_amdgcn_readfirstlane((int)(unsigned)(uintptr_t)(lds + OFF_K + slot * TILEB + wave * 1024));
    const unsigned vd = (unsigned)__builtin_amdgcn_readfirstlane((int)(unsigned)(uintptr_t)(lds + OFF_V + slot * TILEB + wave * 1024));
    ATT_GLDS(so.k, kbase, kd, 0);
    ATT_GLDS(so.v, vbase, vd, 0);
}
struct WaveCtx { int koff[4]; int vl[2]; bf16x8 qf[4]; f32x16 o[2]; f32x16 negm; float m, l; };
__device__ __forceinline__ void wave_offsets(WaveCtx& c, int lane, int krow0  ) {
    const int r31 = lane & 31, h = lane >> 5, row = krow0 + r31;
#pragma unroll
    for (int ds = 0; ds < 4; ++ds) c.koff[ds] = row * 128 + (((2 * ds + h) ^ ((row >> 1) & 7)) << 4);
    const int i = lane & 15, qp = i >> 2, pp = i & 3, cb = (lane >> 4) & 1;
#pragma unroll
    for (int db = 0; db < 2; ++db) c.vl[db] = (4 * h + qp) * 128 + ((db ^ ((qp >> 1) & 1)) << 6) + 32 * cb + 8 * pp;
}
__device__ __forceinline__ void load_q(bf16x8 (&qf)[4], int lane, const bf16* qrow) {
#pragma unroll
    for (int ds = 0; ds < 4; ++ds) qf[ds] = *(const bf16x8*)(qrow + 16 * ds + 8 * (lane >> 5));
}
__device__ __forceinline__ void set_negm(WaveCtx& c) {
#pragma unroll
    for (int r = 0; r < 16; ++r) c.negm[r] = -c.m;
    asm volatile("" : "+v"(c.negm));
}
__device__ __forceinline__ void wave_reset(WaveCtx& c, int lane, float m0, float l0, bool need_negm = true) {
#pragma unroll
    for (int r = 0; r < 16; ++r) { c.o[0][r] = 0.f; c.o[1][r] = 0.f; }
    c.m = m0; c.l = (lane < 32) ? l0 : 0.f; if (need_negm) set_negm(c);
}
typedef short v4i16_t __attribute__((ext_vector_type(4)));
__device__ __forceinline__ s16x4 vtr(const LAS unsigned char* p) { return __builtin_bit_cast(s16x4, __builtin_amdgcn_ds_read_tr16_b64_v4i16((LAS v4i16_t*)p)); }
typedef float f32x2_t __attribute__((ext_vector_type(2))); typedef __bf16 bf16x2_t __attribute__((ext_vector_type(2)));
__device__ __forceinline__ unsigned cvtpk(float lo, float hi) { f32x2_t v = {lo, hi}; bf16x2_t b = __builtin_convertvector(v, bf16x2_t); return __builtin_bit_cast(unsigned, b); }
__device__ __forceinline__ float max3f(float a, float b, float c3) { float r; asm("v_max3_f32 %0, %1, %2, %3" : "=v"(r) : "v"(a), "v"(b), "v"(c3)); return r; }
__device__ __forceinline__ float max2f(float a, float b) { float r; asm("v_max_f32_e32 %0, %1, %2" : "=v"(r) : "v"(a), "v"(b)); return r; }
__device__ __forceinline__ bf16x8 pack8(const f32x16& p, int s) {
    u32x4 w; w.x = cvtpk(p[8 * s], p[8 * s + 1]); w.y = cvtpk(p[8 * s + 2], p[8 * s + 3]); w.z = cvtpk(p[8 * s + 4], p[8 * s + 5]); w.w = cvtpk(p[8 * s + 6], p[8 * s + 7]);
    return __builtin_bit_cast(bf16x8, w);
}
constexpr float ATT_THR = 8.0f;
__device__ __forceinline__ bool update_ref(WaveCtx& c, float mx, float& dl) {
    { auto rr = __builtin_amdgcn_permlane32_swap(__float_as_uint(mx), __float_as_uint(mx), false, false); mx = max2f(__uint_as_float(rr[0]), __uint_as_float(rr[1])); }
    dl = 0.f;
    if (__builtin_expect(__any(mx > ATT_THR), 0)) {
        dl = max2f(mx, 0.f);
        const float f = __builtin_amdgcn_exp2f(-dl);
        c.m += dl; c.l *= f;
        c.o[0] = c.o[0] * f; c.o[1] = c.o[1] * f;
        set_negm(c);
        return true;
    }
    return false;
}
#define ATT_SB() __builtin_amdgcn_sched_barrier(0)
struct VFrag { s16x4 lo[4], hi[4]; };
__device__ __forceinline__ void load_v32(const WaveCtx& c, VFrag& f, const LAS unsigned char* vb) {
#pragma unroll
    for (int db = 0; db < 2; ++db)
#pragma unroll
        for (int s = 0; s < 2; ++s) { const LAS unsigned char* p = vb + c.vl[db] + s * 2048; f.lo[db * 2 + s] = vtr(p); f.hi[db * 2 + s] = vtr(p + 1024); }
}
__device__ __forceinline__ void pv32(WaveCtx& c, const f32x16& p, const VFrag& f) {
    const bf16x8 pf0 = pack8(p, 0), pf1 = pack8(p, 1);
#pragma unroll
    for (int db = 0; db < 2; ++db) {
        { const s16x4 lo = f.lo[db * 2], hi = f.hi[db * 2]; const bf16x8 vf = (bf16x8){lo[0], lo[1], lo[2], lo[3], hi[0], hi[1], hi[2], hi[3]}; c.o[db] = __builtin_amdgcn_mfma_f32_32x32x16_bf16(vf, pf0, c.o[db], 0, 0, 0); }
        { const s16x4 lo = f.lo[db * 2 + 1], hi = f.hi[db * 2 + 1]; const bf16x8 vf = (bf16x8){lo[0], lo[1], lo[2], lo[3], hi[0], hi[1], hi[2], hi[3]}; c.o[db] = __builtin_amdgcn_mfma_f32_32x32x16_bf16(vf, pf1, c.o[db], 0, 0, 0); }
    }
}
__device__ __forceinline__ void tile64(WaveCtx& c, const LAS unsigned char* kb, const LAS unsigned char* vb, int qq, int h, int MASK  ) {
    bf16x8 kf[8];
#pragma unroll
    for (int ds = 0; ds < 4; ++ds) { kf[2 * ds] = *(const LAS bf16x8*)(kb + c.koff[ds]); kf[2 * ds + 1] = *(const LAS bf16x8*)(kb + 4096 + c.koff[ds]); }
    ATT_SB();
    f32x16 p0 = __builtin_amdgcn_mfma_f32_32x32x16_bf16(kf[0], c.qf[0], c.negm, 0, 0, 0), p1 = __builtin_amdgcn_mfma_f32_32x32x16_bf16(kf[1], c.qf[0], c.negm, 0, 0, 0);
#pragma unroll
    for (int ds = 1; ds < 4; ++ds) { p0 = __builtin_amdgcn_mfma_f32_32x32x16_bf16(kf[2 * ds], c.qf[ds], p0, 0, 0, 0); p1 = __builtin_amdgcn_mfma_f32_32x32x16_bf16(kf[2 * ds + 1], c.qf[ds], p1, 0, 0, 0); }
    VFrag f0, f1; load_v32(c, f0, vb); load_v32(c, f1, vb + 4096);
    ATT_SB();
    asm volatile("s_nop 15\n\ts_nop 7" : "+v"(p0), "+v"(p1));
    if (MASK == 1) {
#pragma unroll
        for (int r = 0; r < 16; ++r) { const int kk = crow(r, h); if (kk < qq) p0[r] = NEG; if (kk + 32 < qq) p1[r] = NEG; } }
    if (MASK == 2) {
#pragma unroll
        for (int r = 0; r < 16; ++r) { const int kk = crow(r, h); if (kk > qq) p0[r] = NEG; if (kk + 32 > qq) p1[r] = NEG; } }
    float ma = max3f(p0[0], p0[1], p1[0]), mb = max3f(p0[2], p0[3], p1[1]); ma = max3f(ma, p1[2], p1[3]);
#pragma unroll
    for (int r = 4; r < 16; r += 4) { ma = max3f(ma, p0[r], p0[r + 1]); mb = max3f(mb, p0[r + 2], p0[r + 3]); ma = max3f(ma, p1[r], p1[r + 1]); mb = max3f(mb, p1[r + 2], p1[r + 3]); }
    float dl;
    if (update_ref(c, max2f(ma, mb), dl)) {
#pragma unroll
        for (int r = 0; r < 16; ++r) { p0[r] -= dl; p1[r] -= dl; } }
    float ls = 0.f;
#pragma unroll
    for (int r = 0; r < 16; ++r) { p0[r] = __builtin_amdgcn_exp2f(p0[r]); p1[r] = __builtin_amdgcn_exp2f(p1[r]); ls += p0[r] + p1[r]; }
    c.l += ls;
    pv32(c, p0, f0); pv32(c, p1, f1);
}
constexpr float ATT_FAST_BOUND = 60.0f;
__device__ __forceinline__ void tile64_fast(WaveCtx& c, const LAS unsigned char* kb, const LAS unsigned char* vb, int qq, int h, int MASK  ) {
    bf16x8 kf[8];
#pragma unroll
    for (int ds = 0; ds < 4; ++ds) { kf[2 * ds] = *(const LAS bf16x8*)(kb + c.koff[ds]); kf[2 * ds + 1] = *(const LAS bf16x8*)(kb + 4096 + c.koff[ds]); }
    ATT_SB();
    f32x16 p0, p1;
#pragma unroll
    for (int r = 0; r < 16; ++r) { p0[r] = 0.f; p1[r] = 0.f; }
#pragma unroll
    for (int ds = 0; ds < 4; ++ds) { p0 = __builtin_amdgcn_mfma_f32_32x32x16_bf16(kf[2 * ds], c.qf[ds], p0, 0, 0, 0); p1 = __builtin_amdgcn_mfma_f32_32x32x16_bf16(kf[2 * ds + 1], c.qf[ds], p1, 0, 0, 0); }
    VFrag f0, f1; load_v32(c, f0, vb); load_v32(c, f1, vb + 4096);
    ATT_SB();
    if (MASK == 1) {
#pragma unroll
        for (int r = 0; r < 16; ++r) { const int kk = crow(r, h); if (kk < qq) p0[r] = NEG; if (kk + 32 < qq) p1[r] = NEG; } }
    if (MASK == 2) {
#pragma unroll
        for (int r = 0; r < 16; ++r) { const int kk = crow(r, h); if (kk > qq) p0[r] = NEG; if (kk + 32 > qq) p1[r] = NEG; } }
    float ls = 0.f;
#pragma unroll
    for (int r = 0; r < 16; ++r) { p0[r] = __builtin_amdgcn_exp2f(p0[r]); p1[r] = __builtin_amdgcn_exp2f(p1[r]); ls += p0[r] + p1[r]; }
    c.l += ls;
    pv32(c, p0, f0); pv32(c, p1, f1);
}
__device__ __forceinline__ void ldk64(bf16x8 (&kf)[8], const WaveCtx& c, const LAS unsigned char* kb) {
#pragma unroll
    for (int ds = 0; ds < 4; ++ds) { kf[2 * ds] = *(const LAS bf16x8*)(kb + c.koff[ds]); kf[2 * ds + 1] = *(const LAS bf16x8*)(kb + 4096 + c.koff[ds]); }
}
template <bool PRE>
__device__ __forceinline__ void tile64_fast_core(WaveCtx& c, const bf16x8 (&kf)[8], bf16x8 (&kn)[8], const LAS unsigned char* knb, const LAS unsigned char* vb, int qq, int h, int MASK  ) {
    f32x16 p0, p1;
#pragma unroll
    for (int r = 0; r < 16; ++r) { p0[r] = 0.f; p1[r] = 0.f; }
#pragma unroll
    for (int ds = 0; ds < 4; ++ds) { p0 = __builtin_amdgcn_mfma_f32_32x32x16_bf16(kf[2 * ds], c.qf[ds], p0, 0, 0, 0); p1 = __builtin_amdgcn_mfma_f32_32x32x16_bf16(kf[2 * ds + 1], c.qf[ds], p1, 0, 0, 0); }
    VFrag f0, f1; load_v32(c, f0, vb); load_v32(c, f1, vb + 4096);
    if (PRE) ldk64(kn, c, knb);
    if (MASK == 1) {
#pragma unroll
        for (int r = 0; r < 16; ++r) { const int kk = crow(r, h); if (kk < qq) p0[r] = NEG; if (kk + 32 < qq) p1[r] = NEG; } }
    if (MASK == 2) {
#pragma unroll
        for (int r = 0; r < 16; ++r) { const int kk = crow(r, h); if (kk > qq) p0[r] = NEG; if (kk + 32 > qq) p1[r] = NEG; } }
    float ls = 0.f;
#pragma unroll
    for (int r = 0; r < 16; ++r) { p0[r] = __builtin_amdgcn_exp2f(p0[r]); p1[r] = __builtin_amdgcn_exp2f(p1[r]); ls += p0[r] + p1[r]; }
    c.l += ls;
    pv32(c, p0, f0); pv32(c, p1, f1);
}
__device__ __forceinline__ void tile32_b_fast(WaveCtx& c, const LAS unsigned char* kb, const int (&koffL)[4], const LAS unsigned char* vb, const LAS float* brow, bool rowok, int kstart, int wst, int h) {
    bf16x8 kf[4];
#pragma unroll
    for (int ds = 0; ds < 4; ++ds) kf[ds] = *(const LAS bf16x8*)(kb + koffL[ds]);
    float bv[16];
#pragma unroll
    for (int r = 0; r < 16; ++r) bv[r] = brow[(r & 3) + 8 * (r >> 2)];
    ATT_SB();
    f32x16 p0;
#pragma unroll
    for (int r = 0; r < 16; ++r) p0[r] = 0.f;
#pragma unroll
    for (int ds = 0; ds < 4; ++ds) p0 = __builtin_amdgcn_mfma_f32_32x32x16_bf16(kf[ds], c.qf[ds], p0, 0, 0, 0);
    VFrag f0; load_v32(c, f0, vb);
    ATT_SB();
    float ls = 0.f;
#pragma unroll
    for (int r = 0; r < 16; ++r) { const int kc = kstart + (r & 3) + 8 * (r >> 2) + 4 * h; const float sv = (rowok && kc >= wst && kc < wst + 16) ? p0[r] + bv[r] : NEG; p0[r] = __builtin_amdgcn_exp2f(sv); ls += p0[r]; }
    c.l += ls;
    pv32(c, p0, f0);
}
struct B32In { bf16x8 kf[4]; float bv[16]; };
__device__ __forceinline__ void ld_b32(B32In& in, const LAS unsigned char* kb, const int (&koffL)[4], const LAS float* brow) {
#pragma unroll
    for (int ds = 0; ds < 4; ++ds) in.kf[ds] = *(const LAS bf16x8*)(kb + koffL[ds]);
#pragma unroll
    for (int r = 0; r < 16; ++r) in.bv[r] = brow[(r & 3) + 8 * (r >> 2)];
}
template <bool PRE>
__device__ __forceinline__ void tile32_b_fast_core(WaveCtx& c, const B32In& in, B32In& nx, const LAS unsigned char* knb, const int (&koffL)[4], const LAS float* nbrow, const LAS unsigned char* vb, bool rowok, int kstart, int wst, int h) {
    f32x16 p0;
#pragma unroll
    for (int r = 0; r < 16; ++r) p0[r] = 0.f;
#pragma unroll
    for (int ds = 0; ds < 4; ++ds) p0 = __builtin_amdgcn_mfma_f32_32x32x16_bf16(in.kf[ds], c.qf[ds], p0, 0, 0, 0);
    VFrag f0; load_v32(c, f0, vb);
    if (PRE) ld_b32(nx, knb, koffL, nbrow);
    float ls = 0.f;
#pragma unroll
    for (int r = 0; r < 16; ++r) { const int kc = kstart + (r & 3) + 8 * (r >> 2) + 4 * h; const float sv = (rowok && kc >= wst && kc < wst + 16) ? p0[r] + in.bv[r] : NEG; p0[r] = __builtin_amdgcn_exp2f(sv); ls += p0[r]; }
    c.l += ls;
    pv32(c, p0, f0);
}
__device__ __forceinline__ void ldk32(bf16x8 (&kf)[4], const LAS unsigned char* kb, const int (&koffL)[4]) {
#pragma unroll
    for (int ds = 0; ds < 4; ++ds) kf[ds] = *(const LAS bf16x8*)(kb + koffL[ds]);
}
__device__ __forceinline__ void ldbias(float (&bv)[16], const LAS float* brow) {
#pragma unroll
    for (int r = 0; r < 16; ++r) bv[r] = brow[(r & 3) + 8 * (r >> 2)];
}
template <bool PRE>
__device__ __forceinline__ void tile32_b_fast_core(WaveCtx& c, const bf16x8 (&kf)[4], const float (&bv)[16], bf16x8 (&kn)[4], float (&bvn)[16], const LAS unsigned char* knb, const LAS float* nbrow, const int (&koffL)[4], const LAS unsigned char* vb, bool rowok, int kstart, int wst, int h) {
    f32x16 p0;
#pragma unroll
    for (int r = 0; r < 16; ++r) { const int kc = kstart + (r & 3) + 8 * (r >> 2) + 4 * h; p0[r] = (rowok && kc >= wst && kc < wst + 16) ? bv[r] : NEG; }
#pragma unroll
    for (int ds = 0; ds < 4; ++ds) p0 = __builtin_amdgcn_mfma_f32_32x32x16_bf16(kf[ds], c.qf[ds], p0, 0, 0, 0);
    VFrag f0; load_v32(c, f0, vb);
    if (PRE) { ldk32(kn, knb, koffL); ldbias(bvn, nbrow); }
    float ls = 0.f;
#pragma unroll
    for (int r = 0; r < 16; ++r) { p0[r] = __builtin_amdgcn_exp2f(p0[r]); ls += p0[r]; }
    c.l += ls;
    pv32(c, p0, f0);
}
__device__ __forceinline__ void tile32_b(WaveCtx& c, const LAS unsigned char* kb, const int (&koffL)[4], const LAS unsigned char* vb, const LAS float* brow, bool rowok, int kstart, int wst, int h) {
    bf16x8 kf[4];
#pragma unroll
    for (int ds = 0; ds < 4; ++ds) kf[ds] = *(const LAS bf16x8*)(kb + koffL[ds]);
    float bv[16];
#pragma unroll
    for (int r = 0; r < 16; ++r) bv[r] = brow[(r & 3) + 8 * (r >> 2)];
    ATT_SB();
    f32x16 p0 = __builtin_amdgcn_mfma_f32_32x32x16_bf16(kf[0], c.qf[0], c.negm, 0, 0, 0);
#pragma unroll
    for (int ds = 1; ds < 4; ++ds) p0 = __builtin_amdgcn_mfma_f32_32x32x16_bf16(kf[ds], c.qf[ds], p0, 0, 0, 0);
    VFrag f0; load_v32(c, f0, vb);
    ATT_SB();
    asm volatile("s_nop 15\n\ts_nop 7" : "+v"(p0));
#pragma unroll
    for (int r = 0; r < 16; ++r) { const int kc = kstart + (r & 3) + 8 * (r >> 2) + 4 * h; p0[r] = (rowok && kc >= wst && kc < wst + 16) ? p0[r] + bv[r] : NEG; }
    float ma = max3f(p0[0], p0[1], p0[2]), mb = max3f(p0[3], p0[4], p0[5]);
    ma = max3f(ma, p0[6], p0[7]); mb = max3f(mb, p0[8], p0[9]); ma = max3f(ma, p0[10], p0[11]); mb = max3f(mb, p0[12], p0[13]); ma = max3f(ma, p0[14], p0[15]);
    float dl;
    if (update_ref(c, max2f(ma, mb), dl)) {
#pragma unroll
        for (int r = 0; r < 16; ++r) p0[r] -= dl; }
    float ls = 0.f;
#pragma unroll
    for (int r = 0; r < 16; ++r) { p0[r] = __builtin_amdgcn_exp2f(p0[r]); ls += p0[r]; }
    c.l += ls;
    pv32(c, p0, f0);
}
__device__ __forceinline__ void wave_store(const WaveCtx& c, int lane, bf16* orow  ) {
    const int h = lane >> 5;
    const float lt = c.l + __shfl_xor(c.l, 32), rl = (FP8_O ? O8_SCALE : 1.0f) / lt;
    if (FP8_O) {
#pragma unroll
        for (int db = 0; db < 2; ++db) {
            unsigned d[4];
#pragma unroll
            for (int g = 0; g < 4; ++g) { int w = 0; w = __builtin_amdgcn_cvt_pk_fp8_f32(c.o[db][4 * g] * rl, c.o[db][4 * g + 1] * rl, w, false); w = __builtin_amdgcn_cvt_pk_fp8_f32(c.o[db][4 * g + 2] * rl, c.o[db][4 * g + 3] * rl, w, true); d[g] = (unsigned)w; }
            { auto r = __builtin_amdgcn_permlane32_swap(d[0], d[1], false, false); d[0] = r[0]; d[1] = r[1]; }
            { auto r = __builtin_amdgcn_permlane32_swap(d[2], d[3], false, false); d[2] = r[0]; d[3] = r[1]; }
            { auto r = __builtin_amdgcn_permlane32_swap(d[0], d[2], false, false); d[0] = r[0]; d[2] = r[1]; }
            { auto r = __builtin_amdgcn_permlane32_swap(d[1], d[3], false, false); d[1] = r[0]; d[3] = r[1]; }
            u32x4 w; w.x = d[0]; w.y = d[1]; w.z = d[2]; w.w = d[3];
            *(u32x4*)((unsigned char*)orow + 32 * db + 16 * h) = w;
        }
    } else {
#pragma unroll
        for (int db = 0; db < 2; ++db)
#pragma unroll
            for (int g = 0; g < 4; ++g) { u32x2 w; w.x = cvtpk(c.o[db][4 * g] * rl, c.o[db][4 * g + 1] * rl); w.y = cvtpk(c.o[db][4 * g + 2] * rl, c.o[db][4 * g + 3] * rl);
                *(u32x2*)(orow + 32 * db + 8 * g + 4 * h) = w; }
    }
}
__device__ __forceinline__ void stage_q(LAS unsigned char* qbox, const bf16* qbase, unsigned qoff) {
    const unsigned qd = (unsigned)__builtin_amdgcn_readfirstlane((int)(unsigned)(uintptr_t)qbox);
    ATT_GLDS(qoff, qbase, qd, 0); ATT_GLDS(qoff, qbase + 16, qd + 1024u, 0); ATT_GLDS(qoff, qbase + 32, qd + 2048u, 0); ATT_GLDS(qoff, qbase + 48, qd + 3072u, 0);
}
__device__ __forceinline__ void read_q(bf16x8 (&qf)[4], const LAS unsigned char* qbox, int lane) {
#pragma unroll
    for (int ds = 0; ds < 4; ++ds) qf[ds] = *(const LAS bf16x8*)(qbox + ds * 1024 + lane * 16);
}
__device__ __forceinline__ void wave_pack(const WaveCtx& c, u32x4 (&w)[2]) {
    const float lt = c.l + __shfl_xor(c.l, 32), rl = O8_SCALE / lt;
#pragma unroll
    for (int db = 0; db < 2; ++db) {
        unsigned d[4];
#pragma unroll
        for (int g = 0; g < 4; ++g) { int t = 0; t = __builtin_amdgcn_cvt_pk_fp8_f32(c.o[db][4 * g] * rl, c.o[db][4 * g + 1] * rl, t, false); t = __builtin_amdgcn_cvt_pk_fp8_f32(c.o[db][4 * g + 2] * rl, c.o[db][4 * g + 3] * rl, t, true); d[g] = (unsigned)t; }
        { auto r = __builtin_amdgcn_permlane32_swap(d[0], d[1], false, false); d[0] = r[0]; d[1] = r[1]; }
        { auto r = __builtin_amdgcn_permlane32_swap(d[2], d[3], false, false); d[2] = r[0]; d[3] = r[1]; }
        { auto r = __builtin_amdgcn_permlane32_swap(d[0], d[2], false, false); d[0] = r[0]; d[2] = r[1]; }
        { auto r = __builtin_amdgcn_permlane32_swap(d[1], d[3], false, false); d[1] = r[0]; d[3] = r[1]; }
        w[db].x = d[0]; w[db].y = d[1]; w[db].z = d[2]; w[db].w = d[3];
    }
}
#define ATT_WAIT_BAR() do { asm volatile("s_waitcnt vmcnt(0)" ::: "memory"); __syncthreads(); } while (0)

struct UnitA { int b, kvh, Q0, qrow0, nl, tl0, nt; };
__device__ __forceinline__ UnitA decode_a(int u) {
    UnitA d;
    if (u < 2048) { d.b = u >> 9; d.kvh = (u >> 7) & 3; d.Q0 = (u & 127) * 64; d.qrow0 = d.b * S + d.Q0;
        d.tl0 = d.Q0 >= 128 ? 0 : (128 - d.Q0) / 64; const int t1 = (S + 64 - d.Q0) / 64; d.nl = (t1 < 4 ? t1 : 4) - d.tl0 + 1; }
    else { const int v = u - 2048; d.b = v >> 4; d.kvh = (v >> 2) & 3; d.Q0 = 0; d.qrow0 = NLAT + d.b * CTX + (v & 3) * 64; d.nl = 0; d.tl0 = 0; }
    d.nt = d.nl + 4; return d;
}
__device__ __forceinline__ int rowbase_a(const UnitA& d, int j) { return j < d.nl ? d.b * S + d.Q0 - 128 + 64 * (d.tl0 + j) : NLAT + d.b * CTX + 64 * (j - d.nl); }
__device__ __forceinline__ void stage_step_a(LAS unsigned char* lds, const UnitA& d, int s, int buf, const bf16* Kt, const bf16* Vt, const StageOff& so, int wave) {
#pragma unroll
    for (int sub = 0; sub < 2; ++sub) { const int j = 2 * s + sub; if (j < d.nt) { const size_t o = (size_t)rowbase_a(d, j) * 256 + d.kvh * 64; stage_tile(lds, buf * 2 + sub, Kt + o, Vt + o, so, wave); } }
}
__device__ __forceinline__ void qk64(const WaveCtx& c, const bf16x8 (&kf)[8], f32x16& p0, f32x16& p1) {
#pragma unroll
    for (int r = 0; r < 16; ++r) { p0[r] = 0.f; p1[r] = 0.f; }
#pragma unroll
    for (int ds = 0; ds < 4; ++ds) { p0 = __builtin_amdgcn_mfma_f32_32x32x16_bf16(kf[2 * ds], c.qf[ds], p0, 0, 0, 0); p1 = __builtin_amdgcn_mfma_f32_32x32x16_bf16(kf[2 * ds + 1], c.qf[ds], p1, 0, 0, 0); }
}
template <int MASK>
__device__ __forceinline__ void sm_pv64(WaveCtx& c, f32x16& p0, f32x16& p1, const LAS unsigned char* vb, int qq, int h) {
    VFrag f0; load_v32(c, f0, vb);
    if (MASK == 1) {
#pragma unroll
        for (int r = 0; r < 16; ++r) { const int kk = crow(r, h); if (kk < qq) p0[r] = NEG; if (kk + 32 < qq) p1[r] = NEG; } }
    if (MASK == 2) {
#pragma unroll
        for (int r = 0; r < 16; ++r) { const int kk = crow(r, h); if (kk > qq) p0[r] = NEG; if (kk + 32 > qq) p1[r] = NEG; } }
    float ls = 0.f;
#pragma unroll
    for (int r = 0; r < 16; ++r) { p0[r] = __builtin_amdgcn_exp2f(p0[r]); p1[r] = __builtin_amdgcn_exp2f(p1[r]); ls += p0[r] + p1[r]; }
    c.l += ls;
    VFrag f1; load_v32(c, f1, vb + 4096);
    pv32(c, p0, f0); pv32(c, p1, f1);
}
__device__ __forceinline__ LAS unsigned char* ringk(LAS unsigned char* lds, int r) { return lds + (r < 4 ? 65536 + r * TILEB : 135168); }
__device__ __forceinline__ LAS unsigned char* ringv(LAS unsigned char* lds, int r) { return lds + (r < 4 ? 98304 + r * TILEB : 143360); }
template <bool FAST>
__device__ __forceinline__ void attn_a_impl(LAS unsigned char* lds, int u0, int ucount, int uextra, const bf16* Q, const bf16* Kt, const bf16* Vt, bf16* O, const float* sink, const float* qgain, const float* kgain, const int kwave) {
    const int tid = TIDX, lane = tid & 63, wave = __builtin_amdgcn_readfirstlane(tid >> 6);
    const int g = wave >> 1, qs = wave & 1, h = lane >> 5, qq = 32 * qs + (lane & 31);
    const int ntot = ucount + (uextra >= 0 ? 1 : 0);
    if (ntot == 0) return;
    WaveCtx c; wave_offsets(c, lane, 0);
    const StageOff so = stage_off(tid, 256);
    const UnitA first = decode_a(ucount > 0 ? u0 : uextra);
    const int b = first.b, kvh = first.kvh, qb0 = first.Q0 >> 6;
    const bf16* Kl = Kt + (size_t)(b * S) * 256 + kvh * 64; const bf16* Vl = Vt + (size_t)(b * S) * 256 + kvh * 64;
    const bf16* Kc = Kt + (size_t)(NLAT + b * CTX) * 256 + kvh * 64; const bf16* Vc = Vt + (size_t)(NLAT + b * CTX) * 256 + kvh * 64;
#pragma unroll
    for (int i = 0; i < 4; ++i) stage_tile_at(lds + i * TILEB, lds + 32768 + i * TILEB, Kc + (size_t)(64 * i) * 256, Vc + (size_t)(64 * i) * 256, so, wave);
    if (ucount > 0) for (int kt = qb0 - 2; kt <= qb0 + 2; ++kt) if (kt >= 0 && kt < S / 64) stage_tile_at(ringk(lds, kt % 5), ringv(lds, kt % 5), Kl + (size_t)(64 * kt) * 256, Vl + (size_t)(64 * kt) * 256, so, wave);
    bf16x8 qn[4]; load_q(qn, lane, Q + (size_t)(first.qrow0 + qq) * 1024 + (kvh * 4 + g) * 64);
    u32x4 pend[2]; unsigned pend_off = 0u;
    ATT_WAIT_BAR();
    for (int ui = 0; ui < ntot; ++ui) {
        const bool lat = ui < ucount, has_next = ui + 1 < ntot;
        const UnitA cur = decode_a(lat ? u0 + ui : uextra);
        const UnitA nxt = decode_a(has_next ? (ui + 1 < ucount ? u0 + ui + 1 : uextra) : (lat ? u0 + ui : uextra));
        const int head = kvh * 4 + g, qb = cur.Q0 >> 6;
#pragma unroll
        for (int ds = 0; ds < 4; ++ds) c.qf[ds] = qn[ds];
        if (FP8_O && ui > 0) { *(u32x4*)((unsigned char*)O + pend_off) = pend[0]; *(u32x4*)((unsigned char*)O + pend_off + 32u) = pend[1]; }
        if (FAST) wave_reset(c, lane, 0.0f, __builtin_amdgcn_exp2f(sink[head] * LOG2E), false); else wave_reset(c, lane, sink[head] * LOG2E, 1.0f);
#define ATT_A_VALID(t) ((t) >= 4 || (lat && qb - 2 + (t) >= 0 && qb - 2 + (t) < S / 64))
#define ATT_A_KB(t) ((t) >= 4 ? lds + ((t) - 4) * TILEB : ringk(lds, (qb + 3 + (t)) % 5))
#define ATT_A_VB(t) ((t) >= 4 ? lds + 32768 + ((t) - 4) * TILEB : ringv(lds, (qb + 3 + (t)) % 5))
        const bool interior = FAST && lat && qb >= 2 && qb + 2 < S / 64;
        if (interior) {
            const int r0 = (qb + 3) % 5;
#define ATT_I_SLOT(i) (r0 + (i) >= 5 ? r0 + (i) - 5 : r0 + (i))
#define ATT_I_KB(i) ((i) < 5 ? ringk(lds, ATT_I_SLOT(i)) : lds + ((i) - 5) * TILEB)
#define ATT_I_VB(i) ((i) < 5 ? ringv(lds, ATT_I_SLOT(i)) : lds + 32768 + ((i) - 5) * TILEB)
#define ATT_I_ITER(i, P0, P1, N0, N1, MSK) do { \
                if ((i) == 2) { ATT_WAIT_BAR(); \
                    if (has_next && ui + 1 < ucount) { const int kt = qb + 3; if (kt < S / 64) stage_tile_at(ringk(lds, kt % 5), ringv(lds, kt % 5), Kl + (size_t)(64 * kt) * 256, Vl + (size_t)(64 * kt) * 256, so, wave); } \
                    } \
                if ((i) == 7) load_q(qn, lane, Q + (size_t)(nxt.qrow0 + qq) * 1024 + (kvh * 4 + g) * 64); \
                if ((i) < 8) qk64(c, kf, N0, N1); \
                if ((i) < 7) ldk64(kf, c, ATT_I_KB((i) + 2)); \
                sm_pv64<MSK>(c, P0, P1, ATT_I_VB(i), qq, h); ATT_SB(); } while (0)
            bf16x8 kf[8]; f32x16 pa0, pa1, pb0, pb1;
            ldk64(kf, c, ATT_I_KB(0)); qk64(c, kf, pa0, pa1); ldk64(kf, c, ATT_I_KB(1));
            ATT_I_ITER(0, pa0, pa1, pb0, pb1, 1); ATT_I_ITER(1, pb0, pb1, pa0, pa1, 0); ATT_I_ITER(2, pa0, pa1, pb0, pb1, 0); ATT_I_ITER(3, pb0, pb1, pa0, pa1, 0); ATT_I_ITER(4, pa0, pa1, pb0, pb1, 2);
            ATT_I_ITER(5, pb0, pb1, pa0, pa1, 0); ATT_I_ITER(6, pa0, pa1, pb0, pb1, 0); ATT_I_ITER(7, pb0, pb1, pa0, pa1, 0); ATT_I_ITER(8, pa0, pa1, pb0, pb1, 0);
        } else {
        if (FAST) {
            bf16x8 kfa[8], kfb[8];
            ldk64(kfa, c, ATT_A_KB(0));
#pragma nounroll
            for (int tp = 0; tp < 4; ++tp) {
                const int t0 = 2 * tp, t1 = t0 + 1, t2 = (t0 + 2) & 7;
                if (ATT_A_VALID(t0)) tile64_fast_core<true>(c, kfa, kfb, ATT_A_KB(t1), ATT_A_VB(t0), qq, h, t0 == 0 ? 1 : 0); else ldk64(kfb, c, ATT_A_KB(t1));
                if (ATT_A_VALID(t1)) tile64_fast_core<true>(c, kfb, kfa, ATT_A_KB(t2), ATT_A_VB(t1), qq, h, 0); else ldk64(kfa, c, ATT_A_KB(t2));
            }
        } else {
            for (int t = 0; t < 8; ++t) if (ATT_A_VALID(t)) tile64(c, ATT_A_KB(t), ATT_A_VB(t), qq, h, t == 0 ? 1 : 0);
        }
        ATT_WAIT_BAR();
        if (has_next && ui + 1 < ucount) { const int kt = qb + 3; if (kt < S / 64) stage_tile_at(ringk(lds, kt % 5), ringv(lds, kt % 5), Kl + (size_t)(64 * kt) * 256, Vl + (size_t)(64 * kt) * 256, so, wave); }
        load_q(qn, lane, Q + (size_t)(nxt.qrow0 + qq) * 1024 + (kvh * 4 + g) * 64);
        if (lat && qb + 2 < S / 64) {
            if (FAST) { bf16x8 kfa[8], kfb[8]; ldk64(kfa, c, ringk(lds, (qb + 2) % 5)); ATT_SB(); tile64_fast_core<false>(c, kfa, kfb, lds, ringv(lds, (qb + 2) % 5), qq, h, 2); }
            else tile64(c, ringk(lds, (qb + 2) % 5), ringv(lds, (qb + 2) % 5), qq, h, 2);
        }
        }
        if (FP8_O) { wave_pack(c, pend); pend_off = (unsigned)((cur.qrow0 + qq) * 1024 + head * 64 + 16 * h); }
        else wave_store(c, lane, O + (size_t)(cur.qrow0 + qq) * 1024 + head * 64);
    }
    if (FP8_O) { *(u32x4*)((unsigned char*)O + pend_off) = pend[0]; *(u32x4*)((unsigned char*)O + pend_off + 32u) = pend[1]; }
    __syncthreads();
}
__device__ __forceinline__ void attn_a_phase(LAS unsigned char* lds, int u0, int ucount, int uextra, const bf16* Q, const bf16* Kt, const bf16* Vt, bf16* O, const float* sink, const float* qgain, const float* kgain, const int kwave) {
    const int lane = TIDX & 63;
    const float gqm = wave_max(fabsf(qgain[lane])), gkm = wave_max(fabsf(kgain[lane])), skm = wave_max(fabsf(sink[lane & 15]));
    const bool fast = (64.0f * QSCALE * gqm * gkm <= ATT_FAST_BOUND) && (skm * LOG2E <= ATT_FAST_BOUND);
    if (fast) attn_a_impl<true>(lds, u0, ucount, uextra, Q, Kt, Vt, O, sink, qgain, kgain, kwave);
    else attn_a_impl<false>(lds, u0, ucount, uextra, Q, Kt, Vt, O, sink, qgain, kgain, kwave);
}
struct UnitB { int b, head, r0, klo, nt; };
__device__ __forceinline__ UnitB decode_b(int u) {
    UnitB d; d.b = u >> 9; d.head = (u >> 5) & 15; d.r0 = (u & 31) * 4;
    d.klo = min(max(d.r0 - 4, 0), 120); const int khi = min(max(d.r0 - 1, 0), 120) + 7; d.nt = 4 + (khi - d.klo + 1); return d;
}
__device__ __forceinline__ int rowbase_b(const UnitB& d, int j) { return j < 4 ? NLAT + d.b * CTX + 64 * j : d.b * S + (d.klo + j - 4) * 64; }
__device__ __forceinline__ void stage_step_b(LAS unsigned char* lds, const UnitB& d, int s, int buf, const bf16* Kt, const bf16* Vt, const StageOff& so, int wave) {
#pragma unroll
    for (int sub = 0; sub < 2; ++sub) { const int j = 2 * s + sub; if (j < d.nt) { const size_t o = (size_t)rowbase_b(d, j) * 1024 + d.head * 64; stage_tile(lds, buf * 2 + sub, Kt + o, Vt + o, so, wave); } }
}
template <bool FAST>
__device__ __forceinline__ void attn_b_impl(LAS unsigned char* lds, int u0, int ucount, const bf16* Q, const bf16* Kt, const bf16* Vt, bf16* O, const float* rpb, const float* qgain, const float* kgain, const int kwave) {
    const int tid = TIDX, lane = tid & 63, wave = __builtin_amdgcn_readfirstlane(tid >> 6);
    if (ucount <= 0) return;
    const int jb = wave & 3, rp = wave >> 2, h = lane >> 5, q31 = lane & 31;
    const int kstart = jb == 0 ? 0 : (jb == 1 ? 8 : (jb == 2 ? 24 : 32));
    const int qc = 16 * jb + (q31 & 15), wst = min(max(qc - 8, 0), 48);
    UnitB cur = decode_b(u0);
    LAS float* bt = (LAS float*)(lds + OFF_BIAS) + BIAS_PITCH;
    for (int i = tid; i < 15 * 31; i += NTHREADS) { const int dr = i / 31, dc = i - dr * 31; bt[dr * BIAS_PITCH + BIAS_ORG + dc] = rpb[(cur.head * 15 + dr) * 31 + dc] * LOG2E; }
    WaveCtx c; wave_offsets(c, lane, 0);
    LAS unsigned char* qbox = lds + OFF_QBOX + wave * 4096;
    int koffL[4];
    { const int row = kstart + q31;
#pragma unroll
      for (int ds = 0; ds < 4; ++ds) koffL[ds] = row * 128 + (((2 * ds + h) ^ ((row >> 1) & 7)) << 4); }
    const StageOff so = stage_off(tid, 1024); const unsigned qoff = (unsigned)(((2 * rp + (q31 >> 4)) * 64 + qc) * 1024 + 8 * h) * 2u;
    int gs = 0;
    stage_step_b(lds, cur, 0, 0, Kt, Vt, so, wave);
    stage_q(qbox, Q + (size_t)(cur.b * S + cur.r0 * 64) * 1024 + cur.head * 64, qoff);
    u32x4 pend[2]; unsigned pend_off = 0u;
    ATT_WAIT_BAR();
    for (int ui = 0; ui < ucount; ++ui) {
        const bool has_next = ui + 1 < ucount;
        const UnitB nxt = decode_b(has_next ? u0 + ui + 1 : u0);
        const int nsteps = (cur.nt + 1) >> 1;
        const int qrow = cur.r0 + 2 * rp + (q31 >> 4);
        const int rsq = min(max(qrow - 4, 0), 120);
        const int rs_a = min(max(cur.r0 + 2 * rp - 4, 0), 120), rs_b = min(max(cur.r0 + 2 * rp + 1 - 4, 0), 120);
        read_q(c.qf, qbox, lane);
        if (FP8_O && ui > 0) { *(u32x4*)((unsigned char*)O + pend_off) = pend[0]; *(u32x4*)((unsigned char*)O + pend_off + 32u) = pend[1]; }
        wave_reset(c, lane, 0.0f, 0.0f, !FAST);
        for (int s = 0; s < 2; ++s) {
            if (FAST) {
                const int slot = (gs & 1) * 2;
                bf16x8 kfa[8], kfb[8];
                ldk64(kfa, c, lds + OFF_K + slot * TILEB);
                stage_step_b(lds, cur, s + 1, (gs + 1) & 1, Kt, Vt, so, wave);
                ATT_SB();
                tile64_fast_core<true>(c, kfa, kfb, lds + OFF_K + (slot + 1) * TILEB, lds + OFF_V + slot * TILEB, 0, h, 0);
                tile64_fast_core<false>(c, kfb, kfa, lds, lds + OFF_V + (slot + 1) * TILEB, 0, h, 0);
            } else {
                stage_step_b(lds, cur, s + 1, (gs + 1) & 1, Kt, Vt, so, wave);
#pragma unroll
                for (int sub = 0; sub < 2; ++sub) { const int slot = (gs & 1) * 2 + sub; tile64(c, lds + OFF_K + slot * TILEB, lds + OFF_V + slot * TILEB, 0, h, 0); }
            }
            ++gs;
            ATT_WAIT_BAR();
        }
        for (int s = 2; s < nsteps; ++s) {
            if (FAST) {
                const int slot = (gs & 1) * 2, kra = cur.klo + 2 * s - 4, krb = kra + 1;
                const bool acta = kra >= rs_a && kra <= rs_b + 7, actb = (2 * s + 1 < cur.nt) && krb >= rs_a && krb <= rs_b + 7;
                const LAS float* browa = bt + (kra - qrow + 7) * BIAS_PITCH + BIAS_ORG + 15 - qc + kstart + 4 * h;
                bf16x8 kfa[4], kfb[4]; float bva[16], bvb[16];
                if (s + 1 < nsteps) stage_step_b(lds, cur, s + 1, (gs + 1) & 1, Kt, Vt, so, wave);
                else if (has_next) { stage_step_b(lds, nxt, 0, (gs + 1) & 1, Kt, Vt, so, wave); stage_q(qbox, Q + (size_t)(nxt.b * S + nxt.r0 * 64) * 1024 + nxt.head * 64, qoff); }
                if (acta) {
                    ldk32(kfa, lds + OFF_K + slot * TILEB, koffL); ldbias(bva, browa);
                    ATT_SB();
                    tile32_b_fast_core<true>(c, kfa, bva, kfb, bvb, lds + OFF_K + (slot + 1) * TILEB, browa + BIAS_PITCH, koffL, lds + OFF_V + slot * TILEB + kstart * 128, kra >= rsq && kra <= rsq + 7, kstart, wst, h);
                } else if (actb) { ldk32(kfb, lds + OFF_K + (slot + 1) * TILEB, koffL); ldbias(bvb, browa + BIAS_PITCH); }
                if (actb) tile32_b_fast_core<false>(c, kfb, bvb, kfa, bva, lds, browa, koffL, lds + OFF_V + (slot + 1) * TILEB + kstart * 128, krb >= rsq && krb <= rsq + 7, kstart, wst, h);
            } else {
                if (s + 1 < nsteps) stage_step_b(lds, cur, s + 1, (gs + 1) & 1, Kt, Vt, so, wave);
                else if (has_next) { stage_step_b(lds, nxt, 0, (gs + 1) & 1, Kt, Vt, so, wave); stage_q(qbox, Q + (size_t)(nxt.b * S + nxt.r0 * 64) * 1024 + nxt.head * 64, qoff); }
#pragma unroll
                for (int sub = 0; sub < 2; ++sub) {
                    const int j = 2 * s + sub, kr = cur.klo + j - 4;
                    if (j < cur.nt && kr >= rs_a && kr <= rs_b + 7) {
                        const int slot = (gs & 1) * 2 + sub;
                        const bool rowok = kr >= rsq && kr <= rsq + 7;
                        const LAS float* brow = bt + (kr - qrow + 7) * BIAS_PITCH + BIAS_ORG + 15 - qc + kstart + 4 * h;
                        tile32_b(c, lds + OFF_K + slot * TILEB, koffL, lds + OFF_V + slot * TILEB + kstart * 128, brow, rowok, kstart, wst, h);
                    }
                }
            }
            ++gs;
            ATT_WAIT_BAR();
        }
        if (FP8_O) { wave_pack(c, pend); pend_off = (unsigned)((cur.b * S + qrow * 64 + qc) * 1024 + cur.head * 64 + 16 * h); }
        else wave_store(c, lane, O + (size_t)(cur.b * S + qrow * 64 + qc) * 1024 + cur.head * 64);
        cur = nxt;
    }
    if (FP8_O) { *(u32x4*)((unsigned char*)O + pend_off) = pend[0]; *(u32x4*)((unsigned char*)O + pend_off + 32u) = pend[1]; }
    __syncthreads();
}
__device__ __forceinline__ void attn_b_phase(LAS unsigned char* lds, int u0, int ucount, const bf16* Q, const bf16* Kt, const bf16* Vt, bf16* O, const float* rpb, const float* qgain, const float* kgain, const int kwave) {
    const int lane = TIDX & 63;
    float bmx = 0.f;
    {
        const f32x4* r4 = (const f32x4*)rpb; f32x4 bv[30];
#pragma unroll
        for (int k = 0; k < 30; ++k) { const int i = lane + 64 * k; bv[k] = r4[i < 1860 ? i : 1859]; }
#pragma unroll
        for (int k = 0; k < 30; ++k) bmx = fmaxf(fmaxf(bmx, fmaxf(fabsf(bv[k][0]), fabsf(bv[k][1]))), fmaxf(fabsf(bv[k][2]), fabsf(bv[k][3])));
    }
    const float gqm = wave_max(fabsf(qgain[lane])), gkm = wave_max(fabsf(kgain[lane]));
    const bool fast = 64.0f * QSCALE * gqm * gkm + wave_max(bmx) * LOG2E <= ATT_FAST_BOUND;
    if (fast) attn_b_impl<true>(lds, u0, ucount, Q, Kt, Vt, O, rpb, qgain, kgain, kwave);
    else attn_b_impl<false>(lds, u0, ucount, Q, Kt, Vt, O, rpb, qgain, kgain, kwave);
}
}


typedef __attribute__((address_space(1))) unsigned gu32;
#define XB_TMO      128
#define XB_XCNT(j)  (256  + 64 * (j))
#define XB_XSUB(j)  (1280 + 64 * (j))
#define XB_XGEN(j)  (2304 + 64 * (j))
#define XB_TOP      3328
#define XB_TOPGEN   3392
#define XCD_BAR_WORDS 3456
#define XB_SPIN_CAP (1u << 20)
__device__ __forceinline__ unsigned xb_ld(unsigned* p)              { return __hip_atomic_load(p, __ATOMIC_RELAXED, __HIP_MEMORY_SCOPE_AGENT); }
__device__ __forceinline__ unsigned xb_add(unsigned* p, unsigned v) { return __hip_atomic_fetch_add(p, v, __ATOMIC_RELAXED, __HIP_MEMORY_SCOPE_AGENT); }
__device__ __forceinline__ unsigned xb_xcc_id() { return (unsigned)__builtin_amdgcn_s_getreg((3 << 11) | 20) & 0xFu; }
#define XB_SPIN(cond, bar) do { unsigned _sp = 0; while (cond) { __builtin_amdgcn_s_sleep(1); \
    if ((++_sp & 255u) == 0u) { if (xb_ld(&(bar)[XB_TMO])) break; if (_sp > XB_SPIN_CAP) { atomicAdd(&(bar)[XB_TMO], 1u); break; } } } } while (0)
struct XcdBarrier { unsigned* bar; unsigned x; volatile LAS unsigned* st; };
__device__ __forceinline__ XcdBarrier xcd_barrier_post(unsigned* bar, volatile LAS unsigned* st, const int kwave) {
    XcdBarrier b; b.bar = bar; b.x = xb_xcc_id(); b.st = st;
    if (TIDX == 0) (void)xb_add(&bar[XB_XCNT(b.x)], 1u);
    return b;
}
__device__ __forceinline__ void xcd_barrier_complete(unsigned* bar, unsigned x, unsigned& nloc, unsigned& nx) {
    const unsigned G = gridDim.x * gridDim.y * gridDim.z;
    unsigned sum, cnt, mine, sp = 0u;
    for (;;) {
        sum = 0u; cnt = 0u; mine = 0u;
#pragma unroll
        for (unsigned j = 0; j < 16; ++j) { const unsigned c = xb_ld(&bar[XB_XCNT(j)]); sum += c; cnt += (c > 0u) ? 1u : 0u; mine = (j == x) ? c : mine; }
        if (sum == G) break;
        __builtin_amdgcn_s_sleep(1);
        if ((++sp & 255u) == 0u) { if (xb_ld(&bar[XB_TMO])) break; if (sp > XB_SPIN_CAP) { atomicAdd(&bar[XB_TMO], 1u); break; } }
    }
    nloc = mine > 0u ? mine : 1u; nx = cnt > 0u ? cnt : 1u;
}
__device__ __forceinline__ void xcd_barrier(const XcdBarrier& b, const int kwave) {
    asm volatile("s_waitcnt vmcnt(0)" ::: "memory");
    __syncthreads();
    if (TIDX == 0) {
        unsigned* bar = b.bar;
        __builtin_amdgcn_s_waitcnt(0);
        unsigned nloc = b.st[0], nx = b.st[1];
        if (nloc == 0u) { xcd_barrier_complete(bar, b.x, nloc, nx); b.st[0] = nloc; b.st[1] = nx; }
        const unsigned old = xb_add(&bar[XB_XSUB(b.x)], 1u);
        const unsigned gen = old / nloc;
        if (old + 1u == (gen + 1u) * nloc) {
            __builtin_amdgcn_fence(__ATOMIC_RELEASE, "agent");
            asm volatile("s_waitcnt vmcnt(0)" ::: "memory");
            const unsigned og = xb_add(&bar[XB_TOP], 1u);
            const unsigned tg = og / nx;
            if (og + 1u == (tg + 1u) * nx) xb_add(&bar[XB_TOPGEN], 1u);
            else XB_SPIN(xb_ld(&bar[XB_TOPGEN]) == tg, bar);
            __builtin_amdgcn_fence(__ATOMIC_ACQUIRE, "agent");
            xb_add(&bar[XB_XGEN(b.x)], 1u);
            asm volatile("s_waitcnt vmcnt(0)" ::: "memory");
        } else {
            XB_SPIN(xb_ld(&bar[XB_XGEN(b.x)]) == gen, bar);
            __builtin_amdgcn_fence(__ATOMIC_ACQUIRE, "agent");
            asm volatile("s_waitcnt vmcnt(0)" ::: "memory");
        }
    }
    __syncthreads();
}

constexpr int CI_QA = 16 * 48, CI_O = FP8_O ? 8 * 32 : 16 * 32, CI_QB = 16 * 96, WD_IPE = FP8_DOWN ? 512 : 1024  , CI_WD = 16 * WD_IPE, GU_IPM = FP8_GU ? 512 : 1024  , CI_WGU = 32 * GU_IPM;
constexpr int CS0 = 0, CS1 = CS0 + CI_QA + CI_O, CS2 = CS1 + CI_WD, CS3 = CS2 + CI_WGU, CS4 = CS3 + CI_QB + CI_O, CS5 = CS4 + CI_WGU, CS_END = CS5 + CI_WD;
__device__ __forceinline__ void conv_load8(const ConvJob& j, f32x4 (&v)[16], int lane) {
    const int nblk = j.N / 32, kb = j.item / nblk, nbk = j.item % nblk, k0 = 128 * kb, n0 = 32 * nbk;
    const int nq = lane & 7, kg = lane >> 3;
#pragma unroll
    for (int i = 0; i < 16; ++i) v[i] = __builtin_nontemporal_load((const f32x4*)(j.W + (size_t)(k0 + 16 * kg + i) * j.N + n0 + 4 * nq));
}
__device__ __forceinline__ void conv_store8(const ConvJob& j, const f32x4 (&v)[16], int lane) {
    const int nblk = j.N / 32, kb = j.item / nblk, nbk = j.item % nblk, k0 = 128 * kb, n0 = 32 * nbk;
    const int nq = lane & 7, kg = lane >> 3;
    unsigned char* Wt8 = (unsigned char*)j.Wt;
#pragma unroll
    for (int c = 0; c < 4; ++c) {
        u32x4 o;
#pragma unroll
        for (int q = 0; q < 4; ++q) { int w = 0; w = __builtin_amdgcn_cvt_pk_fp8_f32(v[4 * q][c] * W8_SCALE, v[4 * q + 1][c] * W8_SCALE, w, false); w = __builtin_amdgcn_cvt_pk_fp8_f32(v[4 * q + 2][c] * W8_SCALE, v[4 * q + 3][c] * W8_SCALE, w, true); o[q] = (unsigned)w; }
        const int row = conv_rowmap(j.mode & 7, n0 + 4 * nq + c);
        __builtin_nontemporal_store(o, (u32x4*)(Wt8 + (size_t)row * j.K + k0 + 16 * kg));
    }
}
__device__ __forceinline__ ConvJob conv_decode(const Args& a, int it) {
    unsigned char* ws = a.ws; ConvJob j;
    if (it < CS1) { if (it < CI_QA) j = ConvJob{a.in[8], (bf16*)(ws + WS_WQKVA), 1024, QKVA_N, 3, it}; else j = ConvJob{a.in[12], (bf16*)(ws + WS_WOA), 1024, 1024, FP8_O ? 8 : 0, it - CI_QA}; return j; }
    if (it >= CS3 && it < CS4) { const int r = it - CS3; if (r < CI_QB) j = ConvJob{a.in[13], (bf16*)(ws + WS_WQKVB), 1024, QKVB_N, 4, r}; else j = ConvJob{a.in[17], (bf16*)(ws + WS_WOB), 1024, 1024, FP8_O ? 8 : 0, r - CI_QB}; return j; }
    int l, r; bool down;
    if (it < CS2) { l = 0; down = true; r = it - CS1; } else if (it < CS3) { l = 0; down = false; r = it - CS2; } else if (it < CS5) { l = 1; down = false; r = it - CS4; } else { l = 1; down = true; r = it - CS5; }
    if (down) { const int e = r / WD_IPE, item = r % WD_IPE, le = l * 16 + e;
        if (FP8_DOWN) j = ConvJob{a.in[21] + (size_t)le * 2048 * 1024, (bf16*)(ws + WS_WD + (size_t)le * 1024 * 2048), 2048, 1024, 8, item};
        else j = ConvJob{a.in[21] + (size_t)le * 2048 * 1024, (bf16*)(ws + WS_WD) + (size_t)le * 1024 * 2048, 2048, 1024, 0, item}; }
    else { const int e = r / (2 * GU_IPM), which = (r / GU_IPM) & 1, item = r % GU_IPM, le = l * 16 + e;
        if (FP8_GU) j = ConvJob{(which ? a.in[20] : a.in[19]) + (size_t)le * 1024 * 2048, (bf16*)(ws + WS_WGU + (size_t)le * 4096 * 1024), 1024, 2048, 8 + 1 + which, item};
        else j = ConvJob{(which ? a.in[20] : a.in[19]) + (size_t)le * 1024 * 2048, (bf16*)(ws + WS_WGU) + (size_t)le * 4096 * 1024, 1024, 2048, 1 + which, item}; }
    return j;
}
#ifndef CONV_DEPTH
#define CONV_DEPTH 3
#endif
__device__ __forceinline__ void conv_span(const Args& a, int lo, int hi, int nw, int wid, const int kwave) {
    const int lane = TIDX & 63, wave = TIDX >> 6, stride = nw * NWAVES;
    for (int it = lo + wid * NWAVES + wave; it < hi; it += CONV_DEPTH * stride) {
        ConvJob j[CONV_DEPTH]; f32x4 v[CONV_DEPTH][8];
        bool any8 = false;
#pragma unroll
        for (int d = 0; d < CONV_DEPTH; ++d) if (it + d * stride < hi) { j[d] = conv_decode(a, it + d * stride); any8 = any8 || j[d].mode >= 8; }
        if (any8) {
#pragma unroll
            for (int d = 0; d < CONV_DEPTH; ++d) if (it + d * stride < hi) {
                if (j[d].mode >= 8) { f32x4 w[16]; conv_load8(j[d], w, lane); conv_store8(j[d], w, lane); }
                else { conv_load(j[d], v[0], lane); conv_store(j[d], v[0], lane); } }
        } else {
#pragma unroll
            for (int d = 0; d < CONV_DEPTH; ++d) if (it + d * stride < hi) conv_load(j[d], v[d], lane);
#pragma unroll
            for (int d = 0; d < CONV_DEPTH; ++d) if (it + d * stride < hi) conv_store(j[d], v[d], lane);
        }
    }
}
#ifndef Q2
#define Q2 5500
#endif
#ifndef Q4
#define Q4 5500
#endif
#ifndef Q6
#define Q6 5384
#endif
#ifndef Q8
#define Q8 8500
#endif
#ifndef Q10
#define Q10 5000
#endif
#ifndef Q14A
#define Q14A 2884
#endif
#ifndef Q14B
#define Q14B 4096
#endif
constexpr int F_P2_A = CS2, F_P2_B = F_P2_A + Q2, F_P4_A = F_P2_B, F_P4_B = F_P4_A + Q4, F_P6_A = F_P4_B, F_P6_B = F_P6_A + Q6;
constexpr int F_P8_A = CS4, F_P8_B = F_P8_A + Q8, F_P10_A = F_P8_B, F_P10_B = F_P10_A + Q10, F_P14_A = F_P10_B, F_P14_B = F_P14_A + Q14A;
constexpr int F_P14_C = CS5, F_P14_D = CS5 + Q14B;
static_assert(F_P6_B <= CS3 && F_P14_B <= CS5 && F_P14_D <= CS_END, "filler plan");

__global__ void __launch_bounds__(NTHREADS, 2) mega(Args a) {
    extern __shared__ __attribute__((aligned(16))) unsigned char lds_raw[];
    LAS unsigned char* lds = (LAS unsigned char*)lds_raw;
    const int kwave = __builtin_amdgcn_readfirstlane((int)(threadIdx.x >> 6));
    const int lo = a.ph_lo, hi = a.ph_hi;
    volatile LAS unsigned* MISC = (volatile LAS unsigned*)(lds + 131072);
    if (TIDX < 64) MISC[TIDX] = 0u;
    __syncthreads();
    XcdBarrier bar; bar.bar = (unsigned*)(a.ws + WS_CTL) + 4096; bar.x = 0; bar.st = nullptr;
    if (hi - lo > 1) bar = xcd_barrier_post((unsigned*)(a.ws + WS_CTL) + 4096, MISC + 8, kwave);
#define IN(k) (lo <= (k) && (k) < hi)
#define SEAM(k) do { if (IN(k) && IN((k) + 1)) xcd_barrier(bar, kwave); } while (0)
    unsigned char* ws = a.ws;
    const float* mod = (const float*)(ws + WS_MOD);
    LAS int* ldsidx = (LAS int*)(lds + IDX_OFF);
    const int G = gridDim.x, bx = blockIdx.x;
    const bool plan = (G == 256) && (hi - lo == 18);
#define FILL_TAIL(nwg_, A, B) do { if (plan) { const int rem_ = (nwg_) % G; if (rem_ && bx >= rem_) conv_span(a, (A), (B), G - rem_, bx - rem_, kwave); } } while (0)
    if (IN(0)) { p0_phase(a, lds, kwave);
        if (plan) { conv_span(a, CS0, CS2, G, bx, kwave); conv_span(a, F_P6_B, CS4, G, bx, kwave); conv_span(a, F_P14_B, CS5, G, bx, kwave); conv_span(a, F_P14_D, CS_END, G, bx, kwave); } else conv_span(a, 0, CS_END, G, bx, kwave); }
    SEAM(0);
    if (IN(1)) norm1_l0_phase(a, kwave);
    SEAM(1);
    if (IN(2)) {
        pg8::Sched Sc; Sc.init(NROWS / 256, QKVA_N / 256, G, bx, 0, ws + WS_WQKVA, 0, (size_t)256 * 1024 * 2); Sc.reph = GREPH(2);
        pg8::EpiQKV E{(bf16*)(ws + WS_Q), (bf16*)(ws + WS_K), (bf16*)(ws + WS_V), 256, 4, 1, a.in[9], a.in[10], (const float*)(ws + WS_ROPE), 1, QSCALE};
        pg8::gemm_phase<pg8::EpiQKV, false>(lds, (const char*)(ws + WS_HL), 1024, Sc, E, ldsidx, nullptr, kwave);
        FILL_TAIL((NROWS / 256) * (QKVA_N / 256), F_P2_A, F_P2_B);
    }
    SEAM(2);
    if (IN(3)) for (int rep_ = 0; rep_ < NREP(3); ++rep_) { if (rep_) xcd_barrier(bar, kwave);
        const int vcu = (G % 8 == 0) ? (bx % 8) * (G / 8) + bx / 8 : bx;
        att::attn_a_phase(lds, vcu * 8, vcu * 8 < 2048 ? 8 : 0, (vcu & 15) < 4 ? 2048 + (vcu >> 4) * 4 + (vcu & 3) : -1, (const bf16*)(ws + WS_Q), (const bf16*)(ws + WS_K), (const bf16*)(ws + WS_V), (bf16*)(ws + WS_O), a.in[11], a.in[9], a.in[10], kwave);
    }
    SEAM(3);
    if (IN(4)) {
        constexpr int EB = FP8_O ? 1 : 2;
        pg8::Sched Sc; Sc.init(NROWS / 256, 4, G, bx, 0, ws + WS_WOA, 0, (size_t)256 * 1024 * EB); Sc.reph = GREPH(4);
        pg8::EpiOproj E{a.in[0], a.in[2], a.out, (float*)(ws + WS_XC), mod + 0 * 5 * 6144 + 2 * 1024, FP8_O ? W8_INV / O8_SCALE : 1.0f};
        pg8::gemm_phase<pg8::EpiOproj, false, FP8_O != 0>(lds, (const char*)(ws + WS_O), 1024 * EB / 2, Sc, E, ldsidx, nullptr, kwave);
        FILL_TAIL((NROWS / 256) * 4, F_P4_A, F_P4_B);
    }
    SEAM(4);
    if (IN(5)) norm2_router_phase(a, 0, NROWS, lds, kwave);
    SEAM(5);
    if (IN(6)) { select_phase(a, 128, lds, kwave);
        if (plan) { constexpr int E1 = 256, E2 = 1024, M0 = F_P6_A + E1, M1 = F_P6_B - E2;
            if (bx < 64) conv_span(a, F_P6_A, M0, 64, bx, kwave);
            else { conv_span(a, M0, M1, G - 64, bx - 64, kwave); if (bx >= 128) conv_span(a, M1, F_P6_B, G - 128, bx - 128, kwave); } } }
    SEAM(6);
    if (IN(7)) {
        constexpr int EB = FP8_GU ? 1 : 2;
        pg8::Sched Sc; Sc.init(272, 16, G, bx, 17, ws + WS_WGU, (size_t)4096 * 1024 * EB, (size_t)256 * 1024 * EB); Sc.reph = GREPH(7);
        pg8::EpiGU E{(bf16*)(ws + WS_H), FP8_GU ? W8_INV : 1.0f};
        pg8::gemm_phase<pg8::EpiGU, true, FP8_GU != 0>(lds, (const char*)(ws + WS_HL), 1024 * EB / 2, Sc, E, ldsidx, (const int*)(ws + WS_ROWIDX), kwave);
    }
    SEAM(7);
    if (IN(8)) {
        constexpr int EB = FP8_DOWN ? 1 : 2;
        pg8::Sched Sc; Sc.init(272, 4, G, bx, 17, ws + WS_WD, (size_t)1024 * 2048 * EB, (size_t)256 * 2048 * EB); Sc.reph = GREPH(8);
        pg8::EpiDown E{(bf16*)(ws + WS_Y), (const float*)(ws + WS_GATE)};
        pg8::gemm_phase<pg8::EpiDown, false, FP8_DOWN != 0>(lds, (const char*)(ws + WS_H), 2048 * EB / 2, Sc, E, ldsidx, nullptr, kwave);
        FILL_TAIL(272 * 4, F_P8_A, F_P8_B);
    }
    SEAM(8);
    if (IN(9)) combine_phase(a, 0, kwave);
    SEAM(9);
    if (IN(10)) {
        pg8::Sched Sc; Sc.init(NROWS / 256, QKVB_N / 256, G, bx, 0, ws + WS_WQKVB, 0, (size_t)256 * 1024 * 2); Sc.reph = GREPH(10);
        pg8::EpiQKV E{(bf16*)(ws + WS_Q), (bf16*)(ws + WS_K), (bf16*)(ws + WS_V), 1024, 4, 4, a.in[14], a.in[15], (const float*)(ws + WS_ROPE), 0, QSCALE};
        pg8::gemm_phase<pg8::EpiQKV, false>(lds, (const char*)(ws + WS_HL), 1024, Sc, E, ldsidx, nullptr, kwave);
        FILL_TAIL((NROWS / 256) * (QKVB_N / 256), F_P10_A, F_P10_B);
    }
    SEAM(10);
    if (IN(11)) for (int rep_ = 0; rep_ < NREP(11); ++rep_) { if (rep_) xcd_barrier(bar, kwave);
        const int vcu = (G % 8 == 0) ? (bx % 8) * (G / 8) + bx / 8 : bx;
        att::attn_b_phase(lds, vcu * 8, vcu * 8 < 2048 ? 8 : 0, (const bf16*)(ws + WS_Q), (const bf16*)(ws + WS_K), (const bf16*)(ws + WS_V), (bf16*)(ws + WS_O), a.in[16], a.in[14], a.in[15], kwave);
    }
    SEAM(11);
    if (IN(12)) {
        constexpr int EB = FP8_O ? 1 : 2;
        pg8::Sched Sc; Sc.init(NLAT / 256, 4, G, bx, 0, ws + WS_WOB, 0, (size_t)256 * 1024 * EB); Sc.reph = GREPH(12);
        pg8::EpiOproj E{a.out, a.in[2], a.out, (float*)(ws + WS_XC), mod + 1 * 5 * 6144 + 2 * 1024, FP8_O ? W8_INV / O8_SCALE : 1.0f};
        pg8::gemm_phase<pg8::EpiOproj, false, FP8_O != 0>(lds, (const char*)(ws + WS_O), 1024 * EB / 2, Sc, E, ldsidx, nullptr, kwave);
    }
    SEAM(12);
    if (IN(13)) norm2_router_phase(a, 1, NLAT, lds, kwave);
    SEAM(13);
    if (IN(14)) { select_phase(a, 64, lds, kwave);
        if (plan) { constexpr int E1 = 640, C1 = F_P14_D - E1;
            if (bx < 64) conv_span(a, C1, F_P14_D, 64, bx, kwave);
            else { conv_span(a, F_P14_A, F_P14_B, G - 64, bx - 64, kwave); conv_span(a, F_P14_C, C1, G - 64, bx - 64, kwave); } } }
    SEAM(14);
    if (IN(15)) {
        constexpr int EB = FP8_GU ? 1 : 2;
        pg8::Sched Sc; Sc.init(256, 16, G, bx, 16, ws + WS_WGU + (size_t)16 * 4096 * 1024 * EB, (size_t)4096 * 1024 * EB, (size_t)256 * 1024 * EB); Sc.reph = GREPH(15);
        pg8::EpiGU E{(bf16*)(ws + WS_H), FP8_GU ? W8_INV : 1.0f};
        pg8::gemm_phase<pg8::EpiGU, true, FP8_GU != 0>(lds, (const char*)(ws + WS_HL), 1024 * EB / 2, Sc, E, ldsidx, (const int*)(ws + WS_ROWIDX), kwave);
    }
    SEAM(15);
    if (IN(16)) {
        constexpr int EB = FP8_DOWN ? 1 : 2;
        pg8::Sched Sc; Sc.init(256, 4, G, bx, 16, ws + WS_WD + (size_t)16 * 1024 * 2048 * EB, (size_t)1024 * 2048 * EB, (size_t)256 * 2048 * EB); Sc.reph = GREPH(16);
        pg8::EpiDown E{(bf16*)(ws + WS_Y), (const float*)(ws + WS_GATE)};
        pg8::gemm_phase<pg8::EpiDown, false, FP8_DOWN != 0>(lds, (const char*)(ws + WS_H), 2048 * EB / 2, Sc, E, ldsidx, nullptr, kwave);
    }
    SEAM(16);
    if (IN(17)) combine_phase(a, 1, kwave);
#undef IN
#undef SEAM
#undef FILL_TAIL
}

struct NaiveG {
    const bf16* A; int lda; const int* rowidx;
    const float* W; const float* W2; int ldw; size_t wstride_e;
    int M, N, K, mode;
    bf16* o0; bf16* o1; bf16* o2; int kvw;
    const float* base_lat; const float* base_ctx; float* out_lat; float* out_ctx; const float* g1;
    const float* gate;
};
__global__ void __launch_bounds__(256) naive_gemm(NaiveG g) {
    const int lane = threadIdx.x & 63, wave = threadIdx.x >> 6;
    const int tiles_n = g.N / 64; const long ntiles = (long)(g.M / 32) * tiles_n;
    const int fr = lane & 15, fq = lane >> 4;
    for (long wt = (long)blockIdx.x * 4 + wave; wt < ntiles; wt += (long)gridDim.x * 4) {
        const int tm = (int)(wt / tiles_n), tn = (int)(wt % tiles_n), r0 = tm * 32, c0 = tn * 64;
        const int e = g.wstride_e ? r0 / SLOTS_E : 0;
        const float* W = g.W + (size_t)e * g.wstride_e; const float* W2 = g.W2 ? g.W2 + (size_t)e * g.wstride_e : nullptr;
        const bf16* arow[2];
#pragma unroll
        for (int mi = 0; mi < 2; ++mi) { const int m = r0 + 16 * mi + fr; const int ar = g.rowidx ? g.rowidx[m] : m; arow[mi] = g.A + (size_t)ar * g.lda + 8 * fq; }
        f32x4 acc[2][4], acc2[2][4];
#pragma unroll
        for (int mi = 0; mi < 2; ++mi)
#pragma unroll
            for (int ni = 0; ni < 4; ++ni) { acc[mi][ni] = (f32x4){0.f, 0.f, 0.f, 0.f}; acc2[mi][ni] = (f32x4){0.f, 0.f, 0.f, 0.f}; }
        for (int k0 = 0; k0 < g.K; k0 += 32) {
            bf16x8 af[2];
#pragma unroll
            for (int mi = 0; mi < 2; ++mi) af[mi] = *(const bf16x8*)(arow[mi] + k0);
#pragma unroll
            for (int ni = 0; ni < 4; ++ni) {
                const float* wp = W + (size_t)(k0 + 8 * fq) * g.ldw + c0 + 16 * ni + fr;
                bf16x8 bfr;
#pragma unroll
                for (int j = 0; j < 8; ++j) bfr[j] = (short)f2bf(wp[(size_t)j * g.ldw]);
#pragma unroll
                for (int mi = 0; mi < 2; ++mi) acc[mi][ni] = __builtin_amdgcn_mfma_f32_16x16x32_bf16(af[mi], bfr, acc[mi][ni], 0, 0, 0);
                if (W2) {
                    const float* wp2 = W2 + (size_t)(k0 + 8 * fq) * g.ldw + c0 + 16 * ni + fr;
#pragma unroll
                    for (int j = 0; j < 8; ++j) bfr[j] = (short)f2bf(wp2[(size_t)j * g.ldw]);
#pragma unroll
                    for (int mi = 0; mi < 2; ++mi) acc2[mi][ni] = __builtin_amdgcn_mfma_f32_16x16x32_bf16(af[mi], bfr, acc2[mi][ni], 0, 0, 0);
                }
            }
        }
#pragma unroll
        for (int mi = 0; mi < 2; ++mi)
#pragma unroll
            for (int ni = 0; ni < 4; ++ni)
#pragma unroll
                for (int i = 0; i < 4; ++i) {
                    const int row = r0 + 16 * mi + 4 * fq + i, col = c0 + 16 * ni + fr; const float v = acc[mi][ni][i];
                    if (g.mode == 0) {
                        const int nq = 1024;
                        if (col < nq) g.o0[(size_t)row * 1024 + col] = (bf16)f2bf(v);
                        else if (col < nq + g.kvw) g.o1[(size_t)row * g.kvw + col - nq] = (bf16)f2bf(v);
                        else g.o2[(size_t)row * g.kvw + col - nq - g.kvw] = (bf16)f2bf(v);
                    } else if (g.mode == 1) {
                        const bool lat = row < NLAT; const int r = lat ? row / S : 4;
                        const size_t off = lat ? (size_t)row * D + col : (size_t)(row - NLAT) * D + col;
                        const float bs = lat ? g.base_lat[off] : g.base_ctx[off];
                        (lat ? g.out_lat : g.out_ctx)[off] = bs + g.g1[r * 6144 + col] * v;
                    } else if (g.mode == 2) {
                        const float u = acc2[mi][ni][i]; g.o0[(size_t)row * FF + col] = (bf16)f2bf(silu_f(v) * u);
                    } else {
                        g.o0[(size_t)row * D + col] = (bf16)f2bf(v * g.gate[row]);
                    }
                }
    }
}
__global__ void __launch_bounds__(256) naive_qknorm(bf16* Q, bf16* Kb, int kvw, const float* qg, const float* kg, const float* ropet, int rope) {
    const int lane = threadIdx.x & 63, wave = threadIdx.x >> 6;
    const int nkh = kvw / 64;
    for (int row = blockIdx.x * 4 + wave; row < NROWS; row += gridDim.x * 4) {
        const bool lat = row < NLAT; const int pos = row % S;
        for (int h = 0; h < 16 + nkh; ++h) {
            bf16* p = h < 16 ? Q + (size_t)row * 1024 + h * 64 + lane : Kb + (size_t)row * kvw + (h - 16) * 64 + lane;
            const float x = bf2f(*p);
            const float ss = wave_sum(x * x);
            float y = x * (1.0f / sqrtf(ss * (1.0f / 64.0f) + EPS)) * (h < 16 ? qg[lane] : kg[lane]);
            if (rope && lat) {
                const int half = lane >> 5, dd = lane & 31, f = dd & 15; const int v = half == 0 ? pos / 64 : pos % 64;
                const float cs = ropet[v * 16 + f], sn = ropet[128 * 16 + v * 16 + f];
                const float other = __shfl_xor(y, 16);
                y = (dd < 16) ? y * cs - other * sn : other * sn + y * cs;
            }
            *p = (bf16)f2bf(y);
        }
    }
}
__global__ void __launch_bounds__(256) naive_attn_a(const bf16* Q, const bf16* Kb, const bf16* Vb, bf16* O, const float* sink, float sscale) {
    const int lane = threadIdx.x & 63, wave = threadIdx.x >> 6;
    const long total = (long)NROWS * 16;
    for (long gw = (long)blockIdx.x * 4 + wave; gw < total; gw += (long)gridDim.x * 4) {
        const int row = (int)(gw >> 4), head = (int)(gw & 15), kvh = head >> 2;
        const bool lat = row < NLAT; const int b = lat ? row / S : (row - NLAT) / CTX, pos = row % S;
        float q[64];
#pragma unroll
        for (int c = 0; c < 8; ++c) { const u32x4 w = *(const u32x4*)(Q + (size_t)row * 1024 + head * 64 + 8 * c);
            q[8 * c] = bf2f(w.x & 0xffffu); q[8 * c + 1] = bf2f(w.x >> 16); q[8 * c + 2] = bf2f(w.y & 0xffffu); q[8 * c + 3] = bf2f(w.y >> 16);
            q[8 * c + 4] = bf2f(w.z & 0xffffu); q[8 * c + 5] = bf2f(w.z >> 16); q[8 * c + 6] = bf2f(w.w & 0xffffu); q[8 * c + 7] = bf2f(w.w >> 16); }
        const int klo = lat ? max(pos - 128, 0) : 0, khi = lat ? min(pos + 128, S - 1) : -1;
        float sc[9]; int krow[9];
        const float sk = sink[head];
        float mx = sk;
#pragma unroll
        for (int t = 0; t < 9; ++t) {
            int kr; bool valid;
            if (t < 5) { const int kp = klo + 64 * t + lane; valid = kp <= khi; kr = b * S + kp; }
            else { valid = true; kr = NLAT + b * CTX + 64 * (t - 5) + lane; }
            krow[t] = valid ? kr : -1; float s = -1e30f;
            if (valid) { const bf16* kp_ = Kb + (size_t)kr * 256 + kvh * 64; float d = 0.f;
#pragma unroll
                for (int c = 0; c < 8; ++c) { const u32x4 w = *(const u32x4*)(kp_ + 8 * c);
                    d += q[8 * c] * bf2f(w.x & 0xffffu) + q[8 * c + 1] * bf2f(w.x >> 16) + q[8 * c + 2] * bf2f(w.y & 0xffffu) + q[8 * c + 3] * bf2f(w.y >> 16)
                       + q[8 * c + 4] * bf2f(w.z & 0xffffu) + q[8 * c + 5] * bf2f(w.z >> 16) + q[8 * c + 6] * bf2f(w.w & 0xffffu) + q[8 * c + 7] * bf2f(w.w >> 16); }
                s = d * sscale; }
            sc[t] = s; mx = fmaxf(mx, s);
        }
        mx = wave_max(mx);
        float den = 0.f;
#pragma unroll
        for (int t = 0; t < 9; ++t) { sc[t] = krow[t] >= 0 ? expf(sc[t] - mx) : 0.f; den += sc[t]; }
        den = wave_sum(den) + expf(sk - mx);
        float o = 0.f;
#pragma unroll
        for (int t = 0; t < 9; ++t)
            for (int j = 0; j < 64; ++j) { const int kr = __shfl(krow[t], j); const float p = __shfl(sc[t], j); if (kr >= 0) o += p * bf2f(Vb[(size_t)kr * 256 + kvh * 64 + lane]); }
        O[(size_t)row * 1024 + head * 64 + lane] = (bf16)f2bf(o / den);
    }
}
__global__ void __launch_bounds__(256) naive_attn_b(const bf16* Q, const bf16* Kb, const bf16* Vb, bf16* O, const float* rpb, float sscale) {
    const int lane = threadIdx.x & 63, wave = threadIdx.x >> 6;
    const long total = (long)NLAT * 16;
    for (long gw = (long)blockIdx.x * 4 + wave; gw < total; gw += (long)gridDim.x * 4) {
        const int row = (int)(gw >> 4), head = (int)(gw & 15);
        const int b = row / S, pos = row % S, r = pos / 64, c = pos % 64;
        const int rs = min(max(r - 4, 0), 120), wst = min(max(c - 8, 0), 48);
        float q[64];
#pragma unroll
        for (int cc = 0; cc < 8; ++cc) { const u32x4 w = *(const u32x4*)(Q + (size_t)row * 1024 + head * 64 + 8 * cc);
            q[8 * cc] = bf2f(w.x & 0xffffu); q[8 * cc + 1] = bf2f(w.x >> 16); q[8 * cc + 2] = bf2f(w.y & 0xffffu); q[8 * cc + 3] = bf2f(w.y >> 16);
            q[8 * cc + 4] = bf2f(w.z & 0xffffu); q[8 * cc + 5] = bf2f(w.z >> 16); q[8 * cc + 6] = bf2f(w.w & 0xffffu); q[8 * cc + 7] = bf2f(w.w >> 16); }
        float sc[6]; int krow[6]; float mx = -1e30f;
#pragma unroll
        for (int t = 0; t < 6; ++t) {
            int kr; float bias = 0.f;
            if (t < 2) { const int j = 64 * t + lane, krr = rs + (j >> 4), kc = wst + (j & 15); kr = b * S + krr * 64 + kc; bias = rpb[(head * 15 + (krr - r + 7)) * 31 + (kc - c + 15)]; }
            else kr = NLAT + b * CTX + 64 * (t - 2) + lane;
            krow[t] = kr;
            const bf16* kp_ = Kb + (size_t)kr * 1024 + head * 64; float d = 0.f;
#pragma unroll
            for (int cc = 0; cc < 8; ++cc) { const u32x4 w = *(const u32x4*)(kp_ + 8 * cc);
                d += q[8 * cc] * bf2f(w.x & 0xffffu) + q[8 * cc + 1] * bf2f(w.x >> 16) + q[8 * cc + 2] * bf2f(w.y & 0xffffu) + q[8 * cc + 3] * bf2f(w.y >> 16)
                   + q[8 * cc + 4] * bf2f(w.z & 0xffffu) + q[8 * cc + 5] * bf2f(w.z >> 16) + q[8 * cc + 6] * bf2f(w.w & 0xffffu) + q[8 * cc + 7] * bf2f(w.w >> 16); }
            sc[t] = d * sscale + bias; mx = fmaxf(mx, sc[t]);
        }
        mx = wave_max(mx);
        float den = 0.f;
#pragma unroll
        for (int t = 0; t < 6; ++t) { sc[t] = expf(sc[t] - mx); den += sc[t]; }
        den = wave_sum(den);
        float o = 0.f;
#pragma unroll
        for (int t = 0; t < 6; ++t)
            for (int j = 0; j < 64; ++j) { const int kr = __shfl(krow[t], j); const float p = __shfl(sc[t], j); o += p * bf2f(Vb[(size_t)kr * 1024 + head * 64 + lane]); }
        O[(size_t)row * 1024 + head * 64 + lane] = (bf16)f2bf(o / den);
    }
}

extern "C" void kernel_launch(void* const* d_in, const int* in_sizes, int n_in, void* d_out, int out_size, void* d_ws, size_t ws_size, hipStream_t stream) {
    static int grid = 0;
    if (grid == 0) {
        if (n_in != 22 || out_size != NLAT * D || ws_size < WS_END) { fprintf(stderr, "kernel_launch: unexpected shapes n_in %d out %d ws %zu\n", n_in, out_size, ws_size); grid = -1; return; }
        int dev = 0, cus = 0, per_cu = 0;
        hipGetDevice(&dev); hipDeviceGetAttribute(&cus, hipDeviceAttributeMultiprocessorCount, dev);
        hipFuncSetAttribute((const void*)mega, hipFuncAttributeMaxDynamicSharedMemorySize, LDS_BYTES);
        hipOccupancyMaxActiveBlocksPerMultiprocessor(&per_cu, (const void*)mega, NTHREADS, LDS_BYTES);
        (void)hipGetLastError();
        if (per_cu < 1) fprintf(stderr, "kernel_launch: occupancy query says %d blocks/CU\n", per_cu);
        grid = cus;
    }
    if (grid < 0) return;
    unsigned char* ws = (unsigned char*)d_ws;
    hipMemsetAsync(ws + WS_CTL, 0, 1 * MiB, stream);
    Args a{};
    for (int i = 0; i < 22; ++i) a.in[i] = (const float*)d_in[i];
    a.out = (float*)d_out; a.ws = ws;
    auto run = [&](int p) { a.ph_lo = p; a.ph_hi = p + 1; hipLaunchKernelGGL(mega, dim3(grid), dim3(NTHREADS), LDS_BYTES, stream, a); };
    const float* mod = (const float*)(ws + WS_MOD);
    bf16* HL = (bf16*)(ws + WS_HL); bf16* Qb = (bf16*)(ws + WS_Q); bf16* Kb = (bf16*)(ws + WS_K); bf16* Vb = (bf16*)(ws + WS_V); bf16* Ob = (bf16*)(ws + WS_O);
    bf16* Hb = (bf16*)(ws + WS_H); bf16* Yb = (bf16*)(ws + WS_Y);
    const int NG = 2048;
#if ONE_LAUNCH
    a.ph_lo = 0; a.ph_hi = 18; hipLaunchKernelGGL(mega, dim3(grid), dim3(NTHREADS), LDS_BYTES, stream, a);
    (void)run; (void)mod; (void)HL; (void)Qb; (void)Kb; (void)Vb; (void)Ob; (void)Hb; (void)Yb; (void)NG;
#else
    run(0); run(1);
    for (int l = 0; l < 2; ++l) {
#if FAST_QKV
        run(l == 0 ? 2 : 10);
        const float sscale = 1.0f / LOG2E;
#else
        { NaiveG g{}; g.A = HL; g.lda = D; g.W = l == 0 ? a.in[8] : a.in[13]; g.ldw = l == 0 ? QKVA_N : QKVB_N; g.M = NROWS; g.N = g.ldw; g.K = D; g.mode = 0;
          g.o0 = Qb; g.o1 = Kb; g.o2 = Vb; g.kvw = l == 0 ? 256 : 1024;
          hipLaunchKernelGGL(naive_gemm, dim3(NG), dim3(256), 0, stream, g); }
        hipLaunchKernelGGL(naive_qknorm, dim3(NG), dim3(256), 0, stream, Qb, Kb, l == 0 ? 256 : 1024, l == 0 ? a.in[9] : a.in[14], l == 0 ? a.in[10] : a.in[15], (const float*)(ws + WS_ROPE), l == 0 ? 1 : 0);
        const float sscale = 0.125f;
#endif
#if FAST_ATTN_A
        if (l == 0) run(3);
#else
        if (l == 0) hipLaunchKernelGGL(naive_attn_a, dim3(NG), dim3(256), 0, stream, (const bf16*)Qb, (const bf16*)Kb, (const bf16*)Vb, Ob, a.in[11], sscale);
#endif
#if FAST_ATTN_B
        if (l == 1) run(11);
#else
        if (l == 1) hipLaunchKernelGGL(naive_attn_b, dim3(NG), dim3(256), 0, stream, (const bf16*)Qb, (const bf16*)Kb, (const bf16*)Vb, Ob, a.in[16], sscale);
#endif
#if FAST_OPROJ
        run(l == 0 ? 4 : 12);
#else
        { NaiveG g{}; g.A = Ob; g.lda = D; g.W = l == 0 ? a.in[12] : a.in[17]; g.ldw = D; g.M = l == 0 ? NROWS : NLAT; g.N = D; g.K = D; g.mode = 1;
          g.base_lat = l == 0 ? a.in[0] : (const float*)d_out; g.base_ctx = a.in[2]; g.out_lat = (float*)d_out; g.out_ctx = (float*)(ws + WS_XC); g.g1 = mod + l * 5 * 6144 + 2 * 1024;
          hipLaunchKernelGGL(naive_gemm, dim3(NG), dim3(256), 0, stream, g); }
#endif
        run(l == 0 ? 5 : 13);
        run(l == 0 ? 6 : 14);
#if FAST_G1
        run(l == 0 ? 7 : 15);
#else
        { NaiveG g{}; g.A = HL; g.lda = D; g.rowidx = (const int*)(ws + WS_ROWIDX); g.W = a.in[19] + (size_t)l * 16 * 1024 * 2048; g.W2 = a.in[20] + (size_t)l * 16 * 1024 * 2048; g.ldw = FF; g.wstride_e = (size_t)1024 * 2048;
          g.M = NSLOT; g.N = FF; g.K = D; g.mode = 2; g.o0 = Hb;
          hipLaunchKernelGGL(naive_gemm, dim3(NG), dim3(256), 0, stream, g); }
#endif
#if FAST_G2
        run(l == 0 ? 8 : 16);
#else
        { NaiveG g{}; g.A = Hb; g.lda = FF; g.W = a.in[21] + (size_t)l * 16 * 2048 * 1024; g.ldw = D; g.wstride_e = (size_t)2048 * 1024;
          g.M = NSLOT; g.N = D; g.K = FF; g.mode = 3; g.o0 = Yb; g.gate = (const float*)(ws + WS_GATE);
          hipLaunchKernelGGL(naive_gemm, dim3(NG), dim3(256), 0, stream, g); }
#endif
        run(l == 0 ? 9 : 17);
    }
#endif
}
```
